# Optimizing an MI355X kernel written in HIP

```python
import math
import jax, jax.numpy as jnp
from jax import lax
import numpy as np

D_MODEL = 1024
BATCH = 16
SEQ = 2048
DEPTH = 2

GRID_W = 64
CTX_LEN = 256
N_MIXERS = 2
N_A_LAYERS = (DEPTH + 1) // 2
N_B_LAYERS = DEPTH // 2
CONV_WIDTH = 3
DIFF_HEADS = 8
DIFF_HEAD_DIM = 64
DIFF_V_DIM = 2 * DIFF_HEAD_DIM
ROPE_BASE = 10000.0
N_EXPERTS = 16
EC_FACTOR = 2
EXPERT_FF = 2048
Q_BLOCK = 128
N_MOD = 6
EPS = 1e-6

kernel_name = "hybrid_shortconv_diffattn_ecmoe_dit"


def rmsnorm(x, g):
    xf = x.astype(jnp.float32)
    xf = xf * lax.rsqrt(jnp.mean(xf * xf, axis=-1, keepdims=True) + EPS)
    return xf.astype(x.dtype) * g


def modulate(h, shift, scale):
    return h * (1.0 + scale) + shift


def ada_mod(cond, w, b):
    return jnp.split(jax.nn.silu(cond) @ w + b, N_MOD, axis=-1)


def axial_rope_angles(n):
    rows = n // GRID_W
    row = jnp.repeat(jnp.arange(rows), GRID_W).astype(jnp.float32)
    col = jnp.tile(jnp.arange(GRID_W), rows).astype(jnp.float32)
    n_freq = DIFF_HEAD_DIM // 4
    inv = 1.0 / (ROPE_BASE ** (jnp.arange(n_freq, dtype=jnp.float32) / n_freq))
    return row[:, None] * inv, col[:, None] * inv


def rope_rotate(x, ang):
    x1, x2 = jnp.split(x, 2, axis=-1)
    cos = jnp.cos(ang).astype(x.dtype)
    sin = jnp.sin(ang).astype(x.dtype)
    return jnp.concatenate([x1 * cos - x2 * sin, x2 * cos + x1 * sin], axis=-1)


def apply_axial_rope(x, ang_row, ang_col):
    xr, xc = jnp.split(x, 2, axis=-1)
    ar = ang_row[:, None, None, :]
    ac = ang_col[:, None, None, :]
    return jnp.concatenate([rope_rotate(xr, ar), rope_rotate(xc, ac)], axis=-1)


def short_conv_mixer(h, w_in, k_conv, w_out):
    n = h.shape[1]
    b_gate, c_gate, v = jnp.split(h @ w_in, 3, axis=-1)
    u = c_gate * v
    pad = (CONV_WIDTH - 1) // 2
    up = jnp.pad(u, ((0, 0), (pad, pad), (0, 0)))
    conv = sum(k_conv[j] * up[:, j:j + n] for j in range(CONV_WIDTH))
    return (b_gate * conv) @ w_out


def heads_qk(t):
    return t.reshape(t.shape[0], t.shape[1], DIFF_HEADS, 2, DIFF_HEAD_DIM)


def heads_v(t):
    return t.reshape(t.shape[0], t.shape[1], DIFF_HEADS, DIFF_V_DIM)


def diff_attend(q, k, v, lam):
    scale = DIFF_HEAD_DIM ** -0.5
    s = jnp.einsum('bqhcd,bkhcd->cbhqk', q, k).astype(jnp.float32) * scale
    p = jax.nn.softmax(s, axis=-1)
    a = p[0] - lam * p[1]
    return jnp.einsum('bhqk,bkhe->bqhe', a.astype(v.dtype), v)


def diff_attn_mixer(h_lat, h_ctx, w_qkv, lq1, lk1, lq2, lk2, subln_g, w_o,
                    layer_idx, ang_row, ang_col, need_ctx):
    lam_init = 0.8 - 0.6 * math.exp(-0.3 * layer_idx)
    lam = (jnp.exp(jnp.sum(lq1.astype(jnp.float32) * lk1.astype(jnp.float32)))
           - jnp.exp(jnp.sum(lq2.astype(jnp.float32) * lk2.astype(jnp.float32)))
           + lam_init)
    bsz, n = h_lat.shape[0], h_lat.shape[1]
    q_l, k_l, v_l = jnp.split(h_lat @ w_qkv, 3, axis=-1)
    q_l = apply_axial_rope(heads_qk(q_l), ang_row, ang_col)
    k_l = apply_axial_rope(heads_qk(k_l), ang_row, ang_col)
    v_l = heads_v(v_l)
    k_c, v_c = jnp.split(h_ctx @ w_qkv[:, D_MODEL:], 2, axis=-1)
    k_c, v_c = heads_qk(k_c), heads_v(v_c)
    k_all = jnp.concatenate([k_c, k_l], axis=1)
    v_all = jnp.concatenate([v_c, v_l], axis=1)

    def finish(o):
        o = rmsnorm(o, subln_g) * (1.0 - lam_init)
        return o.reshape(o.shape[0], o.shape[1], D_MODEL) @ w_o

    nblk = n // Q_BLOCK
    qb = jnp.swapaxes(q_l.reshape(bsz, nblk, Q_BLOCK, DIFF_HEADS, 2, DIFF_HEAD_DIM), 0, 1)
    o_l = lax.map(lambda qq: diff_attend(qq, k_all, v_all, lam), qb)
    o_l = jnp.swapaxes(o_l, 0, 1).reshape(bsz, n, DIFF_HEADS, DIFF_V_DIM)
    out_l = finish(o_l)
    out_c = None
    if need_ctx:
        q_c = heads_qk(h_ctx @ w_qkv[:, :D_MODEL])
        out_c = finish(diff_attend(q_c, k_c, v_c, lam))
    return out_l, out_c


def ec_moe(h, w_router, w_gate, w_up, w_down):
    bsz, n, d = h.shape
    cap = EC_FACTOR * n // N_EXPERTS
    aff = jax.nn.softmax((h @ w_router).astype(jnp.float32), axis=-1)
    vals, idx = lax.top_k(jnp.swapaxes(aff, 1, 2), cap)
    idx_flat = idx.reshape(bsz, N_EXPERTS * cap)
    xs = jnp.take_along_axis(h, idx_flat[..., None], axis=1).reshape(bsz, N_EXPERTS, cap, d)
    g = jnp.einsum('becd,edf->becf', xs, w_gate)
    u = jnp.einsum('becd,edf->becf', xs, w_up)
    y = jnp.einsum('becf,efd->becd', jax.nn.silu(g) * u, w_down)
    y = y * vals[..., None].astype(y.dtype)
    out = jnp.zeros_like(h)
    return out.at[jnp.arange(bsz)[:, None], idx_flat].add(y.reshape(bsz, N_EXPERTS * cap, d))


def setup_inputs(seed: int = 0) -> dict:
    key = jax.random.key(seed)
    ks = jax.random.split(key, 24)
    f32 = jnp.float32
    D, E, F = D_MODEL, N_EXPERTS, EXPERT_FF
    nrm = lambda k, shape, s: jax.random.normal(k, shape, f32) * s
    gain = lambda k, shape: 1.0 + 0.05 * jax.random.normal(k, shape, f32)
    return {
        "x": nrm(ks[0], (BATCH, SEQ, D), 1.0),
        "c": nrm(ks[1], (BATCH, D), 1.0),
        "ctx": nrm(ks[2], (BATCH, CTX_LEN, D), 1.0),
        "c_ctx": nrm(ks[3], (D,), 1.0),
        "ada_w": nrm(ks[4], (DEPTH, D, N_MOD * D), 0.5 * D ** -0.5),
        "ada_b": nrm(ks[5], (DEPTH, N_MOD * D), 0.01),
        "pre_mix_g": gain(ks[6], (DEPTH, D)),
        "post_mix_g": gain(ks[7], (DEPTH, D)),
        "pre_ffn_g": gain(ks[8], (DEPTH, D)),
        "post_ffn_g": gain(ks[9], (DEPTH, D)),
        "conv_w_in": nrm(ks[10], (N_A_LAYERS, D, 3 * D), D ** -0.5),
        "conv_k": nrm(ks[11], (N_A_LAYERS, CONV_WIDTH, D), CONV_WIDTH ** -0.5),
        "conv_w_out": nrm(ks[12], (N_A_LAYERS, D, D), D ** -0.5),
        "attn_w_qkv": nrm(ks[13], (N_B_LAYERS, D, 3 * D), D ** -0.5),
        "attn_lambda_q1": nrm(ks[14], (N_B_LAYERS, DIFF_HEAD_DIM), 0.1),
        "attn_lambda_k1": nrm(ks[15], (N_B_LAYERS, DIFF_HEAD_DIM), 0.1),
        "attn_lambda_q2": nrm(ks[16], (N_B_LAYERS, DIFF_HEAD_DIM), 0.1),
        "attn_lambda_k2": nrm(ks[17], (N_B_LAYERS, DIFF_HEAD_DIM), 0.1),
        "attn_subln_g": gain(ks[18], (N_B_LAYERS, DIFF_V_DIM)),
        "attn_w_o": nrm(ks[19], (N_B_LAYERS, D, D), D ** -0.5),
        "router_w": nrm(ks[20], (DEPTH, D, E), D ** -0.5),
        "moe_w_gate": nrm(ks[21], (DEPTH, E, D, F), D ** -0.5),
        "moe_w_up": nrm(ks[22], (DEPTH, E, D, F), D ** -0.5),
        "moe_w_down": nrm(ks[23], (DEPTH, E, F, D), F ** -0.5),
    }


def reference(x, c, ctx, c_ctx, ada_w, ada_b, pre_mix_g, post_mix_g, pre_ffn_g, post_ffn_g,
              conv_w_in, conv_k, conv_w_out, attn_w_qkv, attn_lambda_q1, attn_lambda_k1,
              attn_lambda_q2, attn_lambda_k2, attn_subln_g, attn_w_o, router_w,
              moe_w_gate, moe_w_up, moe_w_down):
    x_lat, x_ctx = x, ctx
    ang_row, ang_col = axial_rope_angles(x.shape[1])
    for i in range(DEPTH):
        need_ctx = i < DEPTH - 1
        is_attn = (i % N_MIXERS) == 1
        j = i // N_MIXERS
        sh1, sc1, g1, sh2, sc2, g2 = ada_mod(c[:, None, :], ada_w[i], ada_b[i])
        csh1, csc1, cg1, csh2, csc2, cg2 = ada_mod(c_ctx[None, :], ada_w[i], ada_b[i])
        h_l = modulate(rmsnorm(x_lat, pre_mix_g[i]), sh1, sc1)
        m_c = None
        if need_ctx or is_attn:
            h_c = modulate(rmsnorm(x_ctx, pre_mix_g[i]), csh1, csc1)
        if not is_attn:
            m_l = short_conv_mixer(h_l, conv_w_in[j], conv_k[j], conv_w_out[j])
            if need_ctx:
                m_c = short_conv_mixer(h_c, conv_w_in[j], conv_k[j], conv_w_out[j])
        else:
            m_l, m_c = diff_attn_mixer(h_l, h_c, attn_w_qkv[j], attn_lambda_q1[j],
                                       attn_lambda_k1[j], attn_lambda_q2[j], attn_lambda_k2[j],
                                       attn_subln_g[j], attn_w_o[j], i, ang_row, ang_col,
                                       need_ctx)
        x_lat = x_lat + g1 * rmsnorm(m_l, post_mix_g[i])
        if need_ctx:
            x_ctx = x_ctx + cg1 * rmsnorm(m_c, post_mix_g[i])
        h_l = modulate(rmsnorm(x_lat, pre_ffn_g[i]), sh2, sc2)
        f_l = ec_moe(h_l, router_w[i], moe_w_gate[i], moe_w_up[i], moe_w_down[i])
        x_lat = x_lat + g2 * rmsnorm(f_l, post_ffn_g[i])
        if need_ctx:
            h_c = modulate(rmsnorm(x_ctx, pre_ffn_g[i]), csh2, csc2)
            f_c = ec_moe(h_c, router_w[i], moe_w_gate[i], moe_w_up[i], moe_w_down[i])
            x_ctx = x_ctx + cg2 * rmsnorm(f_c, post_ffn_g[i])
    return x_lat
```

```cpp
#include <hip/hip_runtime.h>
#include <hip/hip_bf16.h>
#include <cstdio>
#include <cstdint>
#include <cmath>

#ifndef MK_SPLIT
#define MK_SPLIT 0
#endif

namespace pg8 {
#define PG8_LAS __attribute__((address_space(3)))
typedef unsigned short bf16_t;
typedef short bf16x8 __attribute__((ext_vector_type(8)));
typedef float f32x4 __attribute__((ext_vector_type(4)));
typedef unsigned u32x4 __attribute__((ext_vector_type(4)));
constexpr int BM = 256, BK = 64, HALF = 128, HTB = HALF * BK * 2  , STAGE_BYTES = 8 * HTB, NXCD = 8, WGM = 8;

__host__ __device__ __forceinline__ int lds_byte(int r, int c) { const int st = (r >> 4) * 2 + (c >> 5), rr = r & 15, cc = c & 31, ob = rr * 64 + cc * 2; return st * 1024 + (ob ^ (((ob >> 9) & 1) << 5)); }
__host__ __device__ __forceinline__ void stage_rc(int b, int& R, int& C) { const int st = b / 1024, sb = b % 1024, swz = sb ^ (((sb >> 9) & 1) << 5); R = (st >> 1) * 16 + swz / 64; C = (st & 1) * 32 + (swz % 64) / 2; }
__host__ __device__ __forceinline__ int perm32(int rho) { const int n = rho >> 4, i = rho & 15; return 8 * (i >> 2) + 4 * n + (i & 3); }

struct Unit { int pm, pn, pb; };
struct Gemm { const bf16_t* A; const bf16_t* Bt; int M, N, K; };

__device__ __forceinline__ void tile_decode(int L, int nM, int nN, int& pm, int& pn) {
    const int nwg = nM * nN; int wgid = L;
    { const int q = nwg / NXCD, r = nwg % NXCD, xcd = wgid % NXCD, off = wgid / NXCD; wgid = (xcd < r ? xcd * (q + 1) : r * (q + 1) + (xcd - r) * q) + off; }
    const int nig = WGM * nN, gid = wgid / nig, fm = gid * WGM, gsz = (nM - fm) < WGM ? (nM - fm) : WGM;
    pm = fm + ((wgid % nig) % gsz); pn = (wgid % nig) / gsz;
}
__device__ __forceinline__ unsigned cvt_pk_bf16(float lo, float hi) { unsigned r; asm volatile("v_cvt_pk_bf16_f32 %0, %1, %2" : "=v"(r) : "v"(lo), "v"(hi)); return r; }
__device__ __forceinline__ u32x4 pack8(const f32x4 v0, const f32x4 v1) { u32x4 w; w.x = cvt_pk_bf16(v0[0], v0[1]); w.y = cvt_pk_bf16(v0[2], v0[3]); w.z = cvt_pk_bf16(v1[0], v1[1]); w.w = cvt_pk_bf16(v1[2], v1[3]); return w; }

template <class Epi, class Sched, bool ALIGN_EPI = false, bool SP2 = false>
__device__ __forceinline__ void gemm_phase(PG8_LAS unsigned char* lds, const Gemm g, const Sched& S, const Epi& E) {
    const int tid = threadIdx.x, wid = __builtin_amdgcn_readfirstlane(tid >> 6), lane = tid & 63, wr = wid >> 2, wc = wid & 3, fr = lane & 15, fq = lane >> 4;
    const int K = g.K, nt = K / BK;
    unsigned voffA[2], voffB[2];
#pragma unroll
    for (int i = 0; i < 2; ++i) { int R, C; stage_rc(tid * 16 + i * 8192, R, C); const int Rb = Epi::PERM ? ((R & ~31) + perm32(R & 31)) : R;
        voffA[i] = (unsigned)(R * K + C) * 2u; voffB[i] = (unsigned)(Rb * K + C) * 2u; }
    const size_t kstep = (size_t)(BK * 2);
    const size_t hstep = (size_t)HALF * K * 2;
    const size_t tstep = 2 * hstep;
    const unsigned ldsw = (unsigned)wid * 1024u;
    const int aoff = lds_byte(wr * 64 + fr, fq * 8), boff = lds_byte(wc * 32 + fr, fq * 8);
#define PG8_SA(b, h) (((b) * 2 + (h)) * HTB)
#define PG8_SB(b, h) ((4 + (b) * 2 + (h)) * HTB)
#define PG8_STAGE(bufoff, gbase, voff) do { _Pragma("unroll") for (int _i = 0; _i < 2; ++_i) \
        __builtin_amdgcn_global_load_lds((const unsigned*)((const char*)(gbase) + (voff)[_i]), (PG8_LAS unsigned*)(lds + (bufoff) + ldsw + _i * 8192), 16, 0, 0); } while (0)
#define PG8_LDA(dst, b, h) do { _Pragma("unroll") for (int m = 0; m < 4; ++m) _Pragma("unroll") for (int k = 0; k < 2; ++k) dst[m][k] = *(const PG8_LAS bf16x8*)(lds + PG8_SA(b, h) + aoff + m * 2048 + k * 1024); } while (0)
#define PG8_LDB(dst, b, h) do { _Pragma("unroll") for (int n = 0; n < 2; ++n) _Pragma("unroll") for (int k = 0; k < 2; ++k) dst[n][k] = *(const PG8_LAS bf16x8*)(lds + PG8_SB(b, h) + boff + n * 2048 + k * 1024); } while (0)
#define PG8_MMA(ai, bj, At, Bt) do { __builtin_amdgcn_s_setprio(1); _Pragma("unroll") for (int m = 0; m < 4; ++m) _Pragma("unroll") for (int n = 0; n < 2; ++n) _Pragma("unroll") for (int k = 0; k < 2; ++k) \
        acc[ai][bj][m][n] = __builtin_amdgcn_mfma_f32_16x16x32_bf16(Bt[n][k], At[m][k], acc[ai][bj][m][n], 0, 0, 0); __builtin_amdgcn_s_setprio(0); } while (0)
#define PG8_WAIT_V(n) asm volatile("s_waitcnt vmcnt(" #n ")" ::: "memory")
#define PG8_WAIT_L(n) asm volatile("s_waitcnt lgkmcnt(" #n ")" ::: "memory")
#define PG8_BAR __builtin_amdgcn_s_barrier()
#define PG8_SCHED __builtin_amdgcn_sched_barrier(0)
    Unit cur, nxt; int ui = 0;
    if (!S.next(0, cur)) return;
    f32x4 acc[2][2][4][2];
#pragma unroll
    for (int a = 0; a < 2; ++a)
#pragma unroll
        for (int b = 0; b < 2; ++b)
#pragma unroll
            for (int m = 0; m < 4; ++m)
#pragma unroll
                for (int n = 0; n < 2; ++n) acc[a][b][m][n] = (f32x4){0.f, 0.f, 0.f, 0.f};
    bf16x8 At[4][2], B0[2][2], B1[2][2];
    const char* cA = (const char*)g.A + (size_t)cur.pm * tstep; const char* cB = (const char*)g.Bt + (size_t)cur.pb * tstep;
    S.a_ready(cur);
    if constexpr (SP2) {
        PG8_STAGE(PG8_SB(0, 0), cB, voffB); PG8_STAGE(PG8_SB(0, 1), cB + hstep, voffB); PG8_STAGE(PG8_SA(0, 0), cA, voffA); PG8_STAGE(PG8_SA(0, 1), cA + hstep, voffA);
        if (wr == 1) PG8_BAR;
        PG8_WAIT_V(2); PG8_BAR;
        PG8_STAGE(PG8_SB(1, 0), cB + kstep, voffB); PG8_STAGE(PG8_SA(1, 0), cA + kstep, voffA); PG8_STAGE(PG8_SB(1, 1), cB + hstep + kstep, voffB);
        PG8_WAIT_V(6); PG8_BAR;
    } else {
        PG8_STAGE(PG8_SB(0, 0), cB, voffB); PG8_STAGE(PG8_SA(0, 0), cA, voffA); PG8_STAGE(PG8_SB(0, 1), cB + hstep, voffB); PG8_STAGE(PG8_SA(0, 1), cA + hstep, voffA);
        if (wr == 1) PG8_BAR;
        PG8_WAIT_V(4); PG8_BAR;
        PG8_STAGE(PG8_SB(1, 0), cB + kstep, voffB); PG8_STAGE(PG8_SA(1, 0), cA + kstep, voffA); PG8_STAGE(PG8_SB(1, 1), cB + hstep + kstep, voffB);
        PG8_WAIT_V(6); PG8_BAR;
    }
    for (;;) {
        const bool has_next = S.next(ui + 1, nxt);
        const char* nA = has_next ? (const char*)g.A + (size_t)nxt.pm * tstep : cA; const char* nB = has_next ? (const char*)g.Bt + (size_t)nxt.pb * tstep : cB;
        for (int t = 0; t < nt; t += 2) {
            const bool last = (t == nt - 2);
            const char* a1 = cA + (size_t)(t + 1) * kstep;
            const char* a2 = last ? nA : cA + (size_t)(t + 2) * kstep; const char* b2 = last ? nB : cB + (size_t)(t + 2) * kstep;
            const char* a3 = a2 + kstep; const char* b3 = b2 + kstep;
            if (last && has_next) S.a_ready(nxt);
            if constexpr (SP2) {
            PG8_LDB(B0, 0, 0); PG8_LDB(B1, 0, 1); PG8_SCHED; PG8_LDA(At, 0, 0); PG8_STAGE(PG8_SA(1, 1), a1 + hstep, voffA);
            PG8_WAIT_V(8); PG8_WAIT_L(0); PG8_BAR; PG8_MMA(0, 0, At, B0); PG8_MMA(0, 1, At, B1); PG8_BAR; PG8_SCHED;
            PG8_LDA(At, 0, 1); PG8_STAGE(PG8_SB(0, 0), b2, voffB); PG8_STAGE(PG8_SB(0, 1), b2 + hstep, voffB); PG8_STAGE(PG8_SA(0, 0), a2, voffA);
            PG8_WAIT_V(8); PG8_WAIT_L(0); PG8_BAR; PG8_MMA(1, 0, At, B0); PG8_MMA(1, 1, At, B1); PG8_BAR; PG8_SCHED;
            PG8_LDB(B0, 1, 0); PG8_LDB(B1, 1, 1); PG8_SCHED; PG8_LDA(At, 1, 0); PG8_STAGE(PG8_SA(0, 1), a2 + hstep, voffA);
            PG8_WAIT_V(8); PG8_WAIT_L(0); PG8_BAR; PG8_MMA(0, 0, At, B0); PG8_MMA(0, 1, At, B1); PG8_BAR; PG8_SCHED;
            PG8_LDA(At, 1, 1); PG8_STAGE(PG8_SB(1, 0), b3, voffB); PG8_STAGE(PG8_SB(1, 1), b3 + hstep, voffB); PG8_STAGE(PG8_SA(1, 0), a3, voffA);
            PG8_WAIT_V(8); PG8_WAIT_L(0); PG8_BAR; PG8_MMA(1, 0, At, B0); PG8_MMA(1, 1, At, B1); PG8_BAR; PG8_SCHED;
            } else {
            PG8_LDB(B0, 0, 0); PG8_SCHED; PG8_LDA(At, 0, 0); PG8_STAGE(PG8_SA(1, 1), a1 + hstep, voffA);
            PG8_WAIT_L(8); PG8_BAR; PG8_WAIT_L(0); PG8_MMA(0, 0, At, B0); PG8_BAR; PG8_SCHED;
            PG8_LDB(B1, 0, 1); PG8_STAGE(PG8_SB(0, 0), b2, voffB);
            PG8_BAR; PG8_WAIT_L(0); PG8_MMA(0, 1, At, B1); PG8_BAR;
            PG8_LDA(At, 0, 1); PG8_STAGE(PG8_SA(0, 0), a2, voffA);
            PG8_BAR; PG8_WAIT_L(0); PG8_MMA(1, 0, At, B0); PG8_BAR; PG8_SCHED;
            PG8_STAGE(PG8_SB(0, 1), b2 + hstep, voffB);
            PG8_WAIT_V(6); PG8_BAR; PG8_MMA(1, 1, At, B1); PG8_BAR;
            PG8_LDB(B0, 1, 0); PG8_SCHED; PG8_LDA(At, 1, 0); PG8_STAGE(PG8_SA(0, 1), a2 + hstep, voffA);
            PG8_WAIT_L(8); PG8_BAR; PG8_WAIT_L(0); PG8_MMA(0, 0, At, B0); PG8_BAR; PG8_SCHED;
            PG8_LDB(B1, 1, 1); PG8_STAGE(PG8_SB(1, 0), b3, voffB);
            PG8_BAR; PG8_WAIT_L(0); PG8_MMA(0, 1, At, B1); PG8_BAR;
            PG8_LDA(At, 1, 1); PG8_STAGE(PG8_SA(1, 0), a3, voffA);
            PG8_BAR; PG8_WAIT_L(0); PG8_MMA(1, 0, At, B0); PG8_BAR; PG8_SCHED;
            PG8_STAGE(PG8_SB(1, 1), b3 + hstep, voffB);
            PG8_WAIT_V(6); PG8_BAR; PG8_MMA(1, 1, At, B1); PG8_BAR;
            }
        }
        if constexpr (ALIGN_EPI) { if (wr == 0) PG8_BAR; }
        if constexpr (!Epi::AFTER_DRAIN) { E(acc, cur, wr, wc, fr, fq); S.done(cur); }
        if (!has_next) break;
#pragma unroll
        for (int a = 0; a < 2; ++a)
#pragma unroll
            for (int b = 0; b < 2; ++b)
#pragma unroll
                for (int m = 0; m < 4; ++m)
#pragma unroll
                    for (int n = 0; n < 2; ++n) acc[a][b][m][n] = (f32x4){0.f, 0.f, 0.f, 0.f};
        cur = nxt; cA = nA; cB = nB; ++ui;
        if constexpr (ALIGN_EPI) { if (wr == 1) PG8_BAR; }
    }
    PG8_WAIT_V(0);
    if constexpr (!ALIGN_EPI) { if (wr == 0) PG8_BAR; }
    PG8_BAR;
    if constexpr (Epi::AFTER_DRAIN) { E.fused(acc, cur, wr, wc, fr, fq, lds, wid, lane); S.done(cur); }
#undef PG8_SA
#undef PG8_SB
#undef PG8_STAGE
#undef PG8_LDA
#undef PG8_LDB
#undef PG8_MMA
#undef PG8_WAIT_V
#undef PG8_WAIT_L
#undef PG8_BAR
#undef PG8_SCHED
}
typedef int v4i __attribute__((ext_vector_type(4)));
typedef int v8i __attribute__((ext_vector_type(8)));
template <class Epi, class Sched, bool ALIGN_EPI = false, bool SP2 = false>
__device__ __forceinline__ void gemm_phase8(PG8_LAS unsigned char* lds, const Gemm g, const Sched& S, const Epi& E) {
    const int tid = threadIdx.x, wid = __builtin_amdgcn_readfirstlane(tid >> 6), lane = tid & 63, wr = wid >> 2, wc = wid & 3, fr = lane & 15, fq = lane >> 4;
    const int K = g.K, nt = K / BK;
    unsigned voffA[2], voffB[2];
#pragma unroll
    for (int i = 0; i < 2; ++i) { int R, C; stage_rc(tid * 16 + i * 8192, R, C); const int Rb = Epi::PERM ? ((R & ~31) + perm32(R & 31)) : R;
        voffA[i] = (unsigned)(R * K + C) * 2u; voffB[i] = (unsigned)(Rb * K + C) * 2u; }
    const size_t kstep = (size_t)(BK * 2);
    const size_t hstep = (size_t)HALF * K * 2;
    const size_t tstep = 2 * hstep;
    const unsigned ldsw = (unsigned)wid * 1024u;
    const int aoff = lds_byte(wr * 64 + fr, fq * 8), boff = lds_byte(wc * 32 + fr, fq * 8);
#define PG8_SA(b, h) (((b) * 2 + (h)) * HTB)
#define PG8_SB(b, h) ((4 + (b) * 2 + (h)) * HTB)
#define PG8_STAGE(bufoff, gbase, voff) do { _Pragma("unroll") for (int _i = 0; _i < 2; ++_i) \
        __builtin_amdgcn_global_load_lds((const unsigned*)((const char*)(gbase) + (voff)[_i]), (PG8_LAS unsigned*)(lds + (bufoff) + ldsw + _i * 8192), 16, 0, 0); } while (0)
#define PG8_LDA(dst, b, h) do { _Pragma("unroll") for (int m = 0; m < 4; ++m) { const v4i lo_ = *(const PG8_LAS v4i*)(lds + PG8_SA(b, h) + aoff + m * 2048), hi_ = *(const PG8_LAS v4i*)(lds + PG8_SA(b, h) + aoff + m * 2048 + 1024); dst[m] = __builtin_shufflevector(lo_, hi_, 0, 1, 2, 3, 4, 5, 6, 7); } } while (0)
#define PG8_LDB(dst, b, h) do { _Pragma("unroll") for (int n = 0; n < 2; ++n) { const v4i lo_ = *(const PG8_LAS v4i*)(lds + PG8_SB(b, h) + boff + n * 2048), hi_ = *(const PG8_LAS v4i*)(lds + PG8_SB(b, h) + boff + n * 2048 + 1024); dst[n] = __builtin_shufflevector(lo_, hi_, 0, 1, 2, 3, 4, 5, 6, 7); } } while (0)
#define PG8_MMA(ai, bj, At, Bt) do { __builtin_amdgcn_s_setprio(1); _Pragma("unroll") for (int m = 0; m < 4; ++m) _Pragma("unroll") for (int n = 0; n < 2; ++n) \
        asm volatile("v_mfma_f32_16x16x128_f8f6f4 %0, %1, %2, %0" : "+v"(acc[ai][bj][m][n]) : "v"(Bt[n]), "v"(At[m])); __builtin_amdgcn_s_setprio(0); } while (0)
#define PG8_WAIT_V(n) asm volatile("s_waitcnt vmcnt(" #n ")" ::: "memory")
#define PG8_WAIT_L(n) asm volatile("s_waitcnt lgkmcnt(" #n ")" ::: "memory")
#define PG8_BAR __builtin_amdgcn_s_barrier()
#define PG8_SCHED __builtin_amdgcn_sched_barrier(0)
    Unit cur, nxt; int ui = 0;
    if (!S.next(0, cur)) return;
    f32x4 acc[2][2][4][2];
#pragma unroll
    for (int a = 0; a < 2; ++a)
#pragma unroll
        for (int b = 0; b < 2; ++b)
#pragma unroll
            for (int m = 0; m < 4; ++m)
#pragma unroll
                for (int n = 0; n < 2; ++n) acc[a][b][m][n] = (f32x4){0.f, 0.f, 0.f, 0.f};
    v8i At[4], B0[2], B1[2];
    const char* cA = (const char*)g.A + (size_t)cur.pm * tstep; const char* cB = (const char*)g.Bt + (size_t)cur.pb * tstep;
    S.a_ready(cur);
    if constexpr (SP2) {
        PG8_STAGE(PG8_SB(0, 0), cB, voffB); PG8_STAGE(PG8_SB(0, 1), cB + hstep, voffB); PG8_STAGE(PG8_SA(0, 0), cA, voffA); PG8_STAGE(PG8_SA(0, 1), cA + hstep, voffA);
        if (wr == 1) PG8_BAR;
        PG8_WAIT_V(2); PG8_BAR;
        PG8_STAGE(PG8_SB(1, 0), cB + kstep, voffB); PG8_STAGE(PG8_SA(1, 0), cA + kstep, voffA); PG8_STAGE(PG8_SB(1, 1), cB + hstep + kstep, voffB);
        PG8_WAIT_V(6); PG8_BAR;
    } else {
        PG8_STAGE(PG8_SB(0, 0), cB, voffB); PG8_STAGE(PG8_SA(0, 0), cA, voffA); PG8_STAGE(PG8_SB(0, 1), cB + hstep, voffB); PG8_STAGE(PG8_SA(0, 1), cA + hstep, voffA);
        if (wr == 1) PG8_BAR;
        PG8_WAIT_V(4); PG8_BAR;
        PG8_STAGE(PG8_SB(1, 0), cB + kstep, voffB); PG8_STAGE(PG8_SA(1, 0), cA + kstep, voffA); PG8_STAGE(PG8_SB(1, 1), cB + hstep + kstep, voffB);
        PG8_WAIT_V(6); PG8_BAR;
    }
    for (;;) {
        const bool has_next = S.next(ui + 1, nxt);
        const char* nA = has_next ? (const char*)g.A + (size_t)nxt.pm * tstep : cA; const char* nB = has_next ? (const char*)g.Bt + (size_t)nxt.pb * tstep : cB;
#pragma unroll 1
        for (int t = 0; t < nt; t += 2) {
            const bool last = (t == nt - 2);
            const char* a1 = cA + (size_t)(t + 1) * kstep;
            const char* a2 = last ? nA : cA + (size_t)(t + 2) * kstep; const char* b2 = last ? nB : cB + (size_t)(t + 2) * kstep;
            const char* a3 = a2 + kstep; const char* b3 = b2 + kstep;
            if (last && has_next) S.a_ready(nxt);
            if constexpr (SP2) {
            PG8_LDB(B0, 0, 0); PG8_LDB(B1, 0, 1); PG8_SCHED; PG8_LDA(At, 0, 0); PG8_STAGE(PG8_SA(1, 1), a1 + hstep, voffA);
            PG8_WAIT_V(8); PG8_WAIT_L(0); PG8_BAR; PG8_MMA(0, 0, At, B0); PG8_MMA(0, 1, At, B1); PG8_BAR; PG8_SCHED;
            PG8_LDA(At, 0, 1); PG8_STAGE(PG8_SB(0, 0), b2, voffB); PG8_STAGE(PG8_SB(0, 1), b2 + hstep, voffB); PG8_STAGE(PG8_SA(0, 0), a2, voffA);
            PG8_WAIT_V(8); PG8_WAIT_L(0); PG8_BAR; PG8_MMA(1, 0, At, B0); PG8_MMA(1, 1, At, B1); PG8_BAR; PG8_SCHED;
            PG8_LDB(B0, 1, 0); PG8_LDB(B1, 1, 1); PG8_SCHED; PG8_LDA(At, 1, 0); PG8_STAGE(PG8_SA(0, 1), a2 + hstep, voffA);
            PG8_WAIT_V(8); PG8_WAIT_L(0); PG8_BAR; PG8_MMA(0, 0, At, B0); PG8_MMA(0, 1, At, B1); PG8_BAR; PG8_SCHED;
            PG8_LDA(At, 1, 1); PG8_STAGE(PG8_SB(1, 0), b3, voffB); PG8_STAGE(PG8_SB(1, 1), b3 + hstep, voffB); PG8_STAGE(PG8_SA(1, 0), a3, voffA);
            PG8_WAIT_V(8); PG8_WAIT_L(0); PG8_BAR; PG8_MMA(1, 0, At, B0); PG8_MMA(1, 1, At, B1); PG8_BAR; PG8_SCHED;
            } else {
            PG8_LDB(B0, 0, 0); PG8_SCHED; PG8_LDA(At, 0, 0); PG8_STAGE(PG8_SA(1, 1), a1 + hstep, voffA);
            PG8_WAIT_L(8); PG8_BAR; PG8_WAIT_L(0); PG8_MMA(0, 0, At, B0); PG8_BAR; PG8_SCHED;
            PG8_LDB(B1, 0, 1); PG8_STAGE(PG8_SB(0, 0), b2, voffB);
            PG8_BAR; PG8_WAIT_L(0); PG8_MMA(0, 1, At, B1); PG8_BAR;
            PG8_LDA(At, 0, 1); PG8_STAGE(PG8_SA(0, 0), a2, voffA);
            PG8_BAR; PG8_WAIT_L(0); PG8_MMA(1, 0, At, B0); PG8_BAR; PG8_SCHED;
            PG8_STAGE(PG8_SB(0, 1), b2 + hstep, voffB);
            PG8_WAIT_V(6); PG8_BAR; PG8_MMA(1, 1, At, B1); PG8_BAR;
            PG8_LDB(B0, 1, 0); PG8_SCHED; PG8_LDA(At, 1, 0); PG8_STAGE(PG8_SA(0, 1), a2 + hstep, voffA);
            PG8_WAIT_L(8); PG8_BAR; PG8_WAIT_L(0); PG8_MMA(0, 0, At, B0); PG8_BAR; PG8_SCHED;
            PG8_LDB(B1, 1, 1); PG8_STAGE(PG8_SB(1, 0), b3, voffB);
            PG8_BAR; PG8_WAIT_L(0); PG8_MMA(0, 1, At, B1); PG8_BAR;
            PG8_LDA(At, 1, 1); PG8_STAGE(PG8_SA(1, 0), a3, voffA);
            PG8_BAR; PG8_WAIT_L(0); PG8_MMA(1, 0, At, B0); PG8_BAR; PG8_SCHED;
            PG8_STAGE(PG8_SB(1, 1), b3 + hstep, voffB);
            PG8_WAIT_V(6); PG8_BAR; PG8_MMA(1, 1, At, B1); PG8_BAR;
            }
        }
        if constexpr (ALIGN_EPI) { if (wr == 0) PG8_BAR; }
        asm volatile("s_nop 15\n\ts_nop 15" ::: "memory");
        if constexpr (!Epi::AFTER_DRAIN) { E(acc, cur, wr, wc, fr, fq); S.done(cur); }
        if (!has_next) break;
#pragma unroll
        for (int a = 0; a < 2; ++a)
#pragma unroll
            for (int b = 0; b < 2; ++b)
#pragma unroll
                for (int m = 0; m < 4; ++m)
#pragma unroll
                    for (int n = 0; n < 2; ++n) acc[a][b][m][n] = (f32x4){0.f, 0.f, 0.f, 0.f};
        cur = nxt; cA = nA; cB = nB; ++ui;
        if constexpr (ALIGN_EPI) { if (wr == 1) PG8_BAR; }
    }
    PG8_WAIT_V(0);
    if constexpr (!ALIGN_EPI) { if (wr == 0) PG8_BAR; }
    PG8_BAR;
    if constexpr (Epi::AFTER_DRAIN) { E.fused(acc, cur, wr, wc, fr, fq, lds, wid, lane); S.done(cur); }
#undef PG8_SA
#undef PG8_SB
#undef PG8_STAGE
#undef PG8_LDA
#undef PG8_LDB
#undef PG8_MMA
#undef PG8_WAIT_V
#undef PG8_WAIT_L
#undef PG8_BAR
#undef PG8_SCHED
}
template <class Epi, class Sched, bool ALIGN_EPI = false, bool SP2 = false>
__device__ __forceinline__ void gemm_phase8g(PG8_LAS unsigned char* lds, const Gemm g, const Sched& S, const Epi& E, const int* __restrict__ ridx) {
    const int tid = threadIdx.x, wid = __builtin_amdgcn_readfirstlane(tid >> 6), lane = tid & 63, wr = wid >> 2, wc = wid & 3, fr = lane & 15, fq = lane >> 4;
    const int K = g.K, nt = K / BK;
    unsigned voffB[2]; int arow[2]; unsigned acol[2];
#pragma unroll
    for (int i = 0; i < 2; ++i) { int R, C; stage_rc(tid * 16 + i * 8192, R, C); const int Rb = Epi::PERM ? ((R & ~31) + perm32(R & 31)) : R;
        arow[i] = R; acol[i] = (unsigned)C * 2u; voffB[i] = (unsigned)(Rb * K + C) * 2u; }
    constexpr int IDXB_OFF = STAGE_BYTES;
    unsigned offc[2][2], offn[2][2];
#define PG8_LDIDX(dst, pm_) do { _Pragma("unroll") for (int h_ = 0; h_ < 2; ++h_) _Pragma("unroll") for (int i_ = 0; i_ < 2; ++i_) \
        dst[h_][i_] = (unsigned)ridx[(pm_) * BM + h_ * HALF + arow[i_]] * (unsigned)(K * 2) + acol[i_]; } while (0)
#define PG8_STAGE_G(bufoff, gbase, off2) do { _Pragma("unroll") for (int _i = 0; _i < 2; ++_i) \
        __builtin_amdgcn_global_load_lds((const unsigned*)((const char*)(gbase) + (off2)[_i]), (PG8_LAS unsigned*)(lds + (bufoff) + ldsw + _i * 8192), 16, 0, 0); } while (0)
    const size_t kstep = (size_t)(BK * 2);
    const size_t hstep = (size_t)HALF * K * 2;
    const size_t tstep = 2 * hstep;
    const unsigned ldsw = (unsigned)wid * 1024u;
    const int aoff = lds_byte(wr * 64 + fr, fq * 8), boff = lds_byte(wc * 32 + fr, fq * 8);
#define PG8_SA(b, h) (((b) * 2 + (h)) * HTB)
#define PG8_SB(b, h) ((4 + (b) * 2 + (h)) * HTB)
#define PG8_STAGE(bufoff, gbase, voff) do { _Pragma("unroll") for (int _i = 0; _i < 2; ++_i) \
        __builtin_amdgcn_global_load_lds((const unsigned*)((const char*)(gbase) + (voff)[_i]), (PG8_LAS unsigned*)(lds + (bufoff) + ldsw + _i * 8192), 16, 0, 0); } while (0)
#define PG8_LDA(dst, b, h) do { _Pragma("unroll") for (int m = 0; m < 4; ++m) { const v4i lo_ = *(const PG8_LAS v4i*)(lds + PG8_SA(b, h) + aoff + m * 2048), hi_ = *(const PG8_LAS v4i*)(lds + PG8_SA(b, h) + aoff + m * 2048 + 1024); dst[m] = __builtin_shufflevector(lo_, hi_, 0, 1, 2, 3, 4, 5, 6, 7); } } while (0)
#define PG8_LDB(dst, b, h) do { _Pragma("unroll") for (int n = 0; n < 2; ++n) { const v4i lo_ = *(const PG8_LAS v4i*)(lds + PG8_SB(b, h) + boff + n * 2048), hi_ = *(const PG8_LAS v4i*)(lds + PG8_SB(b, h) + boff + n * 2048 + 1024); dst[n] = __builtin_shufflevector(lo_, hi_, 0, 1, 2, 3, 4, 5, 6, 7); } } while (0)
#define PG8_MMA(ai, bj, At, Bt) do { __builtin_amdgcn_s_setprio(1); _Pragma("unroll") for (int m = 0; m < 4; ++m) _Pragma("unroll") for (int n = 0; n < 2; ++n) \
        asm volatile("v_mfma_f32_16x16x128_f8f6f4 %0, %1, %2, %0" : "+v"(acc[ai][bj][m][n]) : "v"(Bt[n]), "v"(At[m])); __builtin_amdgcn_s_setprio(0); } while (0)
#define PG8_WAIT_V(n) asm volatile("s_waitcnt vmcnt(" #n ")" ::: "memory")
#define PG8_WAIT_L(n) asm volatile("s_waitcnt lgkmcnt(" #n ")" ::: "memory")
#define PG8_BAR __builtin_amdgcn_s_barrier()
#define PG8_SCHED __builtin_amdgcn_sched_barrier(0)
    Unit cur, nxt; int ui = 0;
    if (!S.next(0, cur)) return;
    f32x4 acc[2][2][4][2];
#pragma unroll
    for (int a = 0; a < 2; ++a)
#pragma unroll
        for (int b = 0; b < 2; ++b)
#pragma unroll
            for (int m = 0; m < 4; ++m)
#pragma unroll
                for (int n = 0; n < 2; ++n) acc[a][b][m][n] = (f32x4){0.f, 0.f, 0.f, 0.f};
    v8i At[4], B0[2], B1[2];
    const char* gA0 = (const char*)g.A; const char* cB = (const char*)g.Bt + (size_t)cur.pb * tstep; PG8_LDIDX(offc, cur.pm);
    S.a_ready(cur);
    if constexpr (SP2) {
        PG8_STAGE(PG8_SB(0, 0), cB, voffB); PG8_STAGE(PG8_SB(0, 1), cB + hstep, voffB); PG8_STAGE_G(PG8_SA(0, 0), gA0, offc[0]); PG8_STAGE_G(PG8_SA(0, 1), gA0, offc[1]);
        if (wr == 1) PG8_BAR;
        PG8_WAIT_V(2); PG8_BAR;
        PG8_STAGE(PG8_SB(1, 0), cB + kstep, voffB); PG8_STAGE_G(PG8_SA(1, 0), gA0 + kstep, offc[0]); PG8_STAGE(PG8_SB(1, 1), cB + hstep + kstep, voffB);
        PG8_WAIT_V(6); PG8_BAR;
    } else {
        PG8_STAGE(PG8_SB(0, 0), cB, voffB); PG8_STAGE_G(PG8_SA(0, 0), gA0, offc[0]); PG8_STAGE(PG8_SB(0, 1), cB + hstep, voffB); PG8_STAGE_G(PG8_SA(0, 1), gA0, offc[1]);
        if (wr == 1) PG8_BAR;
        PG8_WAIT_V(4); PG8_BAR;
        PG8_STAGE(PG8_SB(1, 0), cB + kstep, voffB); PG8_STAGE_G(PG8_SA(1, 0), gA0 + kstep, offc[0]); PG8_STAGE(PG8_SB(1, 1), cB + hstep + kstep, voffB);
        PG8_WAIT_V(6); PG8_BAR;
    }
    for (;;) {
        const bool has_next = S.next(ui + 1, nxt);
        const char* nB = has_next ? (const char*)g.Bt + (size_t)nxt.pb * tstep : cB;
        if (!has_next) {
#pragma unroll
            for (int h_ = 0; h_ < 2; ++h_) { offn[h_][0] = offc[h_][0]; offn[h_][1] = offc[h_][1]; } }
#pragma unroll 1
        for (int t = 0; t < nt; t += 2) {
            const bool last = (t == nt - 2);
            if (has_next && t == nt - 4 && wid == 0)
                __builtin_amdgcn_global_load_lds((const unsigned*)(ridx + nxt.pm * BM + lane * 4), (PG8_LAS unsigned*)(lds + IDXB_OFF + ((ui + 1) & 1) * 1024), 16, 0, 0);
            if (has_next && last) {
                const PG8_LAS int* ib = (const PG8_LAS int*)(lds + IDXB_OFF + ((ui + 1) & 1) * 1024);
#pragma unroll
                for (int h_ = 0; h_ < 2; ++h_)
#pragma unroll
                    for (int i_ = 0; i_ < 2; ++i_) offn[h_][i_] = (unsigned)ib[h_ * HALF + arow[i_]] * (unsigned)(K * 2) + acol[i_]; }
            const char* a1 = gA0 + (size_t)(t + 1) * kstep;
            const char* a2 = last ? gA0 : gA0 + (size_t)(t + 2) * kstep; const char* b2 = last ? nB : cB + (size_t)(t + 2) * kstep;
            const char* a3 = a2 + kstep; const char* b3 = b2 + kstep;
            unsigned o2[2][2];
#pragma unroll
            for (int h_ = 0; h_ < 2; ++h_) { o2[h_][0] = last ? offn[h_][0] : offc[h_][0]; o2[h_][1] = last ? offn[h_][1] : offc[h_][1]; }
            if (last && has_next) S.a_ready(nxt);
            if constexpr (SP2) {
            PG8_LDB(B0, 0, 0); PG8_LDB(B1, 0, 1); PG8_SCHED; PG8_LDA(At, 0, 0); PG8_STAGE_G(PG8_SA(1, 1), a1, offc[1]);
            PG8_WAIT_V(8); PG8_WAIT_L(0); PG8_BAR; PG8_MMA(0, 0, At, B0); PG8_MMA(0, 1, At, B1); PG8_BAR; PG8_SCHED;
            PG8_LDA(At, 0, 1); PG8_STAGE(PG8_SB(0, 0), b2, voffB); PG8_STAGE(PG8_SB(0, 1), b2 + hstep, voffB); PG8_STAGE_G(PG8_SA(0, 0), a2, o2[0]);
            PG8_WAIT_V(8); PG8_WAIT_L(0); PG8_BAR; PG8_MMA(1, 0, At, B0); PG8_MMA(1, 1, At, B1); PG8_BAR; PG8_SCHED;
            PG8_LDB(B0, 1, 0); PG8_LDB(B1, 1, 1); PG8_SCHED; PG8_LDA(At, 1, 0); PG8_STAGE_G(PG8_SA(0, 1), a2, o2[1]);
            PG8_WAIT_V(8); PG8_WAIT_L(0); PG8_BAR; PG8_MMA(0, 0, At, B0); PG8_MMA(0, 1, At, B1); PG8_BAR; PG8_SCHED;
            PG8_LDA(At, 1, 1); PG8_STAGE(PG8_SB(1, 0), b3, voffB); PG8_STAGE(PG8_SB(1, 1), b3 + hstep, voffB); PG8_STAGE_G(PG8_SA(1, 0), a3, o2[0]);
            PG8_WAIT_V(8); PG8_WAIT_L(0); PG8_BAR; PG8_MMA(1, 0, At, B0); PG8_MMA(1, 1, At, B1); PG8_BAR; PG8_SCHED;
            } else {
            PG8_LDB(B0, 0, 0); PG8_SCHED; PG8_LDA(At, 0, 0); PG8_STAGE_G(PG8_SA(1, 1), a1, offc[1]);
            PG8_WAIT_L(8); PG8_BAR; PG8_WAIT_L(0); PG8_MMA(0, 0, At, B0); PG8_BAR; PG8_SCHED;
            PG8_LDB(B1, 0, 1); PG8_STAGE(PG8_SB(0, 0), b2, voffB);
            PG8_BAR; PG8_WAIT_L(0); PG8_MMA(0, 1, At, B1); PG8_BAR;
            PG8_LDA(At, 0, 1); PG8_STAGE_G(PG8_SA(0, 0), a2, o2[0]);
            PG8_BAR; PG8_WAIT_L(0); PG8_MMA(1, 0, At, B0); PG8_BAR; PG8_SCHED;
            PG8_STAGE(PG8_SB(0, 1), b2 + hstep, voffB);
            PG8_WAIT_V(6); PG8_BAR; PG8_MMA(1, 1, At, B1); PG8_BAR;
            PG8_LDB(B0, 1, 0); PG8_SCHED; PG8_LDA(At, 1, 0); PG8_STAGE_G(PG8_SA(0, 1), a2, o2[1]);
            PG8_WAIT_L(8); PG8_BAR; PG8_WAIT_L(0); PG8_MMA(0, 0, At, B0); PG8_BAR; PG8_SCHED;
            PG8_LDB(B1, 1, 1); PG8_STAGE(PG8_SB(1, 0), b3, voffB);
            PG8_BAR; PG8_WAIT_L(0); PG8_MMA(0, 1, At, B1); PG8_BAR;
            PG8_LDA(At, 1, 1); PG8_STAGE_G(PG8_SA(1, 0), a3, o2[0]);
            PG8_BAR; PG8_WAIT_L(0); PG8_MMA(1, 0, At, B0); PG8_BAR; PG8_SCHED;
            PG8_STAGE(PG8_SB(1, 1), b3 + hstep, voffB);
            PG8_WAIT_V(6); PG8_BAR; PG8_MMA(1, 1, At, B1); PG8_BAR;
            }
        }
        if constexpr (ALIGN_EPI) { if (wr == 0) PG8_BAR; }
        asm volatile("s_nop 15\n\ts_nop 15" ::: "memory");
        if constexpr (!Epi::AFTER_DRAIN) { E(acc, cur, wr, wc, fr, fq); S.done(cur); }
        if (!has_next) break;
#pragma unroll
        for (int a = 0; a < 2; ++a)
#pragma unroll
            for (int b = 0; b < 2; ++b)
#pragma unroll
                for (int m = 0; m < 4; ++m)
#pragma unroll
                    for (int n = 0; n < 2; ++n) acc[a][b][m][n] = (f32x4){0.f, 0.f, 0.f, 0.f};
        cur = nxt; cB = nB; ++ui;
#pragma unroll
        for (int h_ = 0; h_ < 2; ++h_) { offc[h_][0] = offn[h_][0]; offc[h_][1] = offn[h_][1]; }
        if constexpr (ALIGN_EPI) { if (wr == 1) PG8_BAR; }
    }
    PG8_WAIT_V(0);
    if constexpr (!ALIGN_EPI) { if (wr == 0) PG8_BAR; }
    PG8_BAR;
    if constexpr (Epi::AFTER_DRAIN) { E.fused(acc, cur, wr, wc, fr, fq, lds, wid, lane); S.done(cur); }
#undef PG8_SA
#undef PG8_SB
#undef PG8_STAGE
#undef PG8_STAGE_G
#undef PG8_LDIDX
#undef PG8_LDA
#undef PG8_LDB
#undef PG8_MMA
#undef PG8_WAIT_V
#undef PG8_WAIT_L
#undef PG8_BAR
#undef PG8_SCHED
}
template <class Epi, class Sched, bool ALIGN_EPI = false, bool SP2 = false>
__device__ __forceinline__ void gemm_phase_i8(PG8_LAS unsigned char* lds, const Gemm g, const Sched& S, const Epi& E, const float* __restrict__ rowscale) {
    const int tid = threadIdx.x, wid = __builtin_amdgcn_readfirstlane(tid >> 6), lane = tid & 63, wr = wid >> 2, wc = wid & 3, fr = lane & 15, fq = lane >> 4;
    const int K = g.K, nt = K / BK;
    unsigned voffA[2], voffB[2];
#pragma unroll
    for (int i = 0; i < 2; ++i) { int R, C; stage_rc(tid * 16 + i * 8192, R, C); const int Rb = Epi::PERM ? ((R & ~31) + perm32(R & 31)) : R;
        voffA[i] = (unsigned)(R * K + C) * 2u; voffB[i] = (unsigned)(Rb * K + C) * 2u; }
    const size_t kstep = (size_t)(BK * 2);
    const size_t hstep = (size_t)HALF * K * 2;
    const size_t tstep = 2 * hstep;
    const unsigned ldsw = (unsigned)wid * 1024u;
    const int aoff = lds_byte(wr * 64 + fr, fq * 8), boff = lds_byte(wc * 32 + fr, fq * 8);
#define PG8_SA(b, h) (((b) * 2 + (h)) * HTB)
#define PG8_SB(b, h) ((4 + (b) * 2 + (h)) * HTB)
#define PG8_STAGE(bufoff, gbase, voff) do { _Pragma("unroll") for (int _i = 0; _i < 2; ++_i) \
        __builtin_amdgcn_global_load_lds((const unsigned*)((const char*)(gbase) + (voff)[_i]), (PG8_LAS unsigned*)(lds + (bufoff) + ldsw + _i * 8192), 16, 0, 0); } while (0)
#define PG8_LDA(dst, b, h) do { _Pragma("unroll") for (int m = 0; m < 4; ++m) _Pragma("unroll") for (int k = 0; k < 2; ++k) dst[m][k] = *(const PG8_LAS bf16x8*)(lds + PG8_SA(b, h) + aoff + m * 2048 + k * 1024); } while (0)
#define PG8_LDB(dst, b, h) do { _Pragma("unroll") for (int n = 0; n < 2; ++n) _Pragma("unroll") for (int k = 0; k < 2; ++k) dst[n][k] = *(const PG8_LAS bf16x8*)(lds + PG8_SB(b, h) + boff + n * 2048 + k * 1024); } while (0)
#define PG8_MMA(ai, bj, At, Bt) do { __builtin_amdgcn_s_setprio(1); _Pragma("unroll") for (int m = 0; m < 4; ++m) _Pragma("unroll") for (int n = 0; n < 2; ++n) _Pragma("unroll") for (int k = 0; k < 2; ++k) \
        acc[ai][bj][m][n] = __builtin_bit_cast(f32x4, __builtin_amdgcn_mfma_i32_16x16x64_i8(__builtin_bit_cast(v4i, Bt[n][k]), __builtin_bit_cast(v4i, At[m][k]), __builtin_bit_cast(v4i, acc[ai][bj][m][n]), 0, 0, 0)); __builtin_amdgcn_s_setprio(0); } while (0)
#define PG8_WAIT_V(n) asm volatile("s_waitcnt vmcnt(" #n ")" ::: "memory")
#define PG8_WAIT_L(n) asm volatile("s_waitcnt lgkmcnt(" #n ")" ::: "memory")
#define PG8_BAR __builtin_amdgcn_s_barrier()
#define PG8_SCHED __builtin_amdgcn_sched_barrier(0)
    Unit cur, nxt; int ui = 0;
    if (!S.next(0, cur)) return;
    f32x4 acc[2][2][4][2];
#pragma unroll
    for (int a = 0; a < 2; ++a)
#pragma unroll
        for (int b = 0; b < 2; ++b)
#pragma unroll
            for (int m = 0; m < 4; ++m)
#pragma unroll
                for (int n = 0; n < 2; ++n) acc[a][b][m][n] = (f32x4){0.f, 0.f, 0.f, 0.f};
    bf16x8 At[4][2], B0[2][2], B1[2][2];
    const char* cA = (const char*)g.A + (size_t)cur.pm * tstep; const char* cB = (const char*)g.Bt + (size_t)cur.pb * tstep;
    constexpr int SCB_OFF = STAGE_BYTES + 2048;
    if (wid == 0) __builtin_amdgcn_global_load_lds((const unsigned*)(rowscale + cur.pm * BM + lane * 4), (PG8_LAS unsigned*)(lds + SCB_OFF), 16, 0, 0);
    S.a_ready(cur);
    if constexpr (SP2) {
        PG8_STAGE(PG8_SB(0, 0), cB, voffB); PG8_STAGE(PG8_SB(0, 1), cB + hstep, voffB); PG8_STAGE(PG8_SA(0, 0), cA, voffA); PG8_STAGE(PG8_SA(0, 1), cA + hstep, voffA);
        if (wr == 1) PG8_BAR;
        PG8_WAIT_V(2); PG8_BAR;
        PG8_STAGE(PG8_SB(1, 0), cB + kstep, voffB); PG8_STAGE(PG8_SA(1, 0), cA + kstep, voffA); PG8_STAGE(PG8_SB(1, 1), cB + hstep + kstep, voffB);
        PG8_WAIT_V(6); PG8_BAR;
    } else {
        PG8_STAGE(PG8_SB(0, 0), cB, voffB); PG8_STAGE(PG8_SA(0, 0), cA, voffA); PG8_STAGE(PG8_SB(0, 1), cB + hstep, voffB); PG8_STAGE(PG8_SA(0, 1), cA + hstep, voffA);
        if (wr == 1) PG8_BAR;
        PG8_WAIT_V(4); PG8_BAR;
        PG8_STAGE(PG8_SB(1, 0), cB + kstep, voffB); PG8_STAGE(PG8_SA(1, 0), cA + kstep, voffA); PG8_STAGE(PG8_SB(1, 1), cB + hstep + kstep, voffB);
        PG8_WAIT_V(6); PG8_BAR;
    }
    for (;;) {
        const bool has_next = S.next(ui + 1, nxt);
        const char* nA = has_next ? (const char*)g.A + (size_t)nxt.pm * tstep : cA; const char* nB = has_next ? (const char*)g.Bt + (size_t)nxt.pb * tstep : cB;
#pragma unroll 1
        for (int t = 0; t < nt; t += 2) {
            const bool last = (t == nt - 2);
            if (has_next && t == nt - 4 && wid == 0)
                __builtin_amdgcn_global_load_lds((const unsigned*)(rowscale + nxt.pm * BM + lane * 4), (PG8_LAS unsigned*)(lds + SCB_OFF + ((ui + 1) & 1) * 1024), 16, 0, 0);
            const char* a1 = cA + (size_t)(t + 1) * kstep;
            const char* a2 = last ? nA : cA + (size_t)(t + 2) * kstep; const char* b2 = last ? nB : cB + (size_t)(t + 2) * kstep;
            const char* a3 = a2 + kstep; const char* b3 = b2 + kstep;
            if (last && has_next) S.a_ready(nxt);
            if constexpr (SP2) {
            PG8_LDB(B0, 0, 0); PG8_LDB(B1, 0, 1); PG8_SCHED; PG8_LDA(At, 0, 0); PG8_STAGE(PG8_SA(1, 1), a1 + hstep, voffA);
            PG8_WAIT_V(8); PG8_WAIT_L(0); PG8_BAR; PG8_MMA(0, 0, At, B0); PG8_MMA(0, 1, At, B1); PG8_BAR; PG8_SCHED;
            PG8_LDA(At, 0, 1); PG8_STAGE(PG8_SB(0, 0), b2, voffB); PG8_STAGE(PG8_SB(0, 1), b2 + hstep, voffB); PG8_STAGE(PG8_SA(0, 0), a2, voffA);
            PG8_WAIT_V(8); PG8_WAIT_L(0); PG8_BAR; PG8_MMA(1, 0, At, B0); PG8_MMA(1, 1, At, B1); PG8_BAR; PG8_SCHED;
            PG8_LDB(B0, 1, 0); PG8_LDB(B1, 1, 1); PG8_SCHED; PG8_LDA(At, 1, 0); PG8_STAGE(PG8_SA(0, 1), a2 + hstep, voffA);
            PG8_WAIT_V(8); PG8_WAIT_L(0); PG8_BAR; PG8_MMA(0, 0, At, B0); PG8_MMA(0, 1, At, B1); PG8_BAR; PG8_SCHED;
            PG8_LDA(At, 1, 1); PG8_STAGE(PG8_SB(1, 0), b3, voffB); PG8_STAGE(PG8_SB(1, 1), b3 + hstep, voffB); PG8_STAGE(PG8_SA(1, 0), a3, voffA);
            PG8_WAIT_V(8); PG8_WAIT_L(0); PG8_BAR; PG8_MMA(1, 0, At, B0); PG8_MMA(1, 1, At, B1); PG8_BAR; PG8_SCHED;
            } else {
            PG8_LDB(B0, 0, 0); PG8_SCHED; PG8_LDA(At, 0, 0); PG8_STAGE(PG8_SA(1, 1), a1 + hstep, voffA);
            PG8_WAIT_L(8); PG8_BAR; PG8_WAIT_L(0); PG8_MMA(0, 0, At, B0); PG8_BAR; PG8_SCHED;
            PG8_LDB(B1, 0, 1); PG8_STAGE(PG8_SB(0, 0), b2, voffB);
            PG8_BAR; PG8_WAIT_L(0); PG8_MMA(0, 1, At, B1); PG8_BAR;
            PG8_LDA(At, 0, 1); PG8_STAGE(PG8_SA(0, 0), a2, voffA);
            PG8_BAR; PG8_WAIT_L(0); PG8_MMA(1, 0, At, B0); PG8_BAR; PG8_SCHED;
            PG8_STAGE(PG8_SB(0, 1), b2 + hstep, voffB);
            PG8_WAIT_V(6); PG8_BAR; PG8_MMA(1, 1, At, B1); PG8_BAR;
            PG8_LDB(B0, 1, 0); PG8_SCHED; PG8_LDA(At, 1, 0); PG8_STAGE(PG8_SA(0, 1), a2 + hstep, voffA);
            PG8_WAIT_L(8); PG8_BAR; PG8_WAIT_L(0); PG8_MMA(0, 0, At, B0); PG8_BAR; PG8_SCHED;
            PG8_LDB(B1, 1, 1); PG8_STAGE(PG8_SB(1, 0), b3, voffB);
            PG8_BAR; PG8_WAIT_L(0); PG8_MMA(0, 1, At, B1); PG8_BAR;
            PG8_LDA(At, 1, 1); PG8_STAGE(PG8_SA(1, 0), a3, voffA);
            PG8_BAR; PG8_WAIT_L(0); PG8_MMA(1, 0, At, B0); PG8_BAR; PG8_SCHED;
            PG8_STAGE(PG8_SB(1, 1), b3 + hstep, voffB);
            PG8_WAIT_V(6); PG8_BAR; PG8_MMA(1, 1, At, B1); PG8_BAR;
            }
        }
        if constexpr (ALIGN_EPI) { if (wr == 0) PG8_BAR; }
#pragma unroll
        for (int a = 0; a < 2; ++a)
#pragma unroll
            for (int b = 0; b < 2; ++b)
#pragma unroll
                for (int m = 0; m < 4; ++m)
#pragma unroll
                    for (int n = 0; n < 2; ++n) acc[a][b][m][n] = __builtin_convertvector(__builtin_bit_cast(v4i, acc[a][b][m][n]), f32x4);
        if constexpr (!Epi::AFTER_DRAIN) { E(acc, cur, wr, wc, fr, fq, (const PG8_LAS float*)(lds + SCB_OFF + (ui & 1) * 1024)); S.done(cur); }
        if (!has_next) break;
#pragma unroll
        for (int a = 0; a < 2; ++a)
#pragma unroll
            for (int b = 0; b < 2; ++b)
#pragma unroll
                for (int m = 0; m < 4; ++m)
#pragma unroll
                    for (int n = 0; n < 2; ++n) acc[a][b][m][n] = (f32x4){0.f, 0.f, 0.f, 0.f};
        cur = nxt; cA = nA; cB = nB; ++ui;
        if constexpr (ALIGN_EPI) { if (wr == 1) PG8_BAR; }
    }
    PG8_WAIT_V(0);
    if constexpr (!ALIGN_EPI) { if (wr == 0) PG8_BAR; }
    PG8_BAR;
    if constexpr (Epi::AFTER_DRAIN) { E.fused(acc, cur, wr, wc, fr, fq, lds, wid, lane); S.done(cur); }
#undef PG8_SA
#undef PG8_SB
#undef PG8_STAGE
#undef PG8_LDA
#undef PG8_LDB
#undef PG8_MMA
#undef PG8_WAIT_V
#undef PG8_WAIT_L
#undef PG8_BAR
#undef PG8_SCHED
}
template <class Epi, class Sched, bool ALIGN_EPI = false, bool SP2 = false>
__device__ __forceinline__ void gemm_phase_i8g(PG8_LAS unsigned char* lds, const Gemm g, const Sched& S, const Epi& E, const int* __restrict__ ridx, const float* __restrict__ rowscale) {
    const int tid = threadIdx.x, wid = __builtin_amdgcn_readfirstlane(tid >> 6), lane = tid & 63, wr = wid >> 2, wc = wid & 3, fr = lane & 15, fq = lane >> 4;
    const int K = g.K, nt = K / BK;
    unsigned voffB[2]; int arow[2]; unsigned acol[2];
#pragma unroll
    for (int i = 0; i < 2; ++i) { int R, C; stage_rc(tid * 16 + i * 8192, R, C); const int Rb = Epi::PERM ? ((R & ~31) + perm32(R & 31)) : R;
        arow[i] = R; acol[i] = (unsigned)C * 2u; voffB[i] = (unsigned)(Rb * K + C) * 2u; }
    constexpr int IDXB_OFF = STAGE_BYTES;
    unsigned offc[2][2], offn[2][2];
#define PG8_LDIDX(dst, pm_) do { _Pragma("unroll") for (int h_ = 0; h_ < 2; ++h_) _Pragma("unroll") for (int i_ = 0; i_ < 2; ++i_) \
        dst[h_][i_] = (unsigned)ridx[(pm_) * BM + h_ * HALF + arow[i_]] * (unsigned)(K * 2) + acol[i_]; } while (0)
#define PG8_STAGE_G(bufoff, gbase, off2) do { _Pragma("unroll") for (int _i = 0; _i < 2; ++_i) \
        __builtin_amdgcn_global_load_lds((const unsigned*)((const char*)(gbase) + (off2)[_i]), (PG8_LAS unsigned*)(lds + (bufoff) + ldsw + _i * 8192), 16, 0, 0); } while (0)
    const size_t kstep = (size_t)(BK * 2);
    const size_t hstep = (size_t)HALF * K * 2;
    const size_t tstep = 2 * hstep;
    const unsigned ldsw = (unsigned)wid * 1024u;
    const int aoff = lds_byte(wr * 64 + fr, fq * 8), boff = lds_byte(wc * 32 + fr, fq * 8);
#define PG8_SA(b, h) (((b) * 2 + (h)) * HTB)
#define PG8_SB(b, h) ((4 + (b) * 2 + (h)) * HTB)
#define PG8_STAGE(bufoff, gbase, voff) do { _Pragma("unroll") for (int _i = 0; _i < 2; ++_i) \
        __builtin_amdgcn_global_load_lds((const unsigned*)((const char*)(gbase) + (voff)[_i]), (PG8_LAS unsigned*)(lds + (bufoff) + ldsw + _i * 8192), 16, 0, 0); } while (0)
#define PG8_LDA(dst, b, h) do { _Pragma("unroll") for (int m = 0; m < 4; ++m) _Pragma("unroll") for (int k = 0; k < 2; ++k) dst[m][k] = *(const PG8_LAS bf16x8*)(lds + PG8_SA(b, h) + aoff + m * 2048 + k * 1024); } while (0)
#define PG8_LDB(dst, b, h) do { _Pragma("unroll") for (int n = 0; n < 2; ++n) _Pragma("unroll") for (int k = 0; k < 2; ++k) dst[n][k] = *(const PG8_LAS bf16x8*)(lds + PG8_SB(b, h) + boff + n * 2048 + k * 1024); } while (0)
#define PG8_MMA(ai, bj, At, Bt) do { __builtin_amdgcn_s_setprio(1); _Pragma("unroll") for (int m = 0; m < 4; ++m) _Pragma("unroll") for (int n = 0; n < 2; ++n) _Pragma("unroll") for (int k = 0; k < 2; ++k) \
        acc[ai][bj][m][n] = __builtin_bit_cast(f32x4, __builtin_amdgcn_mfma_i32_16x16x64_i8(__builtin_bit_cast(v4i, Bt[n][k]), __builtin_bit_cast(v4i, At[m][k]), __builtin_bit_cast(v4i, acc[ai][bj][m][n]), 0, 0, 0)); __builtin_amdgcn_s_setprio(0); } while (0)
#define PG8_WAIT_V(n) asm volatile("s_waitcnt vmcnt(" #n ")" ::: "memory")
#define PG8_WAIT_L(n) asm volatile("s_waitcnt lgkmcnt(" #n ")" ::: "memory")
#define PG8_BAR __builtin_amdgcn_s_barrier()
#define PG8_SCHED __builtin_amdgcn_sched_barrier(0)
    Unit cur, nxt; int ui = 0;
    if (!S.next(0, cur)) return;
    f32x4 acc[2][2][4][2];
#pragma unroll
    for (int a = 0; a < 2; ++a)
#pragma unroll
        for (int b = 0; b < 2; ++b)
#pragma unroll
            for (int m = 0; m < 4; ++m)
#pragma unroll
                for (int n = 0; n < 2; ++n) acc[a][b][m][n] = (f32x4){0.f, 0.f, 0.f, 0.f};
    bf16x8 At[4][2], B0[2][2], B1[2][2];
    const char* gA0 = (const char*)g.A; const char* cB = (const char*)g.Bt + (size_t)cur.pb * tstep; PG8_LDIDX(offc, cur.pm);
    constexpr int SCB_OFF = STAGE_BYTES + 2048;
    if (wid == 0) __builtin_amdgcn_global_load_lds((const unsigned*)(rowscale + cur.pm * BM + lane * 4), (PG8_LAS unsigned*)(lds + SCB_OFF), 16, 0, 0);
    S.a_ready(cur);
    if constexpr (SP2) {
        PG8_STAGE(PG8_SB(0, 0), cB, voffB); PG8_STAGE(PG8_SB(0, 1), cB + hstep, voffB); PG8_STAGE_G(PG8_SA(0, 0), gA0, offc[0]); PG8_STAGE_G(PG8_SA(0, 1), gA0, offc[1]);
        if (wr == 1) PG8_BAR;
        PG8_WAIT_V(2); PG8_BAR;
        PG8_STAGE(PG8_SB(1, 0), cB + kstep, voffB); PG8_STAGE_G(PG8_SA(1, 0), gA0 + kstep, offc[0]); PG8_STAGE(PG8_SB(1, 1), cB + hstep + kstep, voffB);
        PG8_WAIT_V(6); PG8_BAR;
    } else {
        PG8_STAGE(PG8_SB(0, 0), cB, voffB); PG8_STAGE_G(PG8_SA(0, 0), gA0, offc[0]); PG8_STAGE(PG8_SB(0, 1), cB + hstep, voffB); PG8_STAGE_G(PG8_SA(0, 1), gA0, offc[1]);
        if (wr == 1) PG8_BAR;
        PG8_WAIT_V(4); PG8_BAR;
        PG8_STAGE(PG8_SB(1, 0), cB + kstep, voffB); PG8_STAGE_G(PG8_SA(1, 0), gA0 + kstep, offc[0]); PG8_STAGE(PG8_SB(1, 1), cB + hstep + kstep, voffB);
        PG8_WAIT_V(6); PG8_BAR;
    }
    for (;;) {
        const bool has_next = S.next(ui + 1, nxt);
        const char* nB = has_next ? (const char*)g.Bt + (size_t)nxt.pb * tstep : cB;
        if (!has_next) {
#pragma unroll
            for (int h_ = 0; h_ < 2; ++h_) { offn[h_][0] = offc[h_][0]; offn[h_][1] = offc[h_][1]; } }
#pragma unroll 1
        for (int t = 0; t < nt; t += 2) {
            const bool last = (t == nt - 2);
            if (has_next && t == nt - 4 && wid == 0)
                __builtin_amdgcn_global_load_lds((const unsigned*)(ridx + nxt.pm * BM + lane * 4), (PG8_LAS unsigned*)(lds + IDXB_OFF + ((ui + 1) & 1) * 1024), 16, 0, 0);
            if (has_next && t == nt - 4 && wid == 0)
                __builtin_amdgcn_global_load_lds((const unsigned*)(rowscale + nxt.pm * BM + lane * 4), (PG8_LAS unsigned*)(lds + SCB_OFF + ((ui + 1) & 1) * 1024), 16, 0, 0);
            if (has_next && last) {
                const PG8_LAS int* ib = (const PG8_LAS int*)(lds + IDXB_OFF + ((ui + 1) & 1) * 1024);
#pragma unroll
                for (int h_ = 0; h_ < 2; ++h_)
#pragma unroll
                    for (int i_ = 0; i_ < 2; ++i_) offn[h_][i_] = (unsigned)ib[h_ * HALF + arow[i_]] * (unsigned)(K * 2) + acol[i_]; }
            const char* a1 = gA0 + (size_t)(t + 1) * kstep;
            const char* a2 = last ? gA0 : gA0 + (size_t)(t + 2) * kstep; const char* b2 = last ? nB : cB + (size_t)(t + 2) * kstep;
            const char* a3 = a2 + kstep; const char* b3 = b2 + kstep;
            unsigned o2[2][2];
#pragma unroll
            for (int h_ = 0; h_ < 2; ++h_) { o2[h_][0] = last ? offn[h_][0] : offc[h_][0]; o2[h_][1] = last ? offn[h_][1] : offc[h_][1]; }
            if (last && has_next) S.a_ready(nxt);
            if constexpr (SP2) {
            PG8_LDB(B0, 0, 0); PG8_LDB(B1, 0, 1); PG8_SCHED; PG8_LDA(At, 0, 0); PG8_STAGE_G(PG8_SA(1, 1), a1, offc[1]);
            PG8_WAIT_V(8); PG8_WAIT_L(0); PG8_BAR; PG8_MMA(0, 0, At, B0); PG8_MMA(0, 1, At, B1); PG8_BAR; PG8_SCHED;
            PG8_LDA(At, 0, 1); PG8_STAGE(PG8_SB(0, 0), b2, voffB); PG8_STAGE(PG8_SB(0, 1), b2 + hstep, voffB); PG8_STAGE_G(PG8_SA(0, 0), a2, o2[0]);
            PG8_WAIT_V(8); PG8_WAIT_L(0); PG8_BAR; PG8_MMA(1, 0, At, B0); PG8_MMA(1, 1, At, B1); PG8_BAR; PG8_SCHED;
            PG8_LDB(B0, 1, 0); PG8_LDB(B1, 1, 1); PG8_SCHED; PG8_LDA(At, 1, 0); PG8_STAGE_G(PG8_SA(0, 1), a2, o2[1]);
            PG8_WAIT_V(8); PG8_WAIT_L(0); PG8_BAR; PG8_MMA(0, 0, At, B0); PG8_MMA(0, 1, At, B1); PG8_BAR; PG8_SCHED;
            PG8_LDA(At, 1, 1); PG8_STAGE(PG8_SB(1, 0), b3, voffB); PG8_STAGE(PG8_SB(1, 1), b3 + hstep, voffB); PG8_STAGE_G(PG8_SA(1, 0), a3, o2[0]);
            PG8_WAIT_V(8); PG8_WAIT_L(0); PG8_BAR; PG8_MMA(1, 0, At, B0); PG8_MMA(1, 1, At, B1); PG8_BAR; PG8_SCHED;
            } else {
            PG8_LDB(B0, 0, 0); PG8_SCHED; PG8_LDA(At, 0, 0); PG8_STAGE_G(PG8_SA(1, 1), a1, offc[1]);
            PG8_WAIT_L(8); PG8_BAR; PG8_WAIT_L(0); PG8_MMA(0, 0, At, B0); PG8_BAR; PG8_SCHED;
            PG8_LDB(B1, 0, 1); PG8_STAGE(PG8_SB(0, 0), b2, voffB);
            PG8_BAR; PG8_WAIT_L(0); PG8_MMA(0, 1, At, B1); PG8_BAR;
            PG8_LDA(At, 0, 1); PG8_STAGE_G(PG8_SA(0, 0), a2, o2[0]);
            PG8_BAR; PG8_WAIT_L(0); PG8_MMA(1, 0, At, B0); PG8_BAR; PG8_SCHED;
            PG8_STAGE(PG8_SB(0, 1), b2 + hstep, voffB);
            PG8_WAIT_V(6); PG8_BAR; PG8_MMA(1, 1, At, B1); PG8_BAR;
            PG8_LDB(B0, 1, 0); PG8_SCHED; PG8_LDA(At, 1, 0); PG8_STAGE_G(PG8_SA(0, 1), a2, o2[1]);
            PG8_WAIT_L(8); PG8_BAR; PG8_WAIT_L(0); PG8_MMA(0, 0, At, B0); PG8_BAR; PG8_SCHED;
            PG8_LDB(B1, 1, 1); PG8_STAGE(PG8_SB(1, 0), b3, voffB);
            PG8_BAR; PG8_WAIT_L(0); PG8_MMA(0, 1, At, B1); PG8_BAR;
            PG8_LDA(At, 1, 1); PG8_STAGE_G(PG8_SA(1, 0), a3, o2[0]);
            PG8_BAR; PG8_WAIT_L(0); PG8_MMA(1, 0, At, B0); PG8_BAR; PG8_SCHED;
            PG8_STAGE(PG8_SB(1, 1), b3 + hstep, voffB);
            PG8_WAIT_V(6); PG8_BAR; PG8_MMA(1, 1, At, B1); PG8_BAR;
            }
        }
        if constexpr (ALIGN_EPI) { if (wr == 0) PG8_BAR; }
#pragma unroll
        for (int a = 0; a < 2; ++a)
#pragma unroll
            for (int b = 0; b < 2; ++b)
#pragma unroll
                for (int m = 0; m < 4; ++m)
#pragma unroll
                    for (int n = 0; n < 2; ++n) acc[a][b][m][n] = __builtin_convertvector(__builtin_bit_cast(v4i, acc[a][b][m][n]), f32x4);
        if constexpr (!Epi::AFTER_DRAIN) { E(acc, cur, wr, wc, fr, fq, (const PG8_LAS float*)(lds + SCB_OFF + (ui & 1) * 1024)); S.done(cur); }
        if (!has_next) break;
#pragma unroll
        for (int a = 0; a < 2; ++a)
#pragma unroll
            for (int b = 0; b < 2; ++b)
#pragma unroll
                for (int m = 0; m < 4; ++m)
#pragma unroll
                    for (int n = 0; n < 2; ++n) acc[a][b][m][n] = (f32x4){0.f, 0.f, 0.f, 0.f};
        cur = nxt; cB = nB; ++ui;
#pragma unroll
        for (int h_ = 0; h_ < 2; ++h_) { offc[h_][0] = offn[h_][0]; offc[h_][1] = offn[h_][1]; }
        if constexpr (ALIGN_EPI) { if (wr == 1) PG8_BAR; }
    }
    PG8_WAIT_V(0);
    if constexpr (!ALIGN_EPI) { if (wr == 0) PG8_BAR; }
    PG8_BAR;
    if constexpr (Epi::AFTER_DRAIN) { E.fused(acc, cur, wr, wc, fr, fq, lds, wid, lane); S.done(cur); }
#undef PG8_SA
#undef PG8_SB
#undef PG8_STAGE
#undef PG8_STAGE_G
#undef PG8_LDIDX
#undef PG8_LDA
#undef PG8_LDB
#undef PG8_MMA
#undef PG8_WAIT_V
#undef PG8_WAIT_L
#undef PG8_BAR
#undef PG8_SCHED
}

struct EpiPlain {
    static constexpr bool PERM = true, AFTER_DRAIN = false;
    bf16_t* O; int ldc; float scale;
    __device__ __forceinline__ void operator()(const f32x4 (&acc)[2][2][4][2], const Unit& u, int wr, int wc, int fr, int fq, const PG8_LAS float* rowscale = nullptr) const {
        const int row0 = u.pm * BM + wr * 64 + fr, col0 = u.pn * BM + wc * 32 + 8 * fq;
#pragma unroll
        for (int ai = 0; ai < 2; ++ai)
#pragma unroll
            for (int m = 0; m < 4; ++m) { bf16_t* rowp = O + (size_t)(row0 + ai * HALF + m * 16) * ldc + col0;
                const float sc = rowscale ? rowscale[wr * 64 + fr + ai * HALF + m * 16] * scale : scale;
#pragma unroll
                for (int bj = 0; bj < 2; ++bj) *(u32x4*)(rowp + bj * HALF) = pack8(acc[ai][bj][m][0] * sc, acc[ai][bj][m][1] * sc); }
    }
};
struct EpiPlain8 {
    static constexpr bool PERM = true, AFTER_DRAIN = false;
    unsigned char* O; int ldc; float scale;
    __device__ __forceinline__ void operator()(const f32x4 (&acc)[2][2][4][2], const Unit& u, int wr, int wc, int fr, int fq, const PG8_LAS float* = nullptr) const {
        const int row0 = u.pm * BM + wr * 64 + fr, col0 = u.pn * BM + wc * 32 + 8 * fq;
#pragma unroll
        for (int ai = 0; ai < 2; ++ai)
#pragma unroll
            for (int m = 0; m < 4; ++m) { unsigned char* rowp = O + (size_t)(row0 + ai * HALF + m * 16) * ldc + col0;
#pragma unroll
                for (int bj = 0; bj < 2; ++bj) { f32x4 v0 = acc[ai][bj][m][0] * scale, v1 = acc[ai][bj][m][1] * scale;
#pragma unroll
                    for (int j = 0; j < 4; ++j) { v0[j] = __builtin_amdgcn_fmed3f(v0[j], -416.f, 416.f); v1[j] = __builtin_amdgcn_fmed3f(v1[j], -416.f, 416.f); }
                    unsigned w0, w1; { int t = 0; t = __builtin_amdgcn_cvt_pk_fp8_f32(v0[0], v0[1], t, false); t = __builtin_amdgcn_cvt_pk_fp8_f32(v0[2], v0[3], t, true); w0 = (unsigned)t; }
                    { int t = 0; t = __builtin_amdgcn_cvt_pk_fp8_f32(v1[0], v1[1], t, false); t = __builtin_amdgcn_cvt_pk_fp8_f32(v1[2], v1[3], t, true); w1 = (unsigned)t; }
                    unsigned __attribute__((ext_vector_type(2))) w = {w0, w1};
                    *(unsigned __attribute__((ext_vector_type(2)))*)(rowp + bj * HALF) = w; } }
    }
};
struct EpiConvIn {
    static constexpr bool PERM = true, AFTER_DRAIN = false;
    bf16_t* U; bf16_t* Bg; float sb;
    __device__ __forceinline__ void operator()(const f32x4 (&acc)[2][2][4][2], const Unit& u, int wr, int wc, int fr, int fq, const PG8_LAS float* rowscale = nullptr) const {
        const int row0 = u.pm * BM + wr * 64 + fr;
        if (u.pn < 8) {
            const int col0 = u.pn * HALF + wc * 32 + 8 * fq;
#pragma unroll
            for (int ai = 0; ai < 2; ++ai)
#pragma unroll
                for (int m = 0; m < 4; ++m) { const int row = row0 + ai * HALF + m * 16; bf16_t* rowp = U + (size_t)row * 1024 + col0;
                    const float s = rowscale ? rowscale[row - u.pm * BM] * sb : sb, su = s * s;
                    *(u32x4*)rowp = pack8((acc[ai][0][m][0] * su) * acc[ai][1][m][0], (acc[ai][0][m][1] * su) * acc[ai][1][m][1]); }
        } else {
            const int col0 = (u.pn - 8) * BM + wc * 32 + 8 * fq;
#pragma unroll
            for (int ai = 0; ai < 2; ++ai)
#pragma unroll
                for (int m = 0; m < 4; ++m) { const int row = row0 + ai * HALF + m * 16; bf16_t* rowp = Bg + (size_t)row * 1024 + col0;
                    const float s = rowscale ? rowscale[row - u.pm * BM] * sb : sb;
#pragma unroll
                    for (int bj = 0; bj < 2; ++bj) *(u32x4*)(rowp + bj * HALF) = pack8(acc[ai][bj][m][0] * s, acc[ai][bj][m][1] * s); }
        }
    }
};
__device__ __forceinline__ float silu_mul(float g, float u) { return g * __builtin_amdgcn_rcpf(1.0f + __builtin_amdgcn_exp2f(-1.4426950408889634f * g)) * u; }
struct EpiSwiGLU {
    static constexpr bool PERM = true, AFTER_DRAIN = false;
    bf16_t* O; int ldc;
    __device__ __forceinline__ void operator()(const f32x4 (&acc)[2][2][4][2], const Unit& u, int wr, int wc, int fr, int fq, const PG8_LAS float* rowscale = nullptr) const {
        const int row0 = u.pm * BM + wr * 64 + fr, col0 = u.pn * HALF + wc * 32 + 8 * fq;
#pragma unroll
        for (int ai = 0; ai < 2; ++ai)
#pragma unroll
            for (int m = 0; m < 4; ++m) { bf16_t* rowp = O + (size_t)(row0 + ai * HALF + m * 16) * ldc + col0;
                f32x4 h0, h1;
#pragma unroll
                for (int j = 0; j < 4; ++j) { h0[j] = silu_mul(acc[ai][0][m][0][j], acc[ai][1][m][0][j]); h1[j] = silu_mul(acc[ai][0][m][1][j], acc[ai][1][m][1][j]); }
                *(u32x4*)rowp = pack8(h0, h1); }
    }
};
typedef unsigned u32x2 __attribute__((ext_vector_type(2)));
__device__ __forceinline__ unsigned pk4_i8(float a, float b, float c, float d) {
    const float M = 12582912.0f;
    const unsigned ua = __float_as_uint(__builtin_amdgcn_fmed3f(a, -127.f, 127.f) + M) & 0xffu, ub = __float_as_uint(__builtin_amdgcn_fmed3f(b, -127.f, 127.f) + M) & 0xffu;
    const unsigned uc = __float_as_uint(__builtin_amdgcn_fmed3f(c, -127.f, 127.f) + M) & 0xffu, ud = __float_as_uint(__builtin_amdgcn_fmed3f(d, -127.f, 127.f) + M) & 0xffu;
    return ua | (ub << 8) | (uc << 16) | (ud << 24);
}
__device__ __forceinline__ unsigned pk4_fp8(float a, float b, float c, float d) { int w = 0; w = __builtin_amdgcn_cvt_pk_fp8_f32(a, b, w, false); w = __builtin_amdgcn_cvt_pk_fp8_f32(c, d, w, true); return (unsigned)w; }
__device__ __forceinline__ f32x4 sigmoid_poly(f32x4 g) {
#pragma unroll
    for (int j = 0; j < 4; ++j) g[j] = __builtin_amdgcn_fmed3f(g[j], -6.0f, 6.0f);
    const f32x4 g2 = g * g;
    f32x4 p = g2 * -7.679571572410948e-09f + 9.237889806797302e-07f;
    p = p * g2 + -4.464401370582264e-05f; p = p * g2 + 0.0011428644842571107f; p = p * g2 + -0.018061106095597954f; p = p * g2 + 0.2474573026545305f;
    return g * p + 0.5f;
}
struct EpiSwiGLU8 {
    static constexpr bool PERM = true, AFTER_DRAIN = false;
    unsigned char* O; int ldc; float inscale0, outscale;
    __device__ __forceinline__ void operator()(const f32x4 (&acc)[2][2][4][2], const Unit& u, int wr, int wc, int fr, int fq, const PG8_LAS float* rowscale = nullptr) const {
        const int row0 = u.pm * BM + wr * 64 + fr, col0 = u.pn * HALF + wc * 32 + 8 * fq;
        const float s_ = inscale0, s2_ = s_ * s_, c2_ = s2_ * outscale, hk = 0.5f * c2_, lim = 6.0f / s_;
        const float k0 = 0.2474573026545305f * (c2_ * s_), k1 = -0.018061106095597954f * (c2_ * s_ * s2_), k2 = 0.0011428644842571107f * (c2_ * s_ * s2_ * s2_), k3 = -4.464401370582264e-05f * (c2_ * s_ * s2_ * s2_ * s2_),
                    k4 = 9.237889806797302e-07f * (c2_ * s_ * s2_ * s2_ * s2_ * s2_), k5 = -7.679571572410948e-09f * (c2_ * s_ * s2_ * s2_ * s2_ * s2_ * s2_);
#pragma unroll
        for (int ai = 0; ai < 2; ++ai)
#pragma unroll
            for (int m = 0; m < 4; ++m) { const int row = row0 + ai * HALF + m * 16; unsigned char* rowp = O + (size_t)row * ldc + col0;
                const float inscale = rowscale ? rowscale[row - u.pm * BM] * inscale0 : inscale0;
                const float c2 = inscale * inscale * outscale;
                f32x4 h[2];
#pragma unroll
                for (int n = 0; n < 2; ++n) { const f32x4 ag = acc[ai][0][m][n], au = acc[ai][1][m][n];
                    f32x4 p;
                    if (rowscale == nullptr) {
                        f32x4 agc;
#pragma unroll
                        for (int j = 0; j < 4; ++j) agc[j] = __builtin_amdgcn_fmed3f(ag[j], -lim, lim);
                        const f32x4 t = agc * agc; f32x4 q = t * k5 + k4; q = q * t + k3; q = q * t + k2; q = q * t + k1; q = q * t + k0;
                        p = (ag * au) * (agc * q + hk);
                    } else
                    p = ((ag * c2) * au) * sigmoid_poly(ag * inscale);
#pragma unroll
                    for (int j = 0; j < 4; ++j) p[j] = __builtin_amdgcn_fmed3f(p[j], -416.f, 416.f);
                    h[n] = p; }
                u32x2 w; w.x = pk4_fp8(h[0][0], h[0][1], h[0][2], h[0][3]); w.y = pk4_fp8(h[1][0], h[1][1], h[1][2], h[1][3]);
                *(u32x2*)rowp = w; }
    }
};
constexpr float QK8_QS = 4.0f, QK8_KS = 0.25f;
constexpr float VT_SCALE = 8.0f;
struct EpiQKV {
    static constexpr bool PERM = true, AFTER_DRAIN = false;
    bf16_t *Q, *K, *V; const float* rope; float qscale, oscale;
    __device__ __forceinline__ void operator()(const f32x4 (&acc)[2][2][4][2], const Unit& u, int wr, int wc, int fr, int fq, const PG8_LAS float* rowscale = nullptr) const {
        const int t = u.pn >> 2, colt = (u.pn & 3) * BM; const bool lat = u.pm < 128;
        bf16_t* base; int orow;
        if (t == 0) { base = Q; orow = u.pm * BM; }
        else { base = (t == 1) ? K : V; orow = lat ? ((u.pm >> 3) * 2304 + 256 + (u.pm & 7) * BM) : ((u.pm - 128) * 2304); }
        const int rloc = wr * 64 + fr, col0 = colt + wc * 32 + 8 * fq;
        unsigned char* kp = (unsigned char*)K + (unsigned)((((lat ? (u.pm >> 3) : (u.pm - 128)) * 16 + (colt >> 7) * 2 + (wc >> 1)) * 2304 + (lat ? 256 + (u.pm & 7) * BM : 0) + rloc) * 64 + (wc & 1) * 32 + 8 * fq);
        const bool dorope = lat && (t < 2);
        const int axis = wc & 1; const float sgn = (fq < 2) ? -1.f : 1.f; const float qs0 = ((t == 0) ? qscale * QK8_QS : QK8_KS) * oscale;
        if (t == 2) {
            unsigned char* vt = (unsigned char*)V; const int kb = lat ? 256 + (u.pm & 7) * BM : 0, bb = lat ? (u.pm >> 3) : (u.pm - 128);
            const int qi = fr & 3; const unsigned sel1 = (qi & 1) ? 0x03070105u : 0x06020400u, sel2 = (qi & 2) ? 0x03020706u : 0x05040100u;
#pragma unroll
            for (int ai = 0; ai < 2; ++ai)
#pragma unroll
                for (int m = 0; m < 4; ++m) { const int rl = rloc + ai * HALF + m * 16, kpos = kb + rl; const float qs = (rowscale ? rowscale[rl] * qs0 : qs0) * (VT_SCALE / QK8_KS);
#pragma unroll
                    for (int bj = 0; bj < 2; ++bj) { const int ch = col0 + bj * HALF; const f32x4 v0 = acc[ai][bj][m][0] * qs, v1 = acc[ai][bj][m][1] * qs;
                        const int kg = ((kpos & 63) - qi) >> 2;
                        unsigned char* p = vt + ((size_t)(((bb * 8 + (ch >> 7)) * 36 + (kpos >> 6)) * 128 + (ch & 127) + qi)) * 64 + (32 * (kg & 1) + 16 * (kg >> 3) + 4 * ((kg >> 1) & 3));
                        unsigned w[2] = {pk4_fp8(v0[0], v0[1], v0[2], v0[3]), pk4_fp8(v1[0], v1[1], v1[2], v1[3])};
#pragma unroll
                        for (int k = 0; k < 2; ++k) { const unsigned x = (unsigned)__builtin_amdgcn_mov_dpp((int)w[k], 0xB1, 0xF, 0xF, true), t1 = __builtin_amdgcn_perm(x, w[k], sel1);
                            const unsigned y = (unsigned)__builtin_amdgcn_mov_dpp((int)t1, 0x4E, 0xF, 0xF, true); w[k] = __builtin_amdgcn_perm(y, t1, sel2); }
                        *(unsigned*)p = w[0]; *(unsigned*)(p + 256) = w[1]; } }
            return; }
#pragma unroll
        for (int ai = 0; ai < 2; ++ai)
#pragma unroll
            for (int m = 0; m < 4; ++m) { const int rl = rloc + ai * HALF + m * 16; unsigned char* rowp = (unsigned char*)base + (size_t)(orow + rl) * 1024 + col0;
                const float qs = rowscale ? rowscale[rl] * qs0 : qs0;
                f32x4 c0 = {1.f, 1.f, 1.f, 1.f}, c1 = c0, s0 = {0.f, 0.f, 0.f, 0.f}, s1 = s0;
                if (dorope) { const int tok = (u.pm & 7) * BM + rl, pos = axis ? (tok & 63) : (tok >> 6); const float* tp = rope + pos * 32 + 8 * (fq & 1);
                    c0 = *(const f32x4*)tp; c1 = *(const f32x4*)(tp + 4); s0 = *(const f32x4*)(tp + 16); s1 = *(const f32x4*)(tp + 20); }
#pragma unroll
                for (int bj = 0; bj < 2; ++bj) { f32x4 v0 = acc[ai][bj][m][0], v1 = acc[ai][bj][m][1];
                    if (dorope) { f32x4 p0, p1;
#pragma unroll
                        for (int j = 0; j < 4; ++j) { p0[j] = __shfl_xor(v0[j], 32); p1[j] = __shfl_xor(v1[j], 32); }
                        v0 = v0 * c0 + (p0 * s0) * sgn; v1 = v1 * c1 + (p1 * s1) * sgn; }
                    v0 = v0 * qs; v1 = v1 * qs;
                    u32x2 w; w.x = pk4_fp8(v0[0], v0[1], v0[2], v0[3]); w.y = pk4_fp8(v1[0], v1[1], v1[2], v1[3]);
                    if (t == 1) *(u32x2*)(kp + (ai * HALF + m * 16) * 64 + bj * (2 * 2304 * 64)) = w;
                    else *(u32x2*)(rowp + bj * HALF) = w; } }
    }
};

struct EpiNull {
    static constexpr bool PERM = true, AFTER_DRAIN = false;
    __device__ __forceinline__ void operator()(const f32x4 (&acc)[2][2][4][2], const Unit& u, int wr, int wc, int fr, int fq, const PG8_LAS float* rowscale = nullptr) const {}
};
struct SchedGrid {
    int nM, nN, G, c;
    __device__ __forceinline__ bool next(int i, Unit& u) const { const long L = (long)i * G + c; if (L >= (long)nM * nN) return false; tile_decode((int)L, nM, nN, u.pm, u.pn); u.pb = u.pn; return true; }
    __device__ __forceinline__ void a_ready(const Unit&) const {}
    __device__ __forceinline__ void done(const Unit&) const {}
};
struct SchedMoE {
    int nM, nN, G, c;
    __device__ __forceinline__ bool next(int i, Unit& u) const { const long L = (long)i * G + c; if (L >= (long)nM * nN) return false; tile_decode((int)L, nM, nN, u.pm, u.pn);
        u.pb = ((u.pm < 256) ? (u.pm >> 4) : ((u.pm - 256) >> 1)) * nN + u.pn; return true; }
    __device__ __forceinline__ void a_ready(const Unit&) const {}
    __device__ __forceinline__ void done(const Unit&) const {}
};
struct SchedQKV {
    int G, c;
    __device__ __forceinline__ bool next(int i, Unit& u) const { const long L = (long)i * G + c;
        if (L < 1536) { tile_decode((int)L, 128, 12, u.pm, u.pn); u.pb = u.pn; return true; }
        if (L < 1664) { tile_decode((int)L - 1536, 16, 8, u.pm, u.pn); u.pm += 128; u.pn += 4; u.pb = u.pn; return true; }
        return false; }
    __device__ __forceinline__ void a_ready(const Unit&) const {}
    __device__ __forceinline__ void done(const Unit&) const {}
};
struct SchedSame {
    int nM, nN, G, c;
    __device__ __forceinline__ bool next(int i, Unit& u) const { const long L = (long)i * G + c; if (L >= (long)nM * nN) return false; u.pm = c & 7; u.pn = 0; u.pb = c & 3; return true; }
    __device__ __forceinline__ void a_ready(const Unit&) const {}
    __device__ __forceinline__ void done(const Unit&) const {}
};
}

namespace att {
using bf16 = unsigned short;
using bf16x8 = __attribute__((ext_vector_type(8))) short;
using s16x4  = __attribute__((ext_vector_type(4))) short;
using f32x16 = __attribute__((ext_vector_type(16))) float;
using u32x4  = __attribute__((ext_vector_type(4))) unsigned;
using v8i    = __attribute__((ext_vector_type(8))) int;
using v4i    = __attribute__((ext_vector_type(4))) int;
constexpr int NW = 8, QBLK = 32, KVBLK = 64, LDQ = 1024, LDK = 1024, LDO = 2048, NKEYS = 2304;
constexpr float THR2 = 3.0f, PBIAS = 5.0f;
constexpr float VT_UNSCALE = 1.0f / 8.0f;
constexpr size_t SHM_V = KVBLK * 128  , SHM_K = KVBLK * 64  , SHM_ATTN = 2 * SHM_V + 2 * SHM_K + NW * 64 * 4;
#define KSWZ64(row, colB) ((row) * 128 + ((colB) ^ ((((row) >> 1) & 7) << 4)))
#define SBAR() __builtin_amdgcn_sched_barrier(0)
__device__ __forceinline__ int crow(int r, int hi) { return (r & 3) + 8 * (r >> 2) + 4 * hi; }
__device__ __forceinline__ unsigned cvtpk(float lo, float hi) { unsigned r; asm volatile("v_cvt_pk_bf16_f32 %0, %1, %2" : "=v"(r) : "v"(lo), "v"(hi)); return r; }
__device__ __forceinline__ bf16x8 ld8(const bf16* p) { return *reinterpret_cast<const bf16x8*>(p); }

__device__ __forceinline__ int cvt4_fp8(float a, float b, float c, float d) { int w; asm volatile("" : "=v"(w));
  w = __builtin_amdgcn_cvt_pk_fp8_f32(a, b, w, false); w = __builtin_amdgcn_cvt_pk_fp8_f32(c, d, w, true); return w; }
template <int PM, bool FIRST>
__device__ __forceinline__ void partialSM(f32x16& p0, f32x16& p1, f32x16& minit, float& alpha, int (&pk)[6], float (&rest)[8]) {
  float pmax = p0[0];
#pragma unroll
  for (int r = 1; r < 16; ++r) pmax = fmaxf(pmax, p0[r]);
#pragma unroll
  for (int r = 0; r < 16; ++r) pmax = fmaxf(pmax, p1[r]);
  { auto rr = __builtin_amdgcn_permlane32_swap(__float_as_uint(pmax), __float_as_uint(pmax), false, false);
    pmax = fmaxf(__uint_as_float(rr[0]), __uint_as_float(rr[1])); }
  if (!FIRST && (PM >= 4 || __builtin_expect(__all(pmax <= THR2 + PBIAS), 1))) { alpha = 1.f; }
  else { const float d = FIRST ? pmax - PBIAS : fmaxf(pmax - PBIAS, 0.f); alpha = FIRST ? 0.f : __builtin_amdgcn_exp2f(-d);
#pragma unroll
    for (int r = 0; r < 16; ++r) { p0[r] -= d; p1[r] -= d; minit[r] -= d; } }
#pragma unroll
  for (int r = 0; r < 16; ++r) p0[r] = (PM == 1) ? p0[r] * 0.5f : __builtin_amdgcn_exp2f(p0[r]);
#pragma unroll
  for (int r = 0; r < 8; ++r) p1[r] = (PM == 1) ? p1[r] * 0.5f : __builtin_amdgcn_exp2f(p1[r]);
#pragma unroll
  for (int g = 0; g < 4; ++g) pk[g] = cvt4_fp8(p0[4 * g], p0[4 * g + 1], p0[4 * g + 2], p0[4 * g + 3]);
  pk[4] = cvt4_fp8(p1[0], p1[1], p1[2], p1[3]); pk[5] = cvt4_fp8(p1[4], p1[5], p1[6], p1[7]);
#pragma unroll
  for (int r = 0; r < 8; ++r) rest[r] = p1[8 + r];
}
__device__ __forceinline__ float sm_max16(const f32x16& p, float m) {
#pragma unroll
  for (int r = 0; r < 16; r += 2) m = fmaxf(fmaxf(m, p[r]), p[r + 1]);
  return m; }
__device__ __forceinline__ float sm_maxfin(float pmax) {
  auto rr = __builtin_amdgcn_permlane32_swap(__float_as_uint(pmax), __float_as_uint(pmax), false, false);
  return fmaxf(__uint_as_float(rr[0]), __uint_as_float(rr[1])); }
template <int PM>
__device__ __forceinline__ void sm_rebase(f32x16& p0, f32x16& p1, f32x16& minit, float pmax, float& alpha) {
  if (PM >= 4 || __builtin_expect(__all(pmax <= THR2 + PBIAS), 1)) { alpha = 1.f; }
  else { const float d = fmaxf(pmax - PBIAS, 0.f); alpha = __builtin_amdgcn_exp2f(-d);
#pragma unroll
    for (int r = 0; r < 16; ++r) { p0[r] -= d; p1[r] -= d; minit[r] -= d; } } }
template <int PM, int LO>
__device__ __forceinline__ void sm_exp8(f32x16& p) {
#pragma unroll
  for (int r = LO; r < LO + 8; ++r) p[r] = (PM == 1) ? p[r] * 0.5f : __builtin_amdgcn_exp2f(p[r]); }
template <int PM>
__device__ __forceinline__ void finishSM(const int (&pk)[6], float (&rest)[8], v8i& pop) {
#pragma unroll
  for (int r = 0; r < 8; ++r) rest[r] = (PM == 1) ? rest[r] * 0.5f : __builtin_amdgcn_exp2f(rest[r]);
  const int b2 = cvt4_fp8(rest[0], rest[1], rest[2], rest[3]), b3 = cvt4_fp8(rest[4], rest[5], rest[6], rest[7]);
  pop = v8i{pk[0], pk[1], pk[2], pk[3], pk[4], pk[5], b2, b3};
}
template <int OFF> __device__ __forceinline__ v4i lds_rd128(int addr) { v4i r; asm volatile("ds_read_b128 %0, %1 offset:%2" : "=&v"(r) : "v"(addr), "i"(OFF) : "memory"); return r; }
template <int OFF> __device__ __forceinline__ v4i lds_rd128g(int addr, const v8i& guard) { v4i r; asm volatile("ds_read_b128 %0, %1 offset:%2" : "=&v"(r) : "v"(addr), "i"(OFF), "v"(guard) : "memory"); return r; }
__device__ __forceinline__ void k_load(v8i (&kf)[2], int ka_lo, int ka_hi, const v8i& guard) {
  const v4i a0 = lds_rd128g<0>(ka_lo, guard), a1 = lds_rd128g<0>(ka_hi, guard), b0 = lds_rd128g<2048>(ka_lo, guard), b1 = lds_rd128g<2048>(ka_hi, guard);
  kf[0] = __builtin_shufflevector(a0, a1, 0, 1, 2, 3, 4, 5, 6, 7); kf[1] = __builtin_shufflevector(b0, b1, 0, 1, 2, 3, 4, 5, 6, 7);
}
template <int PM>
__device__ __forceinline__ void qk_mm(f32x16& p0, f32x16& p1, const f32x16& minit, const v8i (&kf)[2], const v8i& qr) {
  if constexpr (PM == 3) { p0 = minit; p1 = minit; asm volatile("" : "+v"(p0), "+v"(p1) : "v"(qr), "v"(kf[0]), "v"(kf[1])); return; }
  p0 = __builtin_amdgcn_mfma_scale_f32_32x32x64_f8f6f4(kf[0], qr, minit, 0, 0, 0, 0, 0, 0);
  p1 = __builtin_amdgcn_mfma_scale_f32_32x32x64_f8f6f4(kf[1], qr, minit, 0, 0, 0, 0, 0, 0);
}
__device__ __forceinline__ int v_st(int k, int c) { const int kk = (k & ~0xC) | ((k & 4) << 1) | ((k & 8) >> 1); return ((kk >> 3) * 4 + (c >> 5)) * 512 + ((kk & 7) * 32 + (c & 31)) * 2; }
__device__ __forceinline__ int v_rd_base(int lane) { return ((lane & 3) << 3) | (((lane >> 2) & 3) << 6) | (((lane >> 4) & 1) << 5) | (((lane >> 5) & 1) << 8); }
constexpr int v_rd_off(int d0, int ks, int half) { return d0 * 512 + ks * 4096 + half * 2048; }
template <int OFF> __device__ __forceinline__ s16x4 tr_read(int vb) {
  s16x4 r; asm volatile("ds_read_b64_tr_b16 %0, %1 offset:%2" : "=&v"(r) : "v"(vb), "i"(OFF) : "memory"); return r;
}
__device__ __forceinline__ void v_load(v8i (&vf)[4], int va_lo, int va_hi) {
  { const v4i lo = lds_rd128<0>(va_lo), hh = lds_rd128<0>(va_hi); vf[0] = __builtin_shufflevector(lo, hh, 0, 1, 2, 3, 4, 5, 6, 7); }
  { const v4i lo = lds_rd128<2048>(va_lo), hh = lds_rd128<2048>(va_hi); vf[1] = __builtin_shufflevector(lo, hh, 0, 1, 2, 3, 4, 5, 6, 7); }
  { const v4i lo = lds_rd128<4096>(va_lo), hh = lds_rd128<4096>(va_hi); vf[2] = __builtin_shufflevector(lo, hh, 0, 1, 2, 3, 4, 5, 6, 7); }
  { const v4i lo = lds_rd128<6144>(va_lo), hh = lds_rd128<6144>(va_hi); vf[3] = __builtin_shufflevector(lo, hh, 0, 1, 2, 3, 4, 5, 6, 7); }
}
__device__ __forceinline__ void pv_one(f32x16& od, const v8i& vfd, const v8i& pop) { asm volatile("v_mfma_f32_32x32x64_f8f6f4 %0, %1, %2, %0" : "+v"(od) : "v"(pop), "v"(vfd)); }
using f32x4a = __attribute__((ext_vector_type(4))) float;
__device__ __forceinline__ void pv_sum(f32x4a& lacc, const v8i& sel, const v8i& pop) { asm volatile("v_mfma_f32_16x16x128_f8f6f4 %0, %1, %2, %0" : "+v"(lacc) : "v"(pop), "v"(sel)); }
#define ATT_LAS __attribute__((address_space(3)))
constexpr int SHM_V2 = 2 * (int)SHM_V, SHM_K2 = 2 * (int)SHM_K;
constexpr int RING_V = 0, RING_K = 3 * SHM_V2, RING_WS = RING_K + 3 * SHM_K2, RING_END = RING_WS + NW * 64 * 4;
template <int PM>
__device__ __forceinline__ void attn_pass(const unsigned char* __restrict__ Qb, const unsigned char* __restrict__ Kh, const unsigned char* __restrict__ Vh, const unsigned char* Kn, const unsigned char* Vn, const unsigned char* Qn, v8i& qio, bool pre, char* lds, ATT_LAS unsigned char* lds3, f32x16 (&o)[4], float (&rli)[16]) {
  const int tid = threadIdx.x, wid = __builtin_amdgcn_readfirstlane(tid >> 6), lane = tid & 63, r32 = lane & 31, hi = lane >> 5;
#define LDS_WAIT_V() asm volatile("s_waitcnt lgkmcnt(0)" : "+v"(vfr[0]), "+v"(vfr[1]), "+v"(vfr[2]), "+v"(vfr[3]) :: "memory")
  char* V_lds = lds + RING_V; char* K_lds = lds + RING_K; const int vbase = (int)(uintptr_t)V_lds, kbase = (int)(uintptr_t)K_lds;
  float* ws = (float*)(lds + RING_WS) + wid * 64; float* al_l = ws + 32;
  v8i qr; f32x16 minit = f32x16{}; f32x4a lacc = f32x4a{};
  v8i ones; { int c1 = ((lane & 15) == ((lane >> 4) & 1)) ? 0x38383838 : 0; asm volatile("" : "+v"(c1)); ones = v8i{c1, c1, c1, c1, c1, c1, c1, c1}; }
#pragma unroll
  for (int d = 0; d < 4; ++d) o[d] = f32x16{};
  const unsigned qoff = (unsigned)((wid * QBLK + r32) * LDQ + hi * 32);
  const unsigned kgo = (unsigned)(wid * 1024 + (lane >> 2) * 64 + (((lane & 3) ^ ((lane >> 4) & 3)) << 4));
  const int voffl = r32 * 64 + (((2 * hi) ^ ((r32 >> 2) & 3)) << 4), voffh = r32 * 64 + (((2 * hi + 1) ^ ((r32 >> 2) & 3)) << 4);
  constexpr int NT = NKEYS / KVBLK;
  constexpr int NS = NT / 2;
#define DMA_KS(s_, slotoff) do { if constexpr (PM == 6) break; const bool nx_ = (s_) >= NS && Kn != nullptr; const int ss_ = (s_) < NS ? (s_) : (nx_ ? (s_) - NS : NS - 1); const char* kp_ = (const char*)(nx_ ? Kn : Kh); \
    __builtin_amdgcn_global_load_lds((const unsigned*)(kp_ + (size_t)ss_ * 8192 + kgo), (ATT_LAS unsigned*)(lds3 + RING_K + (slotoff) + wid * 1024), 16, 0, 0); } while (0)
#define DMA_VS(s_, slotoff) do { if constexpr (PM == 6) break; const bool nx_ = (s_) >= NS && Vn != nullptr; const int ss_ = (s_) < NS ? (s_) : (nx_ ? (s_) - NS : NS - 1); const char* vp_ = (const char*)(nx_ ? Vn : Vh); \
    __builtin_amdgcn_global_load_lds((const unsigned*)(vp_ + (size_t)ss_ * 16384 + kgo), (ATT_LAS unsigned*)(lds3 + RING_V + (slotoff) + wid * 1024), 16, 0, 0); \
    __builtin_amdgcn_global_load_lds((const unsigned*)(vp_ + (size_t)ss_ * 16384 + 8192 + kgo), (ATT_LAS unsigned*)(lds3 + RING_V + (slotoff) + 8192 + wid * 1024), 16, 0, 0); } while (0)
#define WAITBAR(n) do { if constexpr (PM == 4) asm volatile("s_waitcnt vmcnt(" #n ") lgkmcnt(0)" ::: "memory"); else if constexpr (PM == 6) asm volatile("s_waitcnt lgkmcnt(0)\n\ts_barrier" ::: "memory"); else asm volatile("s_waitcnt vmcnt(" #n ") lgkmcnt(0)\n\ts_barrier" ::: "memory"); } while (0)
#define MFMA_DRAIN() asm volatile("s_nop 15\n\ts_nop 7" ::: "memory")
#define RESC(a) do { if (__any((a) < 1.f)) { MFMA_DRAIN(); if (hi == 0) al_l[r32] = (a); asm volatile("s_waitcnt lgkmcnt(0)" ::: "memory"); \
    _Pragma("unroll") for (int r = 0; r < 16; ++r) { const float a_ = al_l[crow(r, hi)]; o[0][r] *= a_; o[1][r] *= a_; o[2][r] *= a_; o[3][r] *= a_; } \
    _Pragma("unroll") for (int r = 0; r < 4; ++r) lacc[r] *= al_l[16 * (lane & 1) + 4 * (lane >> 4) + r]; } } while (0)
  int kw0 = 0, kw1 = SHM_K2, kw2 = 2 * SHM_K2, vw0 = 0, vw1 = SHM_V2, vw2 = 2 * SHM_V2;
#define ROT() do { const int k_ = kw0; kw0 = kw1; kw1 = kw2; kw2 = k_; const int v_ = vw0; vw0 = vw1; vw1 = vw2; vw2 = v_; } while (0)
#define WAITBAR_K(n) do { if constexpr (PM == 4) asm volatile("s_waitcnt vmcnt(" #n ") lgkmcnt(0)" : "+v"(kfr[0]), "+v"(kfr[1]) :: "memory"); else if constexpr (PM == 6) asm volatile("s_waitcnt lgkmcnt(0)\n\ts_barrier" : "+v"(kfr[0]), "+v"(kfr[1]) :: "memory"); \
    else asm volatile("s_waitcnt vmcnt(" #n ") lgkmcnt(0)\n\ts_barrier" : "+v"(kfr[0]), "+v"(kfr[1]) :: "memory"); } while (0)
#define KLOAD(slot_) do { if constexpr (PM == 5) asm volatile("" : "=v"(kfr[0]), "=v"(kfr[1])); else k_load(kfr, kbase + (slot_) + voffl, kbase + (slot_) + voffh, pop); } while (0)
#define VLOAD(slot_) do { if constexpr (PM == 5) asm volatile("" : "=v"(vfr[0]), "=v"(vfr[1]), "=v"(vfr[2]), "=v"(vfr[3])); else v_load(vfr, vbase + (slot_) + voffl, vbase + (slot_) + voffh); } while (0)
#define PV1(d_) do { if constexpr (PM != 2) pv_one(o[d_], vfr[d_], pop); else asm volatile("" : "+v"(o[d_]) : "v"(pop), "v"(vfr[d_])); } while (0)
#define PVS() do { if constexpr (PM != 2) pv_sum(lacc, ones, pop); else asm volatile("" : "+v"(lacc) : "v"(pop)); } while (0)
#define STEP(pkN, rsN, alN, pkO, rsO, VOFF, KOFF, KRD) do { f32x16 p0_, p1_; float pm_; \
    SBAR(); VLOAD(VOFF); SBAR(); \
    qk_mm<PM>(p0_, p1_, minit, kfr, qr); \
    finishSM<PM>(pkO, rsO, pop); SBAR(); \
    LDS_WAIT_V(); \
    PV1(0); SBAR(); pm_ = sm_max16(p0_, p0_[0]); SBAR(); \
    PV1(1); SBAR(); pm_ = sm_maxfin(sm_max16(p1_, pm_)); SBAR(); \
    if (KRD) { KLOAD(KOFF); SBAR(); } \
    sm_rebase<PM>(p0_, p1_, minit, pm_, alN); SBAR(); \
    PV1(2); SBAR(); sm_exp8<PM, 0>(p0_); SBAR(); \
    PV1(3); SBAR(); sm_exp8<PM, 8>(p0_); SBAR(); \
    PVS();  SBAR(); sm_exp8<PM, 0>(p1_); \
    _Pragma("unroll") for (int g_ = 0; g_ < 4; ++g_) pkN[g_] = cvt4_fp8(p0_[4 * g_], p0_[4 * g_ + 1], p0_[4 * g_ + 2], p0_[4 * g_ + 3]); \
    pkN[4] = cvt4_fp8(p1_[0], p1_[1], p1_[2], p1_[3]); pkN[5] = cvt4_fp8(p1_[4], p1_[5], p1_[6], p1_[7]); \
    _Pragma("unroll") for (int r_ = 0; r_ < 8; ++r_) rsN[r_] = p1_[8 + r_]; \
    asm volatile("" : "+v"(pkN[0]), "+v"(pkN[1]), "+v"(pkN[2]), "+v"(pkN[3]), "+v"(pkN[4]), "+v"(pkN[5]), "+v"(rsN[0]), "+v"(rsN[1]), "+v"(rsN[2]), "+v"(rsN[3]), "+v"(rsN[4]), "+v"(rsN[5]), "+v"(rsN[6]), "+v"(rsN[7]));   \
    } while (0)
  if (!pre) { DMA_KS(0, 0); DMA_KS(1, SHM_K2); DMA_KS(2, 2 * SHM_K2); DMA_VS(0, 0); DMA_VS(1, SHM_V2); }
  if (!pre) { const v4i q0 = *reinterpret_cast<const v4i*>(Qb + qoff), q1 = *reinterpret_cast<const v4i*>(Qb + qoff + 16); qr = __builtin_shufflevector(q0, q1, 0, 1, 2, 3, 4, 5, 6, 7); }
  else qr = qio;
  asm volatile("s_waitcnt vmcnt(0)" ::: "memory");
  int pkA[6], pkB[6]; float rsA[8], rsB[8]; float alA, alB; v8i pop = qr, kfr[2], vfr[4];
  asm volatile("s_barrier" ::: "memory");
  KLOAD(0); asm volatile("s_waitcnt lgkmcnt(0)" : "+v"(kfr[0]), "+v"(kfr[1]) :: "memory"); { f32x16 p0_, p1_; qk_mm<PM>(p0_, p1_, minit, kfr, qr); partialSM<PM, true>(p0_, p1_, minit, alA, pkA, rsA); }
  SBAR(); KLOAD(4096); SBAR();
  WAITBAR_K(0);
  if (wid >= 4) __builtin_amdgcn_s_setprio(1);
#pragma unroll 1
  for (int w = 0; w + 1 < NS; ++w) {
    DMA_KS(w + 3, kw0); DMA_VS(w + 2, vw2);
    STEP(pkB, rsB, alB, pkA, rsA, vw0, kw1, true);
    asm volatile("s_waitcnt lgkmcnt(0)" : "+v"(kfr[0]), "+v"(kfr[1]) :: "memory"); RESC(alB);
    STEP(pkA, rsA, alA, pkB, rsB, vw0 + 8192, kw1 + 4096, true);
    WAITBAR_K(3); ROT(); RESC(alA);
  }
  if (Kn != nullptr) { DMA_KS(NS + 2, kw0); DMA_VS(NS + 1, vw2); }
  v4i qn0 = v4i{}, qn1 = v4i{};
  if (Qn != nullptr) { qn0 = *reinterpret_cast<const v4i*>(Qn + qoff); qn1 = *reinterpret_cast<const v4i*>(Qn + qoff + 16); }
  STEP(pkB, rsB, alB, pkA, rsA, vw0, 0, false);
  RESC(alB);
  SBAR(); VLOAD(vw0 + 8192); SBAR();
  finishSM<PM>(pkB, rsB, pop); SBAR();
  LDS_WAIT_V(); PV1(0); PV1(1); PV1(2); PV1(3); PVS();
  MFMA_DRAIN();
  __builtin_amdgcn_s_setprio(0);
  if ((lane & 15) < 2) {
#pragma unroll
    for (int r = 0; r < 4; ++r) al_l[16 * (lane & 15) + 4 * (lane >> 4) + r] = lacc[r]; }
  asm volatile("s_waitcnt lgkmcnt(0)" ::: "memory");
#pragma unroll
  for (int r = 0; r < 16; ++r) rli[r] = __builtin_amdgcn_rcpf(al_l[crow(r, hi)]) * VT_UNSCALE;
  WAITBAR(0);
  qio = __builtin_shufflevector(qn0, qn1, 0, 1, 2, 3, 4, 5, 6, 7);
#undef LDS_WAIT_V
#undef STEP
#undef PV1
#undef PVS
#undef KLOAD
#undef VLOAD
#undef WAITBAR_K
#undef DMA_KS
#undef DMA_VS
#undef WAITBAR
#undef RESC
#undef MFMA_DRAIN
#undef ROT
}
constexpr int STASH_OFF = RING_END, ATTN_LDS_TOTAL = STASH_OFF + NW * 8192;
template <bool F8, int PM = 0>
__device__ __forceinline__ void attn_diff_unit(const unsigned char* __restrict__ Qb, const unsigned char* __restrict__ Kh, const unsigned char* __restrict__ Vh, const unsigned char* Knext, const unsigned char* Vnext, const unsigned char* Qnext, v8i& qio, bool pre, unsigned char* __restrict__ Ob, float lam, const float* __restrict__ subln_g, float gscale, char* lds, ATT_LAS unsigned char* lds3) {
  const int tid = threadIdx.x, wid = tid >> 6, lane = tid & 63, r32 = lane & 31, hi = lane >> 5;
  unsigned* stash = (unsigned*)(lds + STASH_OFF + wid * 8192);
#pragma unroll 1
  for (int map = 0; map < 2; ++map) {
    f32x16 o[4]; float rli[16];
    attn_pass<PM>(Qb + 64 * map, Kh + map * (NKEYS * 64), Vh, map == 0 ? Kh + NKEYS * 64 : Knext, map == 0 ? Vh : Vnext, map == 0 ? Qb + 64 : Qnext, qio, map == 0 ? pre : true, lds, lds3, o, rli);
    if (map == 0) {
#pragma unroll
      for (int r = 0; r < 16; ++r) { stash[(r * 2 + 0) * 64 + lane] = cvtpk(o[0][r] * rli[r], o[1][r] * rli[r]); stash[(r * 2 + 1) * 64 + lane] = cvtpk(o[2][r] * rli[r], o[3][r] * rli[r]); }
    } else {
  int lane; asm volatile("v_mbcnt_lo_u32_b32 %0, -1, 0\n\tv_mbcnt_hi_u32_b32 %0, -1, %0" : "=v"(lane));
  const int r32 = lane & 31, hi = lane >> 5;
  float ss[16];
#pragma unroll
  for (int r = 0; r < 16; ++r) { const unsigned w0 = stash[(r * 2 + 0) * 64 + lane], w1 = stash[(r * 2 + 1) * 64 + lane];
    o[0][r] = __uint_as_float(w0 << 16) - lam * (o[0][r] * rli[r]); o[1][r] = __uint_as_float(w0 & 0xffff0000u) - lam * (o[1][r] * rli[r]);
    o[2][r] = __uint_as_float(w1 << 16) - lam * (o[2][r] * rli[r]); o[3][r] = __uint_as_float(w1 & 0xffff0000u) - lam * (o[3][r] * rli[r]);
    float q = (o[0][r] * o[0][r] + o[1][r] * o[1][r]) + (o[2][r] * o[2][r] + o[3][r] * o[3][r]);
    q += __shfl_xor(q, 1); q += __shfl_xor(q, 2); q += __shfl_xor(q, 4); q += __shfl_xor(q, 8); q += __shfl_xor(q, 16);
    ss[r] = 1.0f / sqrtf(q * (1.0f / 128.0f) + 1e-6f); }
  float gs[4];
#pragma unroll
  for (int d0 = 0; d0 < 4; ++d0) gs[d0] = subln_g[d0 * 32 + r32] * gscale;
  if constexpr (F8) {
    unsigned char* stg = (unsigned char*)stash;
#pragma unroll
    for (int r = 0; r < 16; ++r) { const int row = crow(r, hi);
#pragma unroll
      for (int d0 = 0; d0 < 4; d0 += 2) { int w = 0; w = __builtin_amdgcn_cvt_pk_fp8_f32(o[d0][r] * ss[r] * gs[d0], o[d0 + 1][r] * ss[r] * gs[d0 + 1], w, false);
        stg[row * 128 + d0 * 32 + r32] = (unsigned char)(w & 0xff); stg[row * 128 + (d0 + 1) * 32 + r32] = (unsigned char)((w >> 8) & 0xff); } }
    asm volatile("s_waitcnt lgkmcnt(0)" ::: "memory");
#pragma unroll
    for (int i = 0; i < 4; ++i) { const int c = i * 64 + lane, row = c >> 3, ch = c & 7; const u32x4 v = *(const u32x4*)(stg + row * 128 + ch * 16);
      *(u32x4*)(Ob + (long)(wid * QBLK + row) * 1024 + ch * 16) = v; }
  } else {
    bf16* stg = (bf16*)(lds + wid * 8192);
#pragma unroll
    for (int r = 0; r < 16; ++r) { const int row = crow(r, hi);
#pragma unroll
      for (int d0 = 0; d0 < 4; d0 += 2) { const unsigned w = cvtpk(o[d0][r] * ss[r] * gs[d0], o[d0 + 1][r] * ss[r] * gs[d0 + 1]);
        stg[row * 128 + d0 * 32 + r32] = (bf16)(w & 0xffffu); stg[row * 128 + (d0 + 1) * 32 + r32] = (bf16)(w >> 16); } }
    asm volatile("s_waitcnt lgkmcnt(0)" ::: "memory");
#pragma unroll
    for (int i = 0; i < 8; ++i) { const int c = i * 64 + lane, row = c >> 4, ch = c & 15; const u32x4 v = *(const u32x4*)((const char*)stg + row * 256 + ch * 16);
      *(u32x4*)(Ob + (long)(wid * QBLK + row) * 2048 + ch * 16) = v; }
  }
    }
  }
  __syncthreads();
}
#undef SBAR
}

constexpr int NWAVES = 8;
constexpr int D = 1024, NB = 16, SEQ = 2048, CTX = 256, ML = NB * SEQ, MC = NB * CTX, MA = ML + MC;
constexpr int NE = 16, FF = 2048, CAPL = 256, CAPC = 32, NPL = 256, NPC = 32;
constexpr int NMOD = 6 * D;
constexpr float EPS = 1e-6f;
constexpr float QSCALE = 0.125f * 1.4426950408889634f;
constexpr size_t MiB = 1u << 20;
constexpr size_t WS_CTL = 0, CTL_ZERO_BYTES = 1 * MiB;
constexpr size_t WS_MOD = 1 * MiB;
constexpr size_t WS_ROPE = 2 * MiB;
constexpr size_t WS_AFF = 3 * MiB;
constexpr size_t WS_INV = 6 * MiB;
constexpr size_t WS_RIDX = 9 * MiB;
constexpr size_t WS_SAH = 10 * MiB, WS_SAH2 = 11 * MiB, WS_SAG = 12 * MiB;
constexpr size_t WS_WIN = 25 * MiB, WS_WOUT = 31 * MiB, WS_WQKV = 33 * MiB, WS_WO = 39 * MiB;
constexpr size_t WS_WGU8 = 41 * MiB;
constexpr size_t WS_WD8 = 169 * MiB;
constexpr size_t WS_H = 233 * MiB;
constexpr size_t WS_H8 = 305 * MiB;
constexpr size_t WS_BUF1 = 341 * MiB, WS_BUF2 = 413 * MiB, WS_BUF3 = 485 * MiB, WS_OPART = 549 * MiB;
constexpr size_t WS_XS8 = 341 * MiB, WS_HID8 = 413 * MiB, WS_Y = 557 * MiB;
constexpr size_t WS_XR = 701 * MiB;
constexpr size_t WS_END = 773 * MiB;
static_assert(WS_HID8 + (size_t)(NPL + NPC) * 256 * FF <= WS_Y && WS_OPART + (size_t)ML * 2048 * 2 <= WS_END && WS_XS8 + (size_t)(NPL + NPC) * 256 * D <= WS_HID8 && WS_Y + (size_t)(NPL + NPC) * 256 * D * 2 <= WS_END, "d_ws map");
#ifndef MIX8
#define MIX8 2
#endif
constexpr bool CONV8 = (MIX8 & 1) != 0, ATT8 = (MIX8 & 2) != 0, CONVO8 = (MIX8 & 4) != 0;
#ifndef I8MASK
#define I8MASK 9
#endif
constexpr bool CIN_I8 = (I8MASK & 1) != 0, QKV_I8 = (I8MASK & 2) != 0, UP_I8 = (I8MASK & 4) != 0, COUT_I8 = (I8MASK & 8) != 0;
constexpr float WS8 = 1024.0f;
constexpr float WSCALE = 64.0f, HSCALE = 4.0f, YSCALE = 8.0f;
constexpr int CW_TMO = 0, CW_BAR = 4096;
constexpr int RING_BYTES = 131072, LDS_BYTES = 147456, LDSCTL_OFF = LDS_BYTES - 1024, MISC_OFF = LDSCTL_OFF + 320;

#define GAS __attribute__((address_space(1)))
#define LAS __attribute__((address_space(3)))
typedef unsigned short bf16;
typedef unsigned v4u __attribute__((ext_vector_type(4)));
typedef unsigned v2u __attribute__((ext_vector_type(2)));
typedef float f32x4 __attribute__((ext_vector_type(4)));
typedef GAS unsigned gu32;
#define RLX_AGENT __ATOMIC_RELAXED, __HIP_MEMORY_SCOPE_AGENT
#define LDS_WAIT() asm volatile("s_waitcnt lgkmcnt(0)" ::: "memory")
#define VM_WAIT() asm volatile("s_waitcnt vmcnt(0)" ::: "memory")
__device__ __forceinline__ unsigned pk2(float lo, float hi) { return pg8::cvt_pk_bf16(lo, hi); }
__device__ __forceinline__ float bflo(unsigned w) { return __uint_as_float(w << 16); }
__device__ __forceinline__ float bfhi(unsigned w) { return __uint_as_float(w & 0xffff0000u); }

#define XB_TMO      128
#define XB_XCNT(j)  (256  + 64 * (j))
#define XB_XSUB(j)  (1280 + 64 * (j))
#define XB_XGEN(j)  (2304 + 64 * (j))
#define XB_TOP      3328
#define XB_TOPGEN   3392
#define XCD_BAR_WORDS 3456
#define XB_SPIN_CAP (1u << 18)

__device__ __forceinline__ unsigned xb_ld(unsigned* p)              { return __hip_atomic_load(p, __ATOMIC_RELAXED, __HIP_MEMORY_SCOPE_AGENT); }
__device__ __forceinline__ unsigned xb_add(unsigned* p, unsigned v) { return __hip_atomic_fetch_add(p, v, __ATOMIC_RELAXED, __HIP_MEMORY_SCOPE_AGENT); }
__device__ __forceinline__ unsigned xb_xcc_id() { return (unsigned)__builtin_amdgcn_s_getreg((3 << 11) | 20) & 0xFu; }
#define XB_SPIN(cond, bar) do { unsigned _sp = 0; while (cond) { __builtin_amdgcn_s_sleep(1); \
    if ((++_sp & 255u) == 0u) { if (xb_ld(&(bar)[XB_TMO])) break; if (_sp > XB_SPIN_CAP) { atomicAdd(&(bar)[XB_TMO], 1u); break; } } } } while (0)

struct XcdBarrier {
    unsigned* bar; unsigned x;
    volatile LAS unsigned* st;
};

__device__ __forceinline__ XcdBarrier xcd_barrier_post(unsigned* bar, volatile LAS unsigned* st) {
    XcdBarrier b; b.bar = bar; b.x = xb_xcc_id(); b.st = st;
    if (threadIdx.x == 0) (void)xb_add(&bar[XB_XCNT(b.x)], 1u);
    return b;
}
__device__ __forceinline__ void xcd_barrier_complete(unsigned* bar, unsigned x, unsigned& nloc, unsigned& nx) {
    const unsigned G = gridDim.x * gridDim.y * gridDim.z;
    unsigned sum, cnt, mine, sp = 0u;
    for (;;) {
        sum = 0u; cnt = 0u; mine = 0u;
#pragma unroll
        for (unsigned j = 0; j < 16; ++j) { const unsigned c = xb_ld(&bar[XB_XCNT(j)]); sum += c; cnt += (c > 0u) ? 1u : 0u; mine = (j == x) ? c : mine; }
        if (sum == G) break;
        __builtin_amdgcn_s_sleep(1);
        if ((++sp & 255u) == 0u) { if (xb_ld(&bar[XB_TMO])) break; if (sp > XB_SPIN_CAP) { atomicAdd(&bar[XB_TMO], 1u); break; } }
    }
    nloc = mine > 0u ? mine : 1u; nx = cnt > 0u ? cnt : 1u;
}

__device__ __forceinline__ void xcd_barrier(const XcdBarrier& b) {
    asm volatile("s_waitcnt vmcnt(0)" ::: "memory");
    __syncthreads();
    if (threadIdx.x == 0) {
        unsigned* bar = b.bar;
        __builtin_amdgcn_s_waitcnt(0);
        unsigned nloc = b.st[0], nx = b.st[1];
        if (nloc == 0u) { xcd_barrier_complete(bar, b.x, nloc, nx); b.st[0] = nloc; b.st[1] = nx; }
        const unsigned old = xb_add(&bar[XB_XSUB(b.x)], 1u);
        const unsigned gen = old / nloc;
        if (old + 1u == (gen + 1u) * nloc) {
            __builtin_amdgcn_fence(__ATOMIC_RELEASE, "agent");
            asm volatile("s_waitcnt vmcnt(0)" ::: "memory");
            const unsigned og = xb_add(&bar[XB_TOP], 1u);
            const unsigned tg = og / nx;
            if (og + 1u == (tg + 1u) * nx) xb_add(&bar[XB_TOPGEN], 1u);
            else XB_SPIN(xb_ld(&bar[XB_TOPGEN]) == tg, bar);
            __builtin_amdgcn_fence(__ATOMIC_ACQUIRE, "agent");
            xb_add(&bar[XB_XGEN(b.x)], 1u);
            asm volatile("s_waitcnt vmcnt(0)" ::: "memory");
        } else {
            XB_SPIN(xb_ld(&bar[XB_XGEN(b.x)]) == gen, bar);
            __builtin_amdgcn_fence(__ATOMIC_ACQUIRE, "agent");
            asm volatile("s_waitcnt vmcnt(0)" ::: "memory");
        }
    }
    __syncthreads();
}

struct R16 { f32x4 v[4]; };
__device__ __forceinline__ int lane_now() { int l; asm volatile("v_mbcnt_lo_u32_b32 %0, -1, 0\n\tv_mbcnt_hi_u32_b32 %0, -1, %0" : "=v"(l)); return l; }
__device__ __forceinline__ float wave_sum(float v) {
#pragma unroll
    for (int o = 1; o < 64; o <<= 1) v += __shfl_xor(v, o);
    return v;
}
__device__ __forceinline__ void ld_f32(R16& r, const float* p, int lane) {
#pragma unroll
    for (int j = 0; j < 4; ++j) r.v[j] = ((const f32x4*)p)[lane + 64 * j];
}
__device__ __forceinline__ void st_f32(float* p, int lane, const R16& r) {
#pragma unroll
    for (int j = 0; j < 4; ++j) ((f32x4*)p)[lane + 64 * j] = r.v[j];
}
__device__ __forceinline__ void ld_bf16(R16& r, const bf16* p, int lane) {
#pragma unroll
    for (int j = 0; j < 4; ++j) { const v2u w = ((const v2u*)p)[lane + 64 * j]; r.v[j] = (f32x4){bflo(w.x), bfhi(w.x), bflo(w.y), bfhi(w.y)}; }
}
__device__ __forceinline__ void st_bf16(bf16* p, int lane, const R16& r) {
#pragma unroll
    for (int j = 0; j < 4; ++j) { v2u w; w.x = pk2(r.v[j][0], r.v[j][1]); w.y = pk2(r.v[j][2], r.v[j][3]); ((v2u*)p)[lane + 64 * j] = w; }
}
__device__ __forceinline__ void st_fp8(unsigned char* p, int lane, const R16& r) {
#pragma unroll
    for (int j = 0; j < 4; ++j) ((unsigned*)p)[lane + 64 * j] = pg8::pk4_fp8(r.v[j][0], r.v[j][1], r.v[j][2], r.v[j][3]);
}
__device__ __forceinline__ void st_i8(unsigned char* p, float* scale_out, int lane, const R16& r) {
    float mx = 0.f;
#pragma unroll
    for (int j = 0; j < 4; ++j) mx = fmaxf(fmaxf(mx, fmaxf(fabsf(r.v[j][0]), fabsf(r.v[j][1]))), fmaxf(fabsf(r.v[j][2]), fabsf(r.v[j][3])));
#pragma unroll
    for (int o = 1; o < 64; o <<= 1) mx = fmaxf(mx, __shfl_xor(mx, o));
    const float inv = (mx > 0.f) ? 127.0f / mx : 0.f;
#pragma unroll
    for (int j = 0; j < 4; ++j) ((unsigned*)p)[lane + 64 * j] = pg8::pk4_i8(r.v[j][0] * inv, r.v[j][1] * inv, r.v[j][2] * inv, r.v[j][3] * inv);
    if (lane == 0) *scale_out = (mx > 0.f) ? mx * (1.0f / 127.0f) : 1.0f;
}
__device__ __forceinline__ float sumsq(const R16& r) {
    float s = 0.f;
#pragma unroll
    for (int j = 0; j < 4; ++j) s += (r.v[j][0] * r.v[j][0] + r.v[j][1] * r.v[j][1]) + (r.v[j][2] * r.v[j][2] + r.v[j][3] * r.v[j][3]);
    return s;
}
__device__ __forceinline__ float rms_scale(const R16& r) { return 1.0f / sqrtf(wave_sum(sumsq(r)) * (1.0f / 1024.0f) + EPS); }

struct Args { const float* in[24]; float* out; unsigned char* ws; int ph_lo, ph_hi; };
enum { I_X = 0, I_C, I_CTX, I_CCTX, I_ADAW, I_ADAB, I_PREMIX, I_POSTMIX, I_PREFFN, I_POSTFFN, I_CWIN, I_CK, I_CWOUT, I_WQKV, I_LQ1, I_LK1, I_LQ2, I_LK2, I_SUBLN, I_WO, I_ROUTER, I_WG, I_WU, I_WDN };
constexpr int N_PHASES = 19;

__device__ __forceinline__ void titem_decode(const Args& a, int it, const float*& src, unsigned char*& dst, int& N, int& K, int& f8) {
    unsigned char* ws = a.ws; int r = it;
    if (r < 768) {
        const int kb = r / 96, nb = r % 96, n0 = nb * 32, part = n0 >> 10, ch = n0 & 1023;
        const int drow = (part == 0) ? (2048 + ch) : ((ch >> 7) * 256 + (ch & 127) + (part == 2 ? 128 : 0));
        N = 3072; f8 = CIN_I8 ? 2 : (CONV8 ? 1 : 0); K = f8 ? 1024 : 2048; src = a.in[I_CWIN] + (size_t)(kb * 128) * 3072 + n0; dst = ws + WS_WIN + (size_t)drow * K + kb * (f8 ? 128 : 256); return; }
    r -= 768;
    if (r < 256) { const int kb = r / 32, nb = r % 32; N = 1024; f8 = COUT_I8 ? 2 : (CONVO8 ? 1 : 0); K = f8 ? 1024 : 2048; src = a.in[I_CWOUT] + (size_t)(kb * 128) * 1024 + nb * 32; dst = ws + WS_WOUT + (size_t)(nb * 32) * K + kb * (f8 ? 128 : 256); return; }
    r -= 256;
    if (r < 768) { const int kb = r / 96, nb = r % 96; N = 3072; f8 = QKV_I8 ? 2 : (ATT8 ? 1 : 0); K = f8 ? 1024 : 2048; src = a.in[I_WQKV] + (size_t)(kb * 128) * 3072 + nb * 32; dst = ws + WS_WQKV + (size_t)(nb * 32) * K + kb * (f8 ? 128 : 256); return; }
    r -= 768;
    if (r < 256) { const int kb = r / 32, nb = r % 32; N = 1024; f8 = ATT8 ? 1 : 0; K = ATT8 ? 1024 : 2048; src = a.in[I_WO] + (size_t)(kb * 128) * 1024 + nb * 32; dst = ws + WS_WO + (size_t)(nb * 32) * K + kb * (ATT8 ? 128 : 256); return; }
    r -= 256;
    const int seg = r >> 13, which = seg % 3, le = (seg / 3) * 16 + ((r & 8191) >> 9), item = r & 511;
    f8 = 1;
    if (which < 2) {             f8 = UP_I8 ? 2 : 1;
        const int kb = item >> 6, nb = item & 63, f0 = nb * 32, drow = (f0 >> 7) * 256 + (f0 & 127) + (which ? 128 : 0);
        N = 2048; K = 1024; src = a.in[which ? I_WU : I_WG] + (size_t)le * 1024 * 2048 + (size_t)(kb * 128) * 2048 + f0; dst = ws + WS_WGU8 + ((size_t)le * 4096 + drow) * 1024 + kb * 128;
    } else {
        const int kb = item >> 5, nb = item & 31;
        N = 1024; K = 2048; src = a.in[I_WDN] + (size_t)le * 2048 * 1024 + (size_t)(kb * 128) * 1024 + nb * 32; dst = ws + WS_WD8 + ((size_t)le * 1024 + nb * 32) * 2048 + kb * 128;
    }
}

constexpr int I_SMALL = 768 + 256 + 768 + 256, I_MOE = 16384, NITEMS = I_SMALL + 3 * I_MOE;
enum { DS_TOPK1 = 0, DS_QKV, DS_DOWN0, DS_TOPK0, DS_COUT, DS_CIN, DS_N };
#ifndef DEFQ
#define DEFQ {4, 3, 6, 4, 2, 6}
#endif
__device__ __forceinline__ int def_idle_waves(int slot, int G) {
    const int NGW = G * NWAVES;
    if (slot == DS_TOPK0) return NGW > 512 ? NGW - 512 : 0;
    if (slot == DS_TOPK1) return NGW > 256 ? NGW - 256 : 0;
    const int units = (slot == DS_CIN) ? (MA / 256) * 12 : (slot == DS_COUT) ? (MA / 256) * 4 : (slot == DS_DOWN0) ? (NPL + NPC) * 4 : 128 * 12 + 16 * 8, rem = units % G;
    return rem ? (G - rem) * NWAVES : 0; }
__device__ __forceinline__ int def_count(int slot, int G) { constexpr int q[DS_N] = DEFQ; return (G == 256) ? q[slot] * def_idle_waves(slot, G) : 0; }
__device__ __forceinline__ int def_base(int slot, int G) { int b = NITEMS; for (int s = 0; s <= slot; ++s) b -= def_count(s, G); return b; }
__device__ __forceinline__ void copy_items(const Args& a, LAS float* scr, int lane, int it0, int step, int it_end) {
    if (it0 < it_end) {
        const float* src; unsigned char* dst; int N, K; int f8;
        f32x4 buf[16];
#define ITEM_LOAD() do { _Pragma("unroll") for (int i = 0; i < 16; ++i) buf[i] = *(const f32x4*)(src + (size_t)(8 * i + (lane >> 3)) * N + 4 * (lane & 7)); } while (0)
        int it = it0;
        titem_decode(a, it, src, dst, N, K, f8); ITEM_LOAD();
        for (;;) {
#pragma unroll
            for (int i = 0; i < 16; ++i) { LAS float* d = scr + (8 * i + (lane >> 3)) * 33 + 4 * (lane & 7); d[0] = buf[i][0]; d[1] = buf[i][1]; d[2] = buf[i][2]; d[3] = buf[i][3]; }
            unsigned char* cdst = dst; const int cK = K; const int cf8 = f8;
            const int nxt = it + step; const bool has = nxt < it_end;
            if (has) { titem_decode(a, nxt, src, dst, N, K, f8); ITEM_LOAD(); }
            LDS_WAIT(); asm volatile("" ::: "memory");
            const int c = lane & 15;
            if (cf8 == 2) {
#pragma unroll
                for (int j = 0; j < 8; ++j) { const int n = (lane >> 4) + 4 * j; const LAS float* s = scr + (8 * c) * 33 + n;
                    v2u o; o.x = pg8::pk4_i8(s[0 * 33] * WS8, s[1 * 33] * WS8, s[2 * 33] * WS8, s[3 * 33] * WS8); o.y = pg8::pk4_i8(s[4 * 33] * WS8, s[5 * 33] * WS8, s[6 * 33] * WS8, s[7 * 33] * WS8);
                    *(GAS v2u*)(cdst + (size_t)n * cK + 8 * c) = o; }
            } else if (cf8 == 1) {
#pragma unroll
                for (int j = 0; j < 8; ++j) { const int n = (lane >> 4) + 4 * j; const LAS float* s = scr + (8 * c) * 33 + n;
                    v2u o; o.x = pg8::pk4_fp8(s[0 * 33] * WSCALE, s[1 * 33] * WSCALE, s[2 * 33] * WSCALE, s[3 * 33] * WSCALE); o.y = pg8::pk4_fp8(s[4 * 33] * WSCALE, s[5 * 33] * WSCALE, s[6 * 33] * WSCALE, s[7 * 33] * WSCALE);
                    *(GAS v2u*)(cdst + (size_t)n * cK + 8 * c) = o; }
            } else {
#pragma unroll
                for (int j = 0; j < 8; ++j) { const int n = (lane >> 4) + 4 * j; const LAS float* s = scr + (8 * c) * 33 + n;
                    v4u o; o.x = pk2(s[0 * 33], s[1 * 33]); o.y = pk2(s[2 * 33], s[3 * 33]); o.z = pk2(s[4 * 33], s[5 * 33]); o.w = pk2(s[6 * 33], s[7 * 33]);
                    *(GAS v4u*)(cdst + (size_t)n * cK + 16 * c) = o; }
            }
            LDS_WAIT(); asm volatile("" ::: "memory");
            if (!has) break;
            it = nxt;
        }
#undef ITEM_LOAD
    }
}
__device__ __forceinline__ void tail_items(const Args& a, LAS unsigned char* lds, int slot, int units, int G, int bx, int wave, int lane) {
    const int rem = units % G;
    if (rem != 0 && bx >= rem) { const int idle = def_idle_waves(slot, G), base = def_base(slot, G);
        copy_items(a, (LAS float*)(lds + wave * (128 * 33 * 4)), lane, base + (bx - rem) * NWAVES + wave, idle, base + def_count(slot, G)); }
}
__device__ __forceinline__ void phase_prologue_a(const Args& a, LAS unsigned char* lds, int vcu, int G, int wave, int lane, int tid) {
    unsigned char* ws = a.ws;
    if (vcu < 192) {
        LAS float* sl = (LAS float*)lds;
        LAS float* red = sl + 17 * 1024;
        const float* c = a.in[I_C]; const float* cc = a.in[I_CCTX];
        for (int idx = tid; idx < 17 * 1024; idx += 512) { const int r = idx >> 10, k = idx & 1023; const float v = (r < 16) ? c[r * 1024 + k] : cc[k]; sl[idx] = v / (1.0f + __expf(-v)); }
        __syncthreads();
        const int layer = vcu / 96, n0 = (vcu % 96) * 64;
        const float* W = a.in[I_ADAW] + (size_t)layer * 1024 * NMOD + n0 + lane;
        float acc[17];
#pragma unroll
        for (int r = 0; r < 17; ++r) acc[r] = 0.f;
        const int k0 = wave * 128;
#pragma unroll 2
        for (int kk = 0; kk < 128; kk += 4) {
            const float w0 = W[(size_t)(k0 + kk) * NMOD], w1 = W[(size_t)(k0 + kk + 1) * NMOD], w2 = W[(size_t)(k0 + kk + 2) * NMOD], w3 = W[(size_t)(k0 + kk + 3) * NMOD];
#pragma unroll
            for (int r = 0; r < 17; ++r) { const f32x4 s = *(const LAS f32x4*)(sl + r * 1024 + k0 + kk); acc[r] += (s[0] * w0 + s[1] * w1) + (s[2] * w2 + s[3] * w3); }
        }
#pragma unroll
        for (int r = 0; r < 17; ++r) red[(wave * 17 + r) * 64 + lane] = acc[r];
        __syncthreads();
        float* MOD = (float*)(ws + WS_MOD);
        for (int idx = tid; idx < 17 * 64; idx += 512) { const int r = idx >> 6, l = idx & 63; float s = 0.f;
#pragma unroll
            for (int w = 0; w < 8; ++w) s += red[(w * 17 + r) * 64 + l];
            MOD[(size_t)(layer * 17 + r) * NMOD + n0 + l] = s + a.in[I_ADAB][layer * NMOD + n0 + l]; }
        __syncthreads();
    }
    if (vcu == G - 1) { float* rt = (float*)(ws + WS_ROPE);
#pragma unroll 1
        for (int f = 2 * wave; f < 2 * wave + 2; ++f) { const float inv = 1.0f / powf(10000.0f, (float)f / 16.0f); const float ang = (float)lane * inv; rt[lane * 32 + f] = cosf(ang); rt[lane * 32 + 16 + f] = sinf(ang); } }
    LAS float* scr = (LAS float*)(lds + wave * (128 * 33 * 4));
    const int gw = vcu * NWAVES + wave, NGW = G * NWAVES;
    copy_items(a, scr, lane, gw, NGW, def_base(DS_N - 1, G));
}

__device__ __forceinline__ void phase_prologue_b(const Args& a, int gw, int NGW, int lane) {
    const float* MOD = (const float*)(a.ws + WS_MOD); bf16* H = (bf16*)(a.ws + WS_H);
    R16 g; ld_f32(g, a.in[I_PREMIX], lane);
    const int rpw = (MA + NGW - 1) / NGW, m_begin = gw * rpw, m_end = (m_begin + rpw < MA) ? m_begin + rpw : MA;
    int cur_b = -1; R16 sh, sc, nx;
#define PB_PREF(mrow_) do { const int m_ = (mrow_); ld_f32(nx, (m_ < ML) ? a.in[I_X] + (size_t)m_ * D : a.in[I_CTX] + (size_t)(m_ - ML) * D, lane); } while (0)
    if (m_begin < m_end) PB_PREF(m_begin);
    for (int m = m_begin; m < m_end; ++m) {
        const int brow = (m < ML) ? (m >> 11) : 16;
        if (brow != cur_b) { const float* md = MOD + (size_t)brow * NMOD; ld_f32(sh, md, lane); ld_f32(sc, md + 1024, lane); cur_b = brow; }
        R16 x = nx;
        if (m + 1 < m_end) PB_PREF(m + 1);
        const float rs = rms_scale(x);
#pragma unroll
        for (int j = 0; j < 4; ++j) x.v[j] = (x.v[j] * rs) * g.v[j] * (sc.v[j] + 1.0f) + sh.v[j];
        if constexpr (CIN_I8) st_i8(a.ws + WS_H + (size_t)m * D, (float*)(a.ws + WS_SAH) + m, lane, x);
        else if constexpr (CONV8) st_fp8(a.ws + WS_H + (size_t)m * D, lane, x); else st_bf16(H + (size_t)m * D, lane, x);
    }
#undef PB_PREF
}

__device__ __forceinline__ void phase_conv(const Args& a, int gw, int NGW, int lane) {
    const bf16* Bg = (const bf16*)(a.ws + WS_BUF1); const bf16* U = (const bf16*)(a.ws + WS_BUF2); bf16* Z = (bf16*)(a.ws + WS_H);
    float k0[16], k1[16], k2[16];
#pragma unroll
    for (int i = 0; i < 16; ++i) { k0[i] = a.in[I_CK][lane * 16 + i]; k1[i] = a.in[I_CK][1024 + lane * 16 + i]; k2[i] = a.in[I_CK][2048 + lane * 16 + i]; }
    const int rpw = (MA + NGW - 1) / NGW, m_begin = gw * rpw, m_end = (m_begin + rpw < MA) ? m_begin + rpw : MA;
    const v4u zero = {0u, 0u, 0u, 0u};
    v4u rm[2], r0[2], rp[2], nb[2];
#define CV_ROW(dst, mrow_) do { const int m_ = (mrow_); if (m_ >= 0 && m_ < MA) { const v4u* p_ = (const v4u*)(U + (size_t)m_ * D + lane * 16); dst[0] = p_[0]; dst[1] = p_[1]; } else { dst[0] = zero; dst[1] = zero; } } while (0)
    if (m_begin < m_end) { CV_ROW(rm, m_begin - 1); CV_ROW(r0, m_begin); CV_ROW(rp, m_begin + 1); const v4u* br = (const v4u*)(Bg + (size_t)m_begin * D + lane * 16); nb[0] = br[0]; nb[1] = br[1]; }
    for (int m = m_begin; m < m_end; ++m) {
        int t, n; if (m < ML) { t = m & 2047; n = 2048; } else { t = (m - ML) & 255; n = 256; }
        v4u b[2], u0[2], um[2], up[2];
        b[0] = nb[0]; b[1] = nb[1]; u0[0] = r0[0]; u0[1] = r0[1];
        if (t > 0) { um[0] = rm[0]; um[1] = rm[1]; } else { um[0] = zero; um[1] = zero; }
        if (t < n - 1) { up[0] = rp[0]; up[1] = rp[1]; } else { up[0] = zero; up[1] = zero; }
        rm[0] = r0[0]; rm[1] = r0[1]; r0[0] = rp[0]; r0[1] = rp[1];
        if (m + 1 < m_end) { CV_ROW(rp, m + 2); const v4u* br = (const v4u*)(Bg + (size_t)(m + 1) * D + lane * 16); nb[0] = br[0]; nb[1] = br[1]; }
        v4u z[2]; float zf[16];
#pragma unroll
        for (int h = 0; h < 2; ++h)
#pragma unroll
            for (int q = 0; q < 4; ++q) { const int i = h * 8 + q * 2;
                const float lo = bflo(b[h][q]) * (k0[i] * bflo(um[h][q]) + k1[i] * bflo(u0[h][q]) + k2[i] * bflo(up[h][q]));
                const float hi = bfhi(b[h][q]) * (k0[i + 1] * bfhi(um[h][q]) + k1[i + 1] * bfhi(u0[h][q]) + k2[i + 1] * bfhi(up[h][q]));
                if constexpr (COUT_I8) { zf[i] = lo; zf[i + 1] = hi; } else z[h][q] = pk2(lo, hi); }
        if constexpr (COUT_I8) {
            float mx = 0.f;
#pragma unroll
            for (int i = 0; i < 16; ++i) mx = fmaxf(mx, fabsf(zf[i]));
#pragma unroll
            for (int o = 1; o < 64; o <<= 1) mx = fmaxf(mx, __shfl_xor(mx, o));
            const float inv = (mx > 0.f) ? 127.0f / mx : 0.f; v4u w8;
#pragma unroll
            for (int q2 = 0; q2 < 4; ++q2) w8[q2] = pg8::pk4_i8(zf[4 * q2] * inv, zf[4 * q2 + 1] * inv, zf[4 * q2 + 2] * inv, zf[4 * q2 + 3] * inv);
            *(v4u*)(a.ws + WS_H + (size_t)m * D + lane * 16) = w8;
            if (lane == 0) ((float*)(a.ws + WS_SAH))[m] = (mx > 0.f) ? mx * (1.0f / 127.0f) : 1.0f;
        } else
        if constexpr (CONVO8) { v4u w8;
#pragma unroll
            for (int q2 = 0; q2 < 4; ++q2) { const unsigned lo = z[q2 >> 1][(q2 & 1) * 2], hi = z[q2 >> 1][(q2 & 1) * 2 + 1]; w8[q2] = pg8::pk4_fp8(bflo(lo), bfhi(lo), bflo(hi), bfhi(hi)); }
            *(v4u*)(a.ws + WS_H + (size_t)m * D + lane * 16) = w8; }
        else { v4u* zr = (v4u*)(Z + (size_t)m * D + lane * 16); zr[0] = z[0]; zr[1] = z[1]; }
    }
#undef CV_ROW
}

__device__ __forceinline__ void phase_postmix(const Args& a, int layer, LAS unsigned char* lds, int gw, int NGW, int lane, int tid) {
    const float* MOD = (const float*)(a.ws + WS_MOD); unsigned char* H8 = a.ws + WS_H8; const bf16* Mb = (const bf16*)(a.ws + WS_BUF1);
    float* AFF = (float*)(a.ws + WS_AFF); bf16* XR = (bf16*)(a.ws + WS_XR);
    const int nrows = (layer == 0) ? MA : ML;
    LAS f32x4* wl = (LAS f32x4*)lds;
    const f32x4* rw = (const f32x4*)(a.in[I_ROUTER] + (size_t)layer * D * NE);
    for (int idx = tid; idx < 4096; idx += 512) { const int k = idx >> 2, c = idx & 3, j = k >> 8, l = (k >> 2) & 63, i = k & 3; wl[((j * 4 + i) * 4 + c) * 64 + l] = rw[idx]; }
    __syncthreads();
    R16 gpm, gpf; ld_f32(gpm, a.in[I_POSTMIX] + layer * D, lane); ld_f32(gpf, a.in[I_PREFFN] + layer * D, lane);
    const int rpw = (nrows + NGW - 1) / NGW, m_begin = gw * rpw, m_end = (m_begin + rpw < nrows) ? m_begin + rpw : nrows;
    int cur_b = -1; R16 t0, sh, sc; v2u nmm[4], nxb[4]; f32x4 nxf[4];
#define PM_PREF(mrow_) do { const int m_ = (mrow_); _Pragma("unroll") for (int j = 0; j < 4; ++j) nmm[j] = ((const v2u*)(Mb + (size_t)m_ * D))[lane + 64 * j]; \
        if (layer == 0) { const f32x4* xp_ = (const f32x4*)((m_ < ML) ? a.in[I_X] + (size_t)m_ * D : a.in[I_CTX] + (size_t)(m_ - ML) * D); _Pragma("unroll") for (int j = 0; j < 4; ++j) nxf[j] = xp_[lane + 64 * j]; } \
        else { _Pragma("unroll") for (int j = 0; j < 4; ++j) nxb[j] = ((const v2u*)(XR + (size_t)m_ * D))[lane + 64 * j]; } } while (0)
    if (m_begin < m_end) PM_PREF(m_begin);
    for (int m = m_begin; m < m_end; ++m) {
        asm volatile("" ::: "memory");
        const int brow = (m < ML) ? (m >> 11) : 16;
        if (brow != cur_b) { const float* md = MOD + (size_t)(layer * 17 + brow) * NMOD; ld_f32(t0, md + 2048, lane); ld_f32(sh, md + 3072, lane); ld_f32(sc, md + 4096, lane); cur_b = brow; }
        R16 mm, x;
#pragma unroll
        for (int j = 0; j < 4; ++j) { mm.v[j] = (f32x4){bflo(nmm[j].x), bfhi(nmm[j].x), bflo(nmm[j].y), bfhi(nmm[j].y)};
            if (layer == 0) x.v[j] = nxf[j]; else x.v[j] = (f32x4){bflo(nxb[j].x), bfhi(nxb[j].x), bflo(nxb[j].y), bfhi(nxb[j].y)}; }
        if (m + 1 < m_end) PM_PREF(m + 1);
        const float rs = rms_scale(mm);
#pragma unroll
        for (int j = 0; j < 4; ++j) x.v[j] = x.v[j] + t0.v[j] * ((mm.v[j] * rs) * gpm.v[j]);
        st_bf16(XR + (size_t)m * D, lane, x);
        const float rs2 = rms_scale(x);
#pragma unroll
        for (int j = 0; j < 4; ++j) x.v[j] = (x.v[j] * rs2) * gpf.v[j] * (sc.v[j] + 1.0f) + sh.v[j];
#pragma unroll
        for (int j = 0; j < 4; ++j) if constexpr (!UP_I8) ((unsigned*)(H8 + (size_t)m * D))[lane + 64 * j] = pg8::pk4_fp8(x.v[j][0], x.v[j][1], x.v[j][2], x.v[j][3]);
        if constexpr (UP_I8) st_i8(H8 + (size_t)m * D, (float*)(a.ws + WS_SAH2) + m, lane, x);
        f32x4 lgv[4];
#pragma unroll
        for (int c = 0; c < 4; ++c) lgv[c] = (f32x4){0.f, 0.f, 0.f, 0.f};
#pragma unroll
        for (int j = 0; j < 4; ++j)
#pragma unroll
            for (int i = 0; i < 4; ++i) { const float hv = x.v[j][i];
#pragma unroll
                for (int c = 0; c < 4; ++c) { const f32x4 w = wl[((j * 4 + i) * 4 + c) * 64 + lane]; lgv[c] = lgv[c] + w * hv; } }
        float lg[16];
#pragma unroll
        for (int e = 0; e < 16; ++e) lg[e] = lgv[e >> 2][e & 3];
        { const bool up = (lane & 32) != 0;
#pragma unroll
          for (int i = 0; i < 8; ++i) { const float snd = up ? lg[i] : lg[i + 8]; const float rcv = __shfl_xor(snd, 32); lg[i] = (up ? lg[i + 8] : lg[i]) + rcv; } }
        { const bool up = (lane & 16) != 0;
#pragma unroll
          for (int i = 0; i < 4; ++i) { const float snd = up ? lg[i] : lg[i + 4]; const float rcv = __shfl_xor(snd, 16); lg[i] = (up ? lg[i + 4] : lg[i]) + rcv; } }
        { const bool up = (lane & 8) != 0;
#pragma unroll
          for (int i = 0; i < 2; ++i) { const float snd = up ? lg[i] : lg[i + 2]; const float rcv = __shfl_xor(snd, 8); lg[i] = (up ? lg[i + 2] : lg[i]) + rcv; } }
        { const bool up = (lane & 4) != 0; const float snd = up ? lg[0] : lg[1]; const float rcv = __shfl_xor(snd, 4); lg[0] = (up ? lg[1] : lg[0]) + rcv; }
        float lgt = lg[0]; lgt += __shfl_xor(lgt, 2); lgt += __shfl_xor(lgt, 1);
        float mx = lgt;
#pragma unroll
        for (int o = 4; o < 64; o <<= 1) mx = fmaxf(mx, __shfl_xor(mx, o));
        const float ex = __expf(lgt - mx); float sm = ex;
#pragma unroll
        for (int o = 4; o < 64; o <<= 1) sm += __shfl_xor(sm, o);
        if ((lane & 3) == 0) AFF[(size_t)(lane >> 2) * MA + m] = ex / sm;
    }
#undef PM_PREF
    __syncthreads();
}

template <int NJ>
__device__ __forceinline__ void topk_select(const float* AFF, int* INV, int* RIDX, const float* SAH2, float* SAG, int rowbase, int e, int cap, int xsbase, int lane) {
    unsigned key[NJ];
#pragma unroll
    for (int j = 0; j < NJ; ++j) key[j] = __float_as_uint(AFF[(size_t)e * MA + rowbase + j * 64 + lane]);
    unsigned prefix = 0u;
    for (int bit = 30; bit >= 0; --bit) {
        const unsigned cand = prefix | (1u << bit); int cnt = 0;
#pragma unroll
        for (int j = 0; j < NJ; ++j) cnt += __popcll(__ballot(key[j] >= cand));
        if (cnt >= cap) prefix = cand;
    }
    const unsigned T = prefix; int ngt = 0;
#pragma unroll
    for (int j = 0; j < NJ; ++j) ngt += __popcll(__ballot(key[j] > T));
    const int need = cap - ngt; const unsigned long long lt = (1ull << lane) - 1ull;
    int selbase = 0, eqbase = 0;
#pragma unroll
    for (int j = 0; j < NJ; ++j) {
        const bool gt = key[j] > T, eq = key[j] == T; const unsigned long long eqm = __ballot(eq); const int eqr = eqbase + __popcll(eqm & lt);
        const bool sel = gt || (eq && eqr < need); const unsigned long long sm = __ballot(sel); const int slot = selbase + __popcll(sm & lt);
        const int t = j * 64 + lane;
        if (sel) { RIDX[xsbase + slot] = rowbase + t; if constexpr (UP_I8) SAG[xsbase + slot] = SAH2[rowbase + t]; }
        INV[(size_t)e * MA + rowbase + t] = sel ? (xsbase + slot) : -1;
        selbase += __popcll(sm); eqbase += __popcll(eqm);
    }
}
__device__ __forceinline__ void phase_topk(const Args& a, int layer, LAS unsigned char* lds, int gw, int NGW, int lane) {
    const float* AFF = (const float*)(a.ws + WS_AFF); int* INV = (int*)(a.ws + WS_INV); int* RIDX = (int*)(a.ws + WS_RIDX);
    const float* SAH2 = (const float*)(a.ws + WS_SAH2); float* SAG = (float*)(a.ws + WS_SAG);
    const int nitems = (layer == 0) ? 512 : 256;
    for (int it = gw; it < nitems; it += NGW) {
        if (it < 256) { const int e = it >> 4, b = it & 15; topk_select<32>(AFF, INV, RIDX, SAH2, SAG, b * SEQ, e, CAPL, it * 256, lane); }
        else { const int j = it - 256, e = j >> 4, b = j & 15; topk_select<4>(AFF, INV, RIDX, SAH2, SAG, ML + b * CTX, e, CAPC, (NPL + e * 2 + (b >> 3)) * 256 + (b & 7) * CAPC, lane); }
    }
    if (gw >= nitems) { const int G_ = NGW / NWAVES, slot = (layer == 0) ? DS_TOPK0 : DS_TOPK1, idle = def_idle_waves(slot, G_), base = def_base(slot, G_);
        copy_items(a, (LAS float*)(lds + (gw / G_) * (128 * 33 * 4)), lane, base + (gw - nitems), idle, base + def_count(slot, G_)); }
}

__device__ __forceinline__ void phase_combine(const Args& a, int layer, int gw, int NGW, int lane) {
    const float* MOD = (const float*)(a.ws + WS_MOD); bf16* H = (bf16*)(a.ws + WS_H); const unsigned char* Y = a.ws + WS_Y;
    const float* AFF = (const float*)(a.ws + WS_AFF); const int* INV = (const int*)(a.ws + WS_INV); bf16* XR = (bf16*)(a.ws + WS_XR);
    const int nrows = (layer == 0) ? MA : ML;
    R16 gpo, gnx; ld_f32(gpo, a.in[I_POSTFFN] + layer * D, lane); ld_f32(gnx, a.in[I_PREMIX] + D, lane);
    const int rpw = (nrows + NGW - 1) / NGW, m_begin = gw * rpw, m_end = (m_begin + rpw < nrows) ? m_begin + rpw : nrows;
    int cur_b = -1; R16 g2, sh1, sc1;
    int inv_n = -1; float af_n = 0.f;
    int ninv_c = -1; float naf_c = 0.f; unsigned nyw[4][4]; float ngk[4]; unsigned nrest = 0; v2u nxr[4];
#define CB_IDX(mrow_, iv_, av_) do { const int m_ = (mrow_); const bool ok_ = (lane < 16) && (m_ < m_end); iv_ = ok_ ? INV[(size_t)lane * MA + m_] : -1; av_ = ok_ ? AFF[(size_t)lane * MA + m_] : 0.f; } while (0)
#define CB_REQ(mrow_, iv_, av_) do { const int m_ = (mrow_); unsigned mk_ = (unsigned)__ballot((iv_) >= 0) & 0xffffu; \
        _Pragma("unroll") for (int k = 0; k < 4; ++k) { int yr_ = 0; float g_ = 0.f;         \
            if (mk_ != 0) { const int e_ = __builtin_ctz(mk_); mk_ &= mk_ - 1; yr_ = __builtin_amdgcn_readlane((iv_), e_); g_ = __uint_as_float((unsigned)__builtin_amdgcn_readlane((int)__float_as_uint(av_), e_)) * (1.0f / YSCALE); } \
            ngk[k] = g_; _Pragma("unroll") for (int j = 0; j < 4; ++j) nyw[k][j] = ((const unsigned*)(Y + (size_t)yr_ * D))[lane + 64 * j]; } \
        nrest = mk_; ninv_c = (iv_); naf_c = (av_); \
        _Pragma("unroll") for (int j = 0; j < 4; ++j) nxr[j] = ((const v2u*)(XR + (size_t)m_ * D))[lane + 64 * j]; } while (0)
    if (m_begin < m_end) { int iv0; float av0; CB_IDX(m_begin, iv0, av0); CB_REQ(m_begin, iv0, av0); CB_IDX(m_begin + 1, inv_n, af_n); }
    for (int m = m_begin; m < m_end; ++m) {
        const int brow = (m < ML) ? (m >> 11) : 16;
        if (brow != cur_b) { const float* md = MOD + (size_t)(layer * 17 + brow) * NMOD; ld_f32(g2, md + 5120, lane);
            if (layer == 0) { const float* md1 = MOD + (size_t)(17 + brow) * NMOD; ld_f32(sh1, md1, lane); ld_f32(sc1, md1 + 1024, lane); } cur_b = brow; }
        unsigned yw[4][4]; float gk[4]; const unsigned rest = nrest; const int inv = ninv_c; const float af = naf_c; R16 x;
#pragma unroll
        for (int k = 0; k < 4; ++k) { gk[k] = ngk[k];
#pragma unroll
            for (int j = 0; j < 4; ++j) yw[k][j] = nyw[k][j]; }
#pragma unroll
        for (int j = 0; j < 4; ++j) x.v[j] = (f32x4){bflo(nxr[j].x), bfhi(nxr[j].x), bflo(nxr[j].y), bfhi(nxr[j].y)};
        if (m + 1 < m_end) { CB_REQ(m + 1, inv_n, af_n); CB_IDX(m + 2, inv_n, af_n); }
        R16 f;
#pragma unroll
        for (int j = 0; j < 4; ++j) f.v[j] = (f32x4){0.f, 0.f, 0.f, 0.f};
#pragma unroll
        for (int k = 0; k < 4; ++k)
#pragma unroll
            for (int j = 0; j < 4; ++j) { const auto lo = __builtin_amdgcn_cvt_pk_f32_fp8((int)yw[k][j], false), hi = __builtin_amdgcn_cvt_pk_f32_fp8((int)yw[k][j], true);
                f.v[j] = f.v[j] + (f32x4){lo[0], lo[1], hi[0], hi[1]} * gk[k]; }
        for (unsigned mk = rest; mk != 0; mk &= mk - 1) { const int e = __builtin_ctz(mk); const int yr = __builtin_amdgcn_readlane(inv, e);
            const float gt = __uint_as_float((unsigned)__builtin_amdgcn_readlane((int)__float_as_uint(af), e)) * (1.0f / YSCALE);
#pragma unroll
            for (int j = 0; j < 4; ++j) { const unsigned w = ((const unsigned*)(Y + (size_t)yr * D))[lane + 64 * j];
                const auto lo = __builtin_amdgcn_cvt_pk_f32_fp8((int)w, false), hi = __builtin_amdgcn_cvt_pk_f32_fp8((int)w, true); f.v[j] = f.v[j] + (f32x4){lo[0], lo[1], hi[0], hi[1]} * gt; } }
        const float rs = rms_scale(f);
#pragma unroll
        for (int j = 0; j < 4; ++j) x.v[j] = x.v[j] + g2.v[j] * ((f.v[j] * rs) * gpo.v[j]);
        if (layer == 0) st_bf16(XR + (size_t)m * D, lane, x); else st_f32(a.out + (size_t)m * D, lane, x);
        if (layer == 0) {
            const float rs2 = rms_scale(x);
#pragma unroll
            for (int j = 0; j < 4; ++j) x.v[j] = (x.v[j] * rs2) * gnx.v[j] * (sc1.v[j] + 1.0f) + sh1.v[j];
            if constexpr (QKV_I8) st_i8(a.ws + WS_H + (size_t)m * D, (float*)(a.ws + WS_SAH) + m, lane, x);
            else if constexpr (ATT8) st_fp8(a.ws + WS_H + (size_t)m * D, lane, x); else st_bf16(H + (size_t)m * D, lane, x);
        }
    }
#undef CB_IDX
#undef CB_REQ
}

constexpr float LAM_INIT = 0.35550906759096926f;
__device__ __forceinline__ void phase_finish(const Args& a, int gw, int NGW, int lane) {
    const bf16* OP = (const bf16*)(a.ws + WS_OPART); bf16* A2 = (bf16*)(a.ws + WS_BUF3);
    const float s1 = wave_sum(a.in[I_LQ1][lane] * a.in[I_LK1][lane]), s2 = wave_sum(a.in[I_LQ2][lane] * a.in[I_LK2][lane]);
    const float lam = expf(s1) - expf(s2) + LAM_INIT;
    const int h = lane >> 3, sub = lane & 7;
    float g[16];
#pragma unroll
    for (int i = 0; i < 16; ++i) g[i] = a.in[I_SUBLN][sub * 16 + i] * (1.0f - LAM_INIT);
    for (int m = gw; m < ML; m += NGW) {
        const v4u* p0 = (const v4u*)(OP + (size_t)m * 2048 + h * 256 + sub * 16); const v4u* p1 = (const v4u*)(OP + (size_t)m * 2048 + h * 256 + 128 + sub * 16);
        v4u x0[2], x1[2]; x0[0] = p0[0]; x0[1] = p0[1]; x1[0] = p1[0]; x1[1] = p1[1];
        float o[16]; float ss = 0.f;
#pragma unroll
        for (int hh = 0; hh < 2; ++hh)
#pragma unroll
            for (int q = 0; q < 4; ++q) { const int i = hh * 8 + q * 2; o[i] = bflo(x0[hh][q]) - lam * bflo(x1[hh][q]); o[i + 1] = bfhi(x0[hh][q]) - lam * bfhi(x1[hh][q]); ss += o[i] * o[i] + o[i + 1] * o[i + 1]; }
        ss += __shfl_xor(ss, 1); ss += __shfl_xor(ss, 2); ss += __shfl_xor(ss, 4);
        const float rs = 1.0f / sqrtf(ss * (1.0f / 128.0f) + EPS);
        v4u w[2];
#pragma unroll
        for (int hh = 0; hh < 2; ++hh)
#pragma unroll
            for (int q = 0; q < 4; ++q) { const int i = hh * 8 + q * 2; w[hh][q] = pk2(o[i] * rs * g[i], o[i + 1] * rs * g[i + 1]); }
        if constexpr (ATT8) { v4u w8;
#pragma unroll
            for (int q2 = 0; q2 < 4; ++q2) { const int i = q2 * 4; w8[q2] = pg8::pk4_fp8(o[i] * rs * g[i], o[i + 1] * rs * g[i + 1], o[i + 2] * rs * g[i + 2], o[i + 3] * rs * g[i + 3]); }
            *(v4u*)(a.ws + WS_BUF3 + (size_t)m * D + h * 128 + sub * 16) = w8; }
        else { v4u* dst = (v4u*)(A2 + (size_t)m * D + h * 128 + sub * 16); dst[0] = w[0]; dst[1] = w[1]; }
    }
}

__global__ void __launch_bounds__(NWAVES * 64, 2) fwd_kernel(Args args) {
    extern __shared__ __attribute__((aligned(16))) unsigned char lds_raw[];
    LAS unsigned char* lds = (LAS unsigned char*)lds_raw;
    volatile LAS unsigned* MISC = (volatile LAS unsigned*)(lds + MISC_OFF);
    const int tid = threadIdx.x, lane = tid & 63, wave = __builtin_amdgcn_readfirstlane(tid >> 6);
    const int G = gridDim.x; const int bx = blockIdx.x; const int vcu = (G % 8 == 0) ? (bx % 8) * (G / 8) + bx / 8 : bx;
    const int gw = vcu * NWAVES + wave, NGW = G * NWAVES;
    unsigned char* ws = args.ws;
    gu32* ctl = (gu32*)(ws + WS_CTL);
    for (int u = tid; u < (LDS_BYTES - LDSCTL_OFF) / 4; u += NWAVES * 64) ((LAS unsigned*)(lds + LDSCTL_OFF))[u] = 0u;
    __syncthreads();
    XcdBarrier bar; bar.bar = (unsigned*)(ctl + CW_BAR); bar.x = 0; bar.st = nullptr;
    if (!MK_SPLIT) bar = xcd_barrier_post((unsigned*)(ctl + CW_BAR), MISC + 8);
    const int lo = args.ph_lo, hi = args.ph_hi;
#ifndef PH_MASK
#define PH_MASK 0xFFFFFFFFu
#endif
#define IN(k) (((PH_MASK >> (((k) >= 14) ? (k) - 9 : (k))) & 1u) && lo <= (k) && (k) < hi)
#define SEAM(k) do { if (IN(k) && IN((k) + 1)) xcd_barrier(bar); } while (0)
#ifndef DUP_MASK
#define DUP_MASK 0u
#endif
#ifndef PROBE_NULLEPI
#define PROBE_NULLEPI 0
#endif
#ifndef PROBE_ATT
#define PROBE_ATT 0
#endif
#define REPS(k) (((DUP_MASK >> (k)) & 1u) ? 2 : 1)
#define DUPLOOP(k) _Pragma("unroll") for (int rep_ = 0; rep_ < REPS(k); (++rep_ < REPS(k)) ? xcd_barrier(bar) : (void)0)

    bf16* Hb = (bf16*)(ws + WS_H);
    if (IN(0)) DUPLOOP(0) { phase_prologue_a(args, lds, vcu, G, wave, lane_now(), wave * 64 + lane_now()); } SEAM(0);
    if (IN(1)) DUPLOOP(1) { phase_prologue_b(args, gw, NGW, lane_now()); } SEAM(1);

    if (IN(2)) DUPLOOP(2) {
        pg8::Gemm g{Hb, (const bf16*)(ws + WS_WIN), MA, 3072, (CIN_I8 || CONV8) ? D / 2 : D}; pg8::SchedGrid S{MA / 256, 12, G, bx};
        pg8::EpiConvIn E{(bf16*)(ws + WS_BUF2), (bf16*)(ws + WS_BUF1), CIN_I8 ? 1.0f / WS8 : (CONV8 ? 1.0f / WSCALE : 1.0f)};
        if constexpr (CIN_I8) pg8::gemm_phase_i8<pg8::EpiConvIn, pg8::SchedGrid, true, true>(lds, g, S, E, (const float*)(ws + WS_SAH));
        else if constexpr (CONV8) pg8::gemm_phase8<pg8::EpiConvIn, pg8::SchedGrid, true, true>(lds, g, S, E); else pg8::gemm_phase<pg8::EpiConvIn, pg8::SchedGrid, true, true>(lds, g, S, E);
        tail_items(args, lds, DS_CIN, (MA / 256) * 12, G, bx, wave, lane_now());
    } SEAM(2);
    if (IN(3)) DUPLOOP(3) { phase_conv(args, gw, NGW, lane_now()); } SEAM(3);
    if (IN(4)) DUPLOOP(4) {
        pg8::Gemm g{Hb, (const bf16*)(ws + WS_WOUT), MA, D, (COUT_I8 || CONVO8) ? D / 2 : D}; pg8::SchedGrid S{MA / 256, 4, G, bx};
        pg8::EpiPlain E{(bf16*)(ws + WS_BUF1), D, COUT_I8 ? 1.0f / WS8 : (CONVO8 ? 1.0f / WSCALE : 1.0f)};
        if constexpr (COUT_I8) pg8::gemm_phase_i8<pg8::EpiPlain, pg8::SchedGrid, true, true>(lds, g, S, E, (const float*)(ws + WS_SAH));
        else if constexpr (CONVO8) pg8::gemm_phase8<pg8::EpiPlain, pg8::SchedGrid, true, true>(lds, g, S, E); else pg8::gemm_phase<pg8::EpiPlain, pg8::SchedGrid, true, true>(lds, g, S, E);
        tail_items(args, lds, DS_COUT, (MA / 256) * 4, G, bx, wave, lane_now());
    } SEAM(4);

#define FFN_BLOCK(layer, pb) do { \
        constexpr int npanels = ((layer) == 0) ? (NPL + NPC) : NPL; \
        if (IN(pb)) DUPLOOP(pb) { phase_postmix(args, (layer), lds, gw, NGW, lane_now(), wave * 64 + lane_now()); } SEAM(pb); \
        if (IN((pb) + 1)) DUPLOOP((pb) + 1) { phase_topk(args, (layer), lds, wave * G + vcu, NGW, lane_now());     } SEAM((pb) + 1); \
        if (IN((pb) + 2)) DUPLOOP((pb) + 2) { \
            pg8::Gemm g{(const bf16*)(ws + WS_H8), (const bf16*)(ws + WS_WGU8 + (size_t)(layer) * NE * 4096 * D), npanels * 256, 4096, D / 2}; pg8::SchedMoE S{npanels, 16, G, bx}; \
            pg8::EpiSwiGLU8 E{ws + WS_HID8, FF, UP_I8 ? 1.0f / WS8 : 1.0f / WSCALE, HSCALE}; \
            if (PROBE_NULLEPI == 1 && REPS((pb) + 2) == 2 && rep_ == 0) { pg8::EpiNull E0; pg8::gemm_phase8g<pg8::EpiNull, pg8::SchedMoE, true, true>(lds, g, S, E0, (const int*)(ws + WS_RIDX)); } else \
            if (PROBE_NULLEPI == 2 && REPS((pb) + 2) == 2 && rep_ == 0) { pg8::EpiNull E0; pg8::SchedSame S0{npanels, 16, G, bx}; pg8::gemm_phase8g<pg8::EpiNull, pg8::SchedSame, true, true>(lds, g, S0, E0, (const int*)(ws + WS_RIDX)); } else \
            if constexpr (UP_I8) pg8::gemm_phase_i8g<pg8::EpiSwiGLU8, pg8::SchedMoE, true, true>(lds, g, S, E, (const int*)(ws + WS_RIDX), (const float*)(ws + WS_SAG)); else \
            pg8::gemm_phase8g<pg8::EpiSwiGLU8, pg8::SchedMoE, true, true>(lds, g, S, E, (const int*)(ws + WS_RIDX)); \
        } SEAM((pb) + 2); \
        if (IN((pb) + 3)) DUPLOOP((pb) + 3) { \
            pg8::Gemm g{(const bf16*)(ws + WS_HID8), (const bf16*)(ws + WS_WD8 + (size_t)(layer) * NE * D * FF), npanels * 256, D, FF / 2}; pg8::SchedMoE S{npanels, 4, G, bx}; \
            pg8::EpiPlain8 E{ws + WS_Y, D, YSCALE / (WSCALE * HSCALE)}; \
            pg8::gemm_phase8<pg8::EpiPlain8, pg8::SchedMoE, true, true>(lds, g, S, E); \
            if ((layer) == 0) tail_items(args, lds, DS_DOWN0, npanels * 4, G, bx, wave, lane_now()); \
        } SEAM((pb) + 3); \
        if (IN((pb) + 4)) DUPLOOP((pb) + 4) { phase_combine(args, (layer), gw, NGW, lane_now()); } \
    } while (0)

    FFN_BLOCK(0, 5); SEAM(9);

    if (IN(10)) DUPLOOP(10) {
        pg8::Gemm g{Hb, (const bf16*)(ws + WS_WQKV), MA, 3072, (QKV_I8 || ATT8) ? D / 2 : D}; pg8::SchedQKV S{G, bx};
        pg8::EpiQKV E{(bf16*)(ws + WS_BUF3), (bf16*)(ws + WS_BUF1), (bf16*)(ws + WS_BUF2), (const float*)(ws + WS_ROPE), QSCALE, QKV_I8 ? 1.0f / WS8 : (ATT8 ? 1.0f / WSCALE : 1.0f)};
        if constexpr (QKV_I8) pg8::gemm_phase_i8<pg8::EpiQKV, pg8::SchedQKV, true, true>(lds, g, S, E, (const float*)(ws + WS_SAH));
        else if constexpr (ATT8) pg8::gemm_phase8<pg8::EpiQKV, pg8::SchedQKV, true, true>(lds, g, S, E); else pg8::gemm_phase<pg8::EpiQKV, pg8::SchedQKV, true, true>(lds, g, S, E);
        tail_items(args, lds, DS_QKV, 128 * 12 + 16 * 8, G, bx, wave, lane_now());
    } SEAM(10);
    if (IN(11)) DUPLOOP(11) {
        static_assert(att::ATTN_LDS_TOTAL <= LDSCTL_OFF, "attention LDS");
        const unsigned char* Q = ws + WS_BUF3; const unsigned char* Kb = ws + WS_BUF1;   const unsigned char* Vt = ws + WS_BUF2;   unsigned char* A2 = ws + WS_OPART;
        const float s1 = wave_sum(args.in[I_LQ1][lane_now()] * args.in[I_LK1][lane_now()]), s2 = wave_sum(args.in[I_LQ2][lane_now()] * args.in[I_LK2][lane_now()]);
        const float lam = __uint_as_float(__builtin_amdgcn_readfirstlane(__float_as_uint(expf(s1) - expf(s2) + LAM_INIT)));
        att::v8i qio = {};
        for (int L = vcu; L < 1024; L += G) { const int qb = L & 7, h = (L >> 3) & 7, b = L >> 6;
            const int Ln = L + G; const bool hn = Ln < 1024; const int bhn = hn ? (Ln >> 3) : 0;
            const unsigned char* Kn = hn ? Kb + (size_t)bhn * (2 * 2304 * 64) : nullptr; const unsigned char* Vn = hn ? Vt + (size_t)bhn * (36 * 8192) : nullptr;
            const unsigned char* Qn = hn ? Q + ((size_t)(Ln >> 6) * SEQ + (Ln & 7) * 256) * D + ((Ln >> 3) & 7) * 128 : nullptr;
            if (PROBE_ATT != 0 && REPS(11) == 2 && rep_ == 0) att::attn_diff_unit<ATT8, PROBE_ATT>(Q + ((size_t)b * SEQ + qb * 256) * D + h * 128, Kb + (size_t)(b * 8 + h) * (2 * 2304 * 64), Vt + (size_t)(b * 8 + h) * (36 * 8192), nullptr, nullptr, nullptr, qio, false,
                                      A2 + ((size_t)b * SEQ + qb * 256) * (ATT8 ? D : 2 * D) + h * (ATT8 ? 128 : 256), lam, args.in[I_SUBLN], 1.0f - LAM_INIT, (char*)lds_raw, lds); else
            att::attn_diff_unit<ATT8>(Q + ((size_t)b * SEQ + qb * 256) * D + h * 128, Kb + (size_t)(b * 8 + h) * (2 * 2304 * 64), Vt + (size_t)(b * 8 + h) * (36 * 8192), Kn, Vn, Qn, qio, L != vcu,
                                      A2 + ((size_t)b * SEQ + qb * 256) * (ATT8 ? D : 2 * D) + h * (ATT8 ? 128 : 256), lam, args.in[I_SUBLN], 1.0f - LAM_INIT, (char*)lds_raw, lds); }
    } SEAM(11);
    if (IN(13)) DUPLOOP(13) {
        pg8::Gemm g{(const bf16*)(ws + WS_OPART), (const bf16*)(ws + WS_WO), ML, D, ATT8 ? D / 2 : D}; pg8::SchedGrid S{ML / 256, 4, G, bx};
        pg8::EpiPlain E{(bf16*)(ws + WS_BUF1), D, ATT8 ? 1.0f / WSCALE : 1.0f};
        if constexpr (ATT8) pg8::gemm_phase8<pg8::EpiPlain, pg8::SchedGrid, true, true>(lds, g, S, E); else pg8::gemm_phase<pg8::EpiPlain, pg8::SchedGrid, true, true>(lds, g, S, E);
    } SEAM(13);

    FFN_BLOCK(1, 14);
#undef FFN_BLOCK
#undef IN
#undef SEAM
}

extern "C" void kernel_launch(void* const* d_in, const int* in_sizes, int n_in, void* d_out, int out_size, void* d_ws, size_t ws_size, hipStream_t stream) {
    static int grid = 0;
    if (grid == 0) {
        if (n_in != 24 || in_sizes[0] != ML * D || out_size != ML * D || ws_size < WS_END) {
            fprintf(stderr, "kernel_launch: shape mismatch: n_in %d in0 %d out %d ws %zu (need >= %zu); nothing launched\n", n_in, n_in > 0 ? in_sizes[0] : -1, out_size, ws_size, (size_t)WS_END); grid = -1; return; }
        int dev = 0, cus = 0, per_cu = 0;
        if (hipGetDevice(&dev) != hipSuccess || hipDeviceGetAttribute(&cus, hipDeviceAttributeMultiprocessorCount, dev) != hipSuccess) { fprintf(stderr, "kernel_launch: device query failed\n"); grid = -1; return; }
        if (hipFuncSetAttribute((const void*)fwd_kernel, hipFuncAttributeMaxDynamicSharedMemorySize, LDS_BYTES) != hipSuccess) { fprintf(stderr, "kernel_launch: hipFuncSetAttribute failed\n"); grid = -1; return; }
        if (hipOccupancyMaxActiveBlocksPerMultiprocessor(&per_cu, (const void*)fwd_kernel, NWAVES * 64, LDS_BYTES) != hipSuccess || per_cu < 1)
            fprintf(stderr, "kernel_launch: note: occupancy query reports %d workgroups per CU\n", per_cu);
        (void)hipGetLastError();
        grid = cus;
    }
    if (grid < 0) return;
    if (hipMemsetAsync((char*)d_ws + WS_CTL, 0, CTL_ZERO_BYTES, stream) != hipSuccess) { fprintf(stderr, "kernel_launch: memset failed\n"); return; }
    Args a{};
    for (int i = 0; i < 24; ++i) a.in[i] = (const float*)d_in[i];
    a.out = (float*)d_out; a.ws = (unsigned char*)d_ws;
#if MK_SPLIT
    for (int p = 0; p < N_PHASES; ++p) { a.ph_lo = p; a.ph_hi = p + 1; hipLaunchKernelGGL(fwd_kernel, dim3(grid), dim3(NWAVES * 64), LDS_BYTES, stream, a); }
#else
    a.ph_lo = 0; a.ph_hi = N_PHASES;
    hipLaunchKernelGGL(fwd_kernel, dim3(grid), dim3(NWAVES * 64), LDS_BYTES, stream, a);
#endif
    const hipError_t le = hipPeekAtLastError();
    if (le != hipSuccess) fprintf(stderr, "kernel_launch: launch failed: %s\n", hipGetErrorName(le));
}
```

```cpp
#include <hip/hip_runtime.h>
#include <hip/hip_bf16.h>
#include <cstdio>
#include <cstdint>
#include <cmath>

#ifndef MK_SPLIT
#define MK_SPLIT 0
#endif

namespace pg8 {
#define PG8_LAS __attribute__((address_space(3)))
typedef unsigned short bf16_t;
typedef short bf16x8 __attribute__((ext_vector_type(8)));
typedef float f32x4 __attribute__((ext_vector_type(4)));
typedef unsigned u32x4 __attribute__((ext_vector_type(4)));
constexpr int BM = 256, BK = 64, HALF = 128, HTB = HALF * BK * 2  , STAGE_BYTES = 8 * HTB, NXCD = 8, WGM = 8;

__host__ __device__ __forceinline__ int lds_byte(int r, int c) { const int st = (r >> 4) * 2 + (c >> 5), rr = r & 15, cc = c & 31, ob = rr * 64 + cc * 2; return st * 1024 + (ob ^ (((ob >> 9) & 1) << 5)); }
__host__ __device__ __forceinline__ void stage_rc(int b, int& R, int& C) { const int st = b / 1024, sb = b % 1024, swz = sb ^ (((sb >> 9) & 1) << 5); R = (st >> 1) * 16 + swz / 64; C = (st & 1) * 32 + (swz % 64) / 2; }
__host__ __device__ __forceinline__ int perm32(int rho) { const int n = rho >> 4, i = rho & 15; return 8 * (i >> 2) + 4 * n + (i & 3); }

struct Unit { int pm, pn, pb; };
struct Gemm { const bf16_t* A; const bf16_t* Bt; int M, N, K; };

__device__ __forceinline__ void tile_decode(int L, int nM, int nN, int& pm, int& pn) {
    const int nwg = nM * nN; int wgid = L;
    { const int q = nwg / NXCD, r = nwg % NXCD, xcd = wgid % NXCD, off = wgid / NXCD; wgid = (xcd < r ? xcd * (q + 1) : r * (q + 1) + (xcd - r) * q) + off; }
    const int nig = WGM * nN, gid = wgid / nig, fm = gid * WGM, gsz = (nM - fm) < WGM ? (nM - fm) : WGM;
    pm = fm + ((wgid % nig) % gsz); pn = (wgid % nig) / gsz;
}
__device__ __forceinline__ unsigned cvt_pk_bf16(float lo, float hi) { unsigned r; asm volatile("v_cvt_pk_bf16_f32 %0, %1, %2" : "=v"(r) : "v"(lo), "v"(hi)); return r; }
__device__ __forceinline__ u32x4 pack8(const f32x4 v0, const f32x4 v1) { u32x4 w; w.x = cvt_pk_bf16(v0[0], v0[1]); w.y = cvt_pk_bf16(v0[2], v0[3]); w.z = cvt_pk_bf16(v1[0], v1[1]); w.w = cvt_pk_bf16(v1[2], v1[3]); return w; }

template <class Epi, class Sched, bool ALIGN_EPI = false, bool SP2 = false>
__device__ __forceinline__ void gemm_phase(PG8_LAS unsigned char* lds, const Gemm g, const Sched& S, const Epi& E) {
    const int tid = threadIdx.x, wid = __builtin_amdgcn_readfirstlane(tid >> 6), lane = tid & 63, wr = wid >> 2, wc = wid & 3, fr = lane & 15, fq = lane >> 4;
    const int K = g.K, nt = K / BK;
    unsigned voffA[2], voffB[2];
#pragma unroll
    for (int i = 0; i < 2; ++i) { int R, C; stage_rc(tid * 16 + i * 8192, R, C); const int Rb = Epi::PERM ? ((R & ~31) + perm32(R & 31)) : R;
        voffA[i] = (unsigned)(R * K + C) * 2u; voffB[i] = (unsigned)(Rb * K + C) * 2u; }
    const size_t kstep = (size_t)(BK * 2);
    const size_t hstep = (size_t)HALF * K * 2;
    const size_t tstep = 2 * hstep;
    const unsigned ldsw = (unsigned)wid * 1024u;
    const int aoff = lds_byte(wr * 64 + fr, fq * 8), boff = lds_byte(wc * 32 + fr, fq * 8);
#define PG8_SA(b, h) (((b) * 2 + (h)) * HTB)
#define PG8_SB(b, h) ((4 + (b) * 2 + (h)) * HTB)
#define PG8_STAGE(bufoff, gbase, voff) do { _Pragma("unroll") for (int _i = 0; _i < 2; ++_i) \
        __builtin_amdgcn_global_load_lds((const unsigned*)((const char*)(gbase) + (voff)[_i]), (PG8_LAS unsigned*)(lds + (bufoff) + ldsw + _i * 8192), 16, 0, 0); } while (0)
#define PG8_LDA(dst, b, h) do { _Pragma("unroll") for (int m = 0; m < 4; ++m) _Pragma("unroll") for (int k = 0; k < 2; ++k) dst[m][k] = *(const PG8_LAS bf16x8*)(lds + PG8_SA(b, h) + aoff + m * 2048 + k * 1024); } while (0)
#define PG8_LDB(dst, b, h) do { _Pragma("unroll") for (int n = 0; n < 2; ++n) _Pragma("unroll") for (int k = 0; k < 2; ++k) dst[n][k] = *(const PG8_LAS bf16x8*)(lds + PG8_SB(b, h) + boff + n * 2048 + k * 1024); } while (0)
#define PG8_MMA(ai, bj, At, Bt) do { __builtin_amdgcn_s_setprio(1); _Pragma("unroll") for (int m = 0; m < 4; ++m) _Pragma("unroll") for (int n = 0; n < 2; ++n) _Pragma("unroll") for (int k = 0; k < 2; ++k) \
        acc[ai][bj][m][n] = __builtin_amdgcn_mfma_f32_16x16x32_bf16(Bt[n][k], At[m][k], acc[ai][bj][m][n], 0, 0, 0); __builtin_amdgcn_s_setprio(0); } while (0)
#define PG8_WAIT_V(n) asm volatile("s_waitcnt vmcnt(" #n ")" ::: "memory")
#define PG8_WAIT_L(n) asm volatile("s_waitcnt lgkmcnt(" #n ")" ::: "memory")
#define PG8_BAR __builtin_amdgcn_s_barrier()
#define PG8_SCHED __builtin_amdgcn_sched_barrier(0)
    Unit cur, nxt; int ui = 0;
    if (!S.next(0, cur)) return;
    f32x4 acc[2][2][4][2];
#pragma unroll
    for (int a = 0; a < 2; ++a)
#pragma unroll
        for (int b = 0; b < 2; ++b)
#pragma unroll
            for (int m = 0; m < 4; ++m)
#pragma unroll
                for (int n = 0; n < 2; ++n) acc[a][b][m][n] = (f32x4){0.f, 0.f, 0.f, 0.f};
    bf16x8 At[4][2], B0[2][2], B1[2][2];
    const char* cA = (const char*)g.A + (size_t)cur.pm * tstep; const char* cB = (const char*)g.Bt + (size_t)cur.pb * tstep;
    S.a_ready(cur);
    if constexpr (SP2) {
        PG8_STAGE(PG8_SB(0, 0), cB, voffB); PG8_STAGE(PG8_SB(0, 1), cB + hstep, voffB); PG8_STAGE(PG8_SA(0, 0), cA, voffA); PG8_STAGE(PG8_SA(0, 1), cA + hstep, voffA);
        if (wr == 1) PG8_BAR;
        PG8_WAIT_V(2); PG8_BAR;
        PG8_STAGE(PG8_SB(1, 0), cB + kstep, voffB); PG8_STAGE(PG8_SA(1, 0), cA + kstep, voffA); PG8_STAGE(PG8_SB(1, 1), cB + hstep + kstep, voffB);
        PG8_WAIT_V(6); PG8_BAR;
    } else {
        PG8_STAGE(PG8_SB(0, 0), cB, voffB); PG8_STAGE(PG8_SA(0, 0), cA, voffA); PG8_STAGE(PG8_SB(0, 1), cB + hstep, voffB); PG8_STAGE(PG8_SA(0, 1), cA + hstep, voffA);
        if (wr == 1) PG8_BAR;
        PG8_WAIT_V(4); PG8_BAR;
        PG8_STAGE(PG8_SB(1, 0), cB + kstep, voffB); PG8_STAGE(PG8_SA(1, 0), cA + kstep, voffA); PG8_STAGE(PG8_SB(1, 1), cB + hstep + kstep, voffB);
        PG8_WAIT_V(6); PG8_BAR;
    }
    for (;;) {
        const bool has_next = S.next(ui + 1, nxt);
        const char* nA = has_next ? (const char*)g.A + (size_t)nxt.pm * tstep : cA; const char* nB = has_next ? (const char*)g.Bt + (size_t)nxt.pb * tstep : cB;
        for (int t = 0; t < nt; t += 2) {
            const bool last = (t == nt - 2);
            const char* a1 = cA + (size_t)(t + 1) * kstep;
            const char* a2 = last ? nA : cA + (size_t)(t + 2) * kstep; const char* b2 = last ? nB : cB + (size_t)(t + 2) * kstep;
            const char* a3 = a2 + kstep; const char* b3 = b2 + kstep;
            if (last && has_next) S.a_ready(nxt);
            if constexpr (SP2) {
            PG8_LDB(B0, 0, 0); PG8_LDB(B1, 0, 1); PG8_SCHED; PG8_LDA(At, 0, 0); PG8_STAGE(PG8_SA(1, 1), a1 + hstep, voffA);
            PG8_WAIT_V(8); PG8_WAIT_L(0); PG8_BAR; PG8_MMA(0, 0, At, B0); PG8_MMA(0, 1, At, B1); PG8_BAR; PG8_SCHED;
            PG8_LDA(At, 0, 1); PG8_STAGE(PG8_SB(0, 0), b2, voffB); PG8_STAGE(PG8_SB(0, 1), b2 + hstep, voffB); PG8_STAGE(PG8_SA(0, 0), a2, voffA);
            PG8_WAIT_V(8); PG8_WAIT_L(0); PG8_BAR; PG8_MMA(1, 0, At, B0); PG8_MMA(1, 1, At, B1); PG8_BAR; PG8_SCHED;
            PG8_LDB(B0, 1, 0); PG8_LDB(B1, 1, 1); PG8_SCHED; PG8_LDA(At, 1, 0); PG8_STAGE(PG8_SA(0, 1), a2 + hstep, voffA);
            PG8_WAIT_V(8); PG8_WAIT_L(0); PG8_BAR; PG8_MMA(0, 0, At, B0); PG8_MMA(0, 1, At, B1); PG8_BAR; PG8_SCHED;
            PG8_LDA(At, 1, 1); PG8_STAGE(PG8_SB(1, 0), b3, voffB); PG8_STAGE(PG8_SB(1, 1), b3 + hstep, voffB); PG8_STAGE(PG8_SA(1, 0), a3, voffA);
            PG8_WAIT_V(8); PG8_WAIT_L(0); PG8_BAR; PG8_MMA(1, 0, At, B0); PG8_MMA(1, 1, At, B1); PG8_BAR; PG8_SCHED;
            } else {
            PG8_LDB(B0, 0, 0); PG8_SCHED; PG8_LDA(At, 0, 0); PG8_STAGE(PG8_SA(1, 1), a1 + hstep, voffA);
            PG8_WAIT_L(8); PG8_BAR; PG8_WAIT_L(0); PG8_MMA(0, 0, At, B0); PG8_BAR; PG8_SCHED;
            PG8_LDB(B1, 0, 1); PG8_STAGE(PG8_SB(0, 0), b2, voffB);
            PG8_BAR; PG8_WAIT_L(0); PG8_MMA(0, 1, At, B1); PG8_BAR;
            PG8_LDA(At, 0, 1); PG8_STAGE(PG8_SA(0, 0), a2, voffA);
            PG8_BAR; PG8_WAIT_L(0); PG8_MMA(1, 0, At, B0); PG8_BAR; PG8_SCHED;
            PG8_STAGE(PG8_SB(0, 1), b2 + hstep, voffB);
            PG8_WAIT_V(6); PG8_BAR; PG8_MMA(1, 1, At, B1); PG8_BAR;
            PG8_LDB(B0, 1, 0); PG8_SCHED; PG8_LDA(At, 1, 0); PG8_STAGE(PG8_SA(0, 1), a2 + hstep, voffA);
            PG8_WAIT_L(8); PG8_BAR; PG8_WAIT_L(0); PG8_MMA(0, 0, At, B0); PG8_BAR; PG8_SCHED;
            PG8_LDB(B1, 1, 1); PG8_STAGE(PG8_SB(1, 0), b3, voffB);
            PG8_BAR; PG8_WAIT_L(0); PG8_MMA(0, 1, At, B1); PG8_BAR;
            PG8_LDA(At, 1, 1); PG8_STAGE(PG8_SA(1, 0), a3, voffA);
            PG8_BAR; PG8_WAIT_L(0); PG8_MMA(1, 0, At, B0); PG8_BAR; PG8_SCHED;
            PG8_STAGE(PG8_SB(1, 1), b3 + hstep, voffB);
            PG8_WAIT_V(6); PG8_BAR; PG8_MMA(1, 1, At, B1); PG8_BAR;
            }
        }
        if constexpr (ALIGN_EPI) { if (wr == 0) PG8_BAR; }
        if constexpr (!Epi::AFTER_DRAIN) { E(acc, cur, wr, wc, fr, fq); S.done(cur); }
        if (!has_next) break;
#pragma unroll
        for (int a = 0; a < 2; ++a)
#pragma unroll
            for (int b = 0; b < 2; ++b)
#pragma unroll
                for (int m = 0; m < 4; ++m)
#pragma unroll
                    for (int n = 0; n < 2; ++n) acc[a][b][m][n] = (f32x4){0.f, 0.f, 0.f, 0.f};
        cur = nxt; cA = nA; cB = nB; ++ui;
        if constexpr (ALIGN_EPI) { if (wr == 1) PG8_BAR; }
    }
    PG8_WAIT_V(0);
    if constexpr (!ALIGN_EPI) { if (wr == 0) PG8_BAR; }
    PG8_BAR;
    if constexpr (Epi::AFTER_DRAIN) { E.fused(acc, cur, wr, wc, fr, fq, lds, wid, lane); S.done(cur); }
#undef PG8_SA
#undef PG8_SB
#undef PG8_STAGE
#undef PG8_LDA
#undef PG8_LDB
#undef PG8_MMA
#undef PG8_WAIT_V
#undef PG8_WAIT_L
#undef PG8_BAR
#undef PG8_SCHED
}
typedef int v4i __attribute__((ext_vector_type(4)));
typedef int v8i __attribute__((ext_vector_type(8)));
template <class Epi, class Sched, bool ALIGN_EPI = false, bool SP2 = false>
__device__ __forceinline__ void gemm_phase8(PG8_LAS unsigned char* lds, const Gemm g, const Sched& S, const Epi& E) {
    const int tid = threadIdx.x, wid = __builtin_amdgcn_readfirstlane(tid >> 6), lane = tid & 63, wr = wid >> 2, wc = wid & 3, fr = lane & 15, fq = lane >> 4;
    const int K = g.K, nt = K / BK;
    unsigned voffA[2], voffB[2];
#pragma unroll
    for (int i = 0; i < 2; ++i) { int R, C; stage_rc(tid * 16 + i * 8192, R, C); const int Rb = Epi::PERM ? ((R & ~31) + perm32(R & 31)) : R;
        voffA[i] = (unsigned)(R * K + C) * 2u; voffB[i] = (unsigned)(Rb * K + C) * 2u; }
    const size_t kstep = (size_t)(BK * 2);
    const size_t hstep = (size_t)HALF * K * 2;
    const size_t tstep = 2 * hstep;
    const unsigned ldsw = (unsigned)wid * 1024u;
    const int aoff = lds_byte(wr * 64 + fr, fq * 8), boff = lds_byte(wc * 32 + fr, fq * 8);
#define PG8_SA(b, h) (((b) * 2 + (h)) * HTB)
#define PG8_SB(b, h) ((4 + (b) * 2 + (h)) * HTB)
#define PG8_STAGE(bufoff, gbase, voff) do { _Pragma("unroll") for (int _i = 0; _i < 2; ++_i) \
        __builtin_amdgcn_global_load_lds((const unsigned*)((const char*)(gbase) + (voff)[_i]), (PG8_LAS unsigned*)(lds + (bufoff) + ldsw + _i * 8192), 16, 0, 0); } while (0)
#define PG8_LDA(dst, b, h) do { _Pragma("unroll") for (int m = 0; m < 4; ++m) { const v4i lo_ = *(const PG8_LAS v4i*)(lds + PG8_SA(b, h) + aoff + m * 2048), hi_ = *(const PG8_LAS v4i*)(lds + PG8_SA(b, h) + aoff + m * 2048 + 1024); dst[m] = __builtin_shufflevector(lo_, hi_, 0, 1, 2, 3, 4, 5, 6, 7); } } while (0)
#define PG8_LDB(dst, b, h) do { _Pragma("unroll") for (int n = 0; n < 2; ++n) { const v4i lo_ = *(const PG8_LAS v4i*)(lds + PG8_SB(b, h) + boff + n * 2048), hi_ = *(const PG8_LAS v4i*)(lds + PG8_SB(b, h) + boff + n * 2048 + 1024); dst[n] = __builtin_shufflevector(lo_, hi_, 0, 1, 2, 3, 4, 5, 6, 7); } } while (0)
#define PG8_MMA(ai, bj, At, Bt) do { __builtin_amdgcn_s_setprio(1); _Pragma("unroll") for (int m = 0; m < 4; ++m) _Pragma("unroll") for (int n = 0; n < 2; ++n) \
        asm volatile("v_mfma_f32_16x16x128_f8f6f4 %0, %1, %2, %0" : "+v"(acc[ai][bj][m][n]) : "v"(Bt[n]), "v"(At[m])); __builtin_amdgcn_s_setprio(0); } while (0)
#define PG8_WAIT_V(n) asm volatile("s_waitcnt vmcnt(" #n ")" ::: "memory")
#define PG8_WAIT_L(n) asm volatile("s_waitcnt lgkmcnt(" #n ")" ::: "memory")
#define PG8_BAR __builtin_amdgcn_s_barrier()
#define PG8_SCHED __builtin_amdgcn_sched_barrier(0)
    Unit cur, nxt; int ui = 0;
    if (!S.next(0, cur)) return;
    f32x4 acc[2][2][4][2];
#pragma unroll
    for (int a = 0; a < 2; ++a)
#pragma unroll
        for (int b = 0; b < 2; ++b)
#pragma unroll
            for (int m = 0; m < 4; ++m)
#pragma unroll
                for (int n = 0; n < 2; ++n) acc[a][b][m][n] = (f32x4){0.f, 0.f, 0.f, 0.f};
    v8i At[4], B0[2], B1[2];
    const char* cA = (const char*)g.A + (size_t)cur.pm * tstep; const char* cB = (const char*)g.Bt + (size_t)cur.pb * tstep;
    S.a_ready(cur);
    if constexpr (SP2) {
        PG8_STAGE(PG8_SB(0, 0), cB, voffB); PG8_STAGE(PG8_SB(0, 1), cB + hstep, voffB); PG8_STAGE(PG8_SA(0, 0), cA, voffA); PG8_STAGE(PG8_SA(0, 1), cA + hstep, voffA);
        if (wr == 1) PG8_BAR;
        PG8_WAIT_V(2); PG8_BAR;
        PG8_STAGE(PG8_SB(1, 0), cB + kstep, voffB); PG8_STAGE(PG8_SA(1, 0), cA + kstep, voffA); PG8_STAGE(PG8_SB(1, 1), cB + hstep + kstep, voffB);
        PG8_WAIT_V(6); PG8_BAR;
    } else {
        PG8_STAGE(PG8_SB(0, 0), cB, voffB); PG8_STAGE(PG8_SA(0, 0), cA, voffA); PG8_STAGE(PG8_SB(0, 1), cB + hstep, voffB); PG8_STAGE(PG8_SA(0, 1), cA + hstep, voffA);
        if (wr == 1) PG8_BAR;
        PG8_WAIT_V(4); PG8_BAR;
        PG8_STAGE(PG8_SB(1, 0), cB + kstep, voffB); PG8_STAGE(PG8_SA(1, 0), cA + kstep, voffA); PG8_STAGE(PG8_SB(1, 1), cB + hstep + kstep, voffB);
        PG8_WAIT_V(6); PG8_BAR;
    }
    for (;;) {
        const bool has_next = S.next(ui + 1, nxt);
        const char* nA = has_next ? (const char*)g.A + (size_t)nxt.pm * tstep : cA; const char* nB = has_next ? (const char*)g.Bt + (size_t)nxt.pb * tstep : cB;
#pragma unroll 1
        for (int t = 0; t < nt; t += 2) {
            const bool last = (t == nt - 2);
            const char* a1 = cA + (size_t)(t + 1) * kstep;
            const char* a2 = last ? nA : cA + (size_t)(t + 2) * kstep; const char* b2 = last ? nB : cB + (size_t)(t + 2) * kstep;
            const char* a3 = a2 + kstep; const char* b3 = b2 + kstep;
            if (last && has_next) S.a_ready(nxt);
            if constexpr (SP2) {
            PG8_LDB(B0, 0, 0); PG8_LDB(B1, 0, 1); PG8_SCHED; PG8_LDA(At, 0, 0); PG8_STAGE(PG8_SA(1, 1), a1 + hstep, voffA);
            PG8_WAIT_V(8); PG8_WAIT_L(0); PG8_BAR; PG8_MMA(0, 0, At, B0); PG8_MMA(0, 1, At, B1); PG8_BAR; PG8_SCHED;
            PG8_LDA(At, 0, 1); PG8_STAGE(PG8_SB(0, 0), b2, voffB); PG8_STAGE(PG8_SB(0, 1), b2 + hstep, voffB); PG8_STAGE(PG8_SA(0, 0), a2, voffA);
            PG8_WAIT_V(8); PG8_WAIT_L(0); PG8_BAR; PG8_MMA(1, 0, At, B0); PG8_MMA(1, 1, At, B1); PG8_BAR; PG8_SCHED;
            PG8_LDB(B0, 1, 0); PG8_LDB(B1, 1, 1); PG8_SCHED; PG8_LDA(At, 1, 0); PG8_STAGE(PG8_SA(0, 1), a2 + hstep, voffA);
            PG8_WAIT_V(8); PG8_WAIT_L(0); PG8_BAR; PG8_MMA(0, 0, At, B0); PG8_MMA(0, 1, At, B1); PG8_BAR; PG8_SCHED;
            PG8_LDA(At, 1, 1); PG8_STAGE(PG8_SB(1, 0), b3, voffB); PG8_STAGE(PG8_SB(1, 1), b3 + hstep, voffB); PG8_STAGE(PG8_SA(1, 0), a3, voffA);
            PG8_WAIT_V(8); PG8_WAIT_L(0); PG8_BAR; PG8_MMA(1, 0, At, B0); PG8_MMA(1, 1, At, B1); PG8_BAR; PG8_SCHED;
            } else {
            PG8_LDB(B0, 0, 0); PG8_SCHED; PG8_LDA(At, 0, 0); PG8_STAGE(PG8_SA(1, 1), a1 + hstep, voffA);
            PG8_WAIT_L(8); PG8_BAR; PG8_WAIT_L(0); PG8_MMA(0, 0, At, B0); PG8_BAR; PG8_SCHED;
            PG8_LDB(B1, 0, 1); PG8_STAGE(PG8_SB(0, 0), b2, voffB);
            PG8_BAR; PG8_WAIT_L(0); PG8_MMA(0, 1, At, B1); PG8_BAR;
            PG8_LDA(At, 0, 1); PG8_STAGE(PG8_SA(0, 0), a2, voffA);
            PG8_BAR; PG8_WAIT_L(0); PG8_MMA(1, 0, At, B0); PG8_BAR; PG8_SCHED;
            PG8_STAGE(PG8_SB(0, 1), b2 + hstep, voffB);
            PG8_WAIT_V(6); PG8_BAR; PG8_MMA(1, 1, At, B1); PG8_BAR;
            PG8_LDB(B0, 1, 0); PG8_SCHED; PG8_LDA(At, 1, 0); PG8_STAGE(PG8_SA(0, 1), a2 + hstep, voffA);
            PG8_WAIT_L(8); PG8_BAR; PG8_WAIT_L(0); PG8_MMA(0, 0, At, B0); PG8_BAR; PG8_SCHED;
            PG8_LDB(B1, 1, 1); PG8_STAGE(PG8_SB(1, 0), b3, voffB);
            PG8_BAR; PG8_WAIT_L(0); PG8_MMA(0, 1, At, B1); PG8_BAR;
            PG8_LDA(At, 1, 1); PG8_STAGE(PG8_SA(1, 0), a3, voffA);
            PG8_BAR; PG8_WAIT_L(0); PG8_MMA(1, 0, At, B0); PG8_BAR; PG8_SCHED;
            PG8_STAGE(PG8_SB(1, 1), b3 + hstep, voffB);
            PG8_WAIT_V(6); PG8_BAR; PG8_MMA(1, 1, At, B1); PG8_BAR;
            }
        }
        if constexpr (ALIGN_EPI) { if (wr == 0) PG8_BAR; }
        asm volatile("s_nop 15\n\ts_nop 15" ::: "memory");
        if constexpr (!Epi::AFTER_DRAIN) { E(acc, cur, wr, wc, fr, fq); S.done(cur); }
        if (!has_next) break;
#pragma unroll
        for (int a = 0; a < 2; ++a)
#pragma unroll
            for (int b = 0; b < 2; ++b)
#pragma unroll
                for (int m = 0; m < 4; ++m)
#pragma unroll
                    for (int n = 0; n < 2; ++n) acc[a][b][m][n] = (f32x4){0.f, 0.f, 0.f, 0.f};
        cur = nxt; cA = nA; cB = nB; ++ui;
        if constexpr (ALIGN_EPI) { if (wr == 1) PG8_BAR; }
    }
    PG8_WAIT_V(0);
    if constexpr (!ALIGN_EPI) { if (wr == 0) PG8_BAR; }
    PG8_BAR;
    if constexpr (Epi::AFTER_DRAIN) { E.fused(acc, cur, wr, wc, fr, fq, lds, wid, lane); S.done(cur); }
#undef PG8_SA
#undef PG8_SB
#undef PG8_STAGE
#undef PG8_LDA
#undef PG8_LDB
#undef PG8_MMA
#undef PG8_WAIT_V
#undef PG8_WAIT_L
#undef PG8_BAR
#undef PG8_SCHED
}
template <class Epi, class Sched, bool ALIGN_EPI = false, bool SP2 = false>
__device__ __forceinline__ void gemm_phase8g(PG8_LAS unsigned char* lds, const Gemm g, const Sched& S, const Epi& E, const int* __restrict__ ridx) {
    const int tid = threadIdx.x, wid = __builtin_amdgcn_readfirstlane(tid >> 6), lane = tid & 63, wr = wid >> 2, wc = wid & 3, fr = lane & 15, fq = lane >> 4;
    const int K = g.K, nt = K / BK;
    unsigned voffB[2]; int arow[2]; unsigned acol[2];
#pragma unroll
    for (int i = 0; i < 2; ++i) { int R, C; stage_rc(tid * 16 + i * 8192, R, C); const int Rb = Epi::PERM ? ((R & ~31) + perm32(R & 31)) : R;
        arow[i] = R; acol[i] = (unsigned)C * 2u; voffB[i] = (unsigned)(Rb * K + C) * 2u; }
    constexpr int IDXB_OFF = STAGE_BYTES;
    unsigned offc[2][2], offn[2][2];
#define PG8_LDIDX(dst, pm_) do { _Pragma("unroll") for (int h_ = 0; h_ < 2; ++h_) _Pragma("unroll") for (int i_ = 0; i_ < 2; ++i_) \
        dst[h_][i_] = (unsigned)ridx[(pm_) * BM + h_ * HALF + arow[i_]] * (unsigned)(K * 2) + acol[i_]; } while (0)
#define PG8_STAGE_G(bufoff, gbase, off2) do { _Pragma("unroll") for (int _i = 0; _i < 2; ++_i) \
        __builtin_amdgcn_global_load_lds((const unsigned*)((const char*)(gbase) + (off2)[_i]), (PG8_LAS unsigned*)(lds + (bufoff) + ldsw + _i * 8192), 16, 0, 0); } while (0)
    const size_t kstep = (size_t)(BK * 2);
    const size_t hstep = (size_t)HALF * K * 2;
    const size_t tstep = 2 * hstep;
    const unsigned ldsw = (unsigned)wid * 1024u;
    const int aoff = lds_byte(wr * 64 + fr, fq * 8), boff = lds_byte(wc * 32 + fr, fq * 8);
#define PG8_SA(b, h) (((b) * 2 + (h)) * HTB)
#define PG8_SB(b, h) ((4 + (b) * 2 + (h)) * HTB)
#define PG8_STAGE(bufoff, gbase, voff) do { _Pragma("unroll") for (int _i = 0; _i < 2; ++_i) \
        __builtin_amdgcn_global_load_lds((const unsigned*)((const char*)(gbase) + (voff)[_i]), (PG8_LAS unsigned*)(lds + (bufoff) + ldsw + _i * 8192), 16, 0, 0); } while (0)
#define PG8_LDA(dst, b, h) do { _Pragma("unroll") for (int m = 0; m < 4; ++m) { const v4i lo_ = *(const PG8_LAS v4i*)(lds + PG8_SA(b, h) + aoff + m * 2048), hi_ = *(const PG8_LAS v4i*)(lds + PG8_SA(b, h) + aoff + m * 2048 + 1024); dst[m] = __builtin_shufflevector(lo_, hi_, 0, 1, 2, 3, 4, 5, 6, 7); } } while (0)
#define PG8_LDB(dst, b, h) do { _Pragma("unroll") for (int n = 0; n < 2; ++n) { const v4i lo_ = *(const PG8_LAS v4i*)(lds + PG8_SB(b, h) + boff + n * 2048), hi_ = *(const PG8_LAS v4i*)(lds + PG8_SB(b, h) + boff + n * 2048 + 1024); dst[n] = __builtin_shufflevector(lo_, hi_, 0, 1, 2, 3, 4, 5, 6, 7); } } while (0)
#define PG8_MMA(ai, bj, At, Bt) do { __builtin_amdgcn_s_setprio(1); _Pragma("unroll") for (int m = 0; m < 4; ++m) _Pragma("unroll") for (int n = 0; n < 2; ++n) \
        asm volatile("v_mfma_f32_16x16x128_f8f6f4 %0, %1, %2, %0" : "+v"(acc[ai][bj][m][n]) : "v"(Bt[n]), "v"(At[m])); __builtin_amdgcn_s_setprio(0); } while (0)
#define PG8_WAIT_V(n) asm volatile("s_waitcnt vmcnt(" #n ")" ::: "memory")
#define PG8_WAIT_L(n) asm volatile("s_waitcnt lgkmcnt(" #n ")" ::: "memory")
#define PG8_BAR __builtin_amdgcn_s_barrier()
#define PG8_SCHED __builtin_amdgcn_sched_barrier(0)
    Unit cur, nxt; int ui = 0;
    if (!S.next(0, cur)) return;
    f32x4 acc[2][2][4][2];
#pragma unroll
    for (int a = 0; a < 2; ++a)
#pragma unroll
        for (int b = 0; b < 2; ++b)
#pragma unroll
            for (int m = 0; m < 4; ++m)
#pragma unroll
                for (int n = 0; n < 2; ++n) acc[a][b][m][n] = (f32x4){0.f, 0.f, 0.f, 0.f};
    v8i At[4], B0[2], B1[2];
    const char* gA0 = (const char*)g.A; const char* cB = (const char*)g.Bt + (size_t)cur.pb * tstep; PG8_LDIDX(offc, cur.pm);
    S.a_ready(cur);
    if constexpr (SP2) {
        PG8_STAGE(PG8_SB(0, 0), cB, voffB); PG8_STAGE(PG8_SB(0, 1), cB + hstep, voffB); PG8_STAGE_G(PG8_SA(0, 0), gA0, offc[0]); PG8_STAGE_G(PG8_SA(0, 1), gA0, offc[1]);
        if (wr == 1) PG8_BAR;
        PG8_WAIT_V(2); PG8_BAR;
        PG8_STAGE(PG8_SB(1, 0), cB + kstep, voffB); PG8_STAGE_G(PG8_SA(1, 0), gA0 + kstep, offc[0]); PG8_STAGE(PG8_SB(1, 1), cB + hstep + kstep, voffB);
        PG8_WAIT_V(6); PG8_BAR;
    } else {
        PG8_STAGE(PG8_SB(0, 0), cB, voffB); PG8_STAGE_G(PG8_SA(0, 0), gA0, offc[0]); PG8_STAGE(PG8_SB(0, 1), cB + hstep, voffB); PG8_STAGE_G(PG8_SA(0, 1), gA0, offc[1]);
        if (wr == 1) PG8_BAR;
        PG8_WAIT_V(4); PG8_BAR;
        PG8_STAGE(PG8_SB(1, 0), cB + kstep, voffB); PG8_STAGE_G(PG8_SA(1, 0), gA0 + kstep, offc[0]); PG8_STAGE(PG8_SB(1, 1), cB + hstep + kstep, voffB);
        PG8_WAIT_V(6); PG8_BAR;
    }
    for (;;) {
        const bool has_next = S.next(ui + 1, nxt);
        const char* nB = has_next ? (const char*)g.Bt + (size_t)nxt.pb * tstep : cB;
        if (!has_next) {
#pragma unroll
            for (int h_ = 0; h_ < 2; ++h_) { offn[h_][0] = offc[h_][0]; offn[h_][1] = offc[h_][1]; } }
#pragma unroll 1
        for (int t = 0; t < nt; t += 2) {
            const bool last = (t == nt - 2);
            if (has_next && t == nt - 4 && wid == 0)
                __builtin_amdgcn_global_load_lds((const unsigned*)(ridx + nxt.pm * BM + lane * 4), (PG8_LAS unsigned*)(lds + IDXB_OFF + ((ui + 1) & 1) * 1024), 16, 0, 0);
            if (has_next && last) {
                const PG8_LAS int* ib = (const PG8_LAS int*)(lds + IDXB_OFF + ((ui + 1) & 1) * 1024);
#pragma unroll
                for (int h_ = 0; h_ < 2; ++h_)
#pragma unroll
                    for (int i_ = 0; i_ < 2; ++i_) offn[h_][i_] = (unsigned)ib[h_ * HALF + arow[i_]] * (unsigned)(K * 2) + acol[i_]; }
            const char* a1 = gA0 + (size_t)(t + 1) * kstep;
            const char* a2 = last ? gA0 : gA0 + (size_t)(t + 2) * kstep; const char* b2 = last ? nB : cB + (size_t)(t + 2) * kstep;
            const char* a3 = a2 + kstep; const char* b3 = b2 + kstep;
            unsigned o2[2][2];
#pragma unroll
            for (int h_ = 0; h_ < 2; ++h_) { o2[h_][0] = last ? offn[h_][0] : offc[h_][0]; o2[h_][1] = last ? offn[h_][1] : offc[h_][1]; }
            if (last && has_next) S.a_ready(nxt);
            if constexpr (SP2) {
            PG8_LDB(B0, 0, 0); PG8_LDB(B1, 0, 1); PG8_SCHED; PG8_LDA(At, 0, 0); PG8_STAGE_G(PG8_SA(1, 1), a1, offc[1]);
            PG8_WAIT_V(8); PG8_WAIT_L(0); PG8_BAR; PG8_MMA(0, 0, At, B0); PG8_MMA(0, 1, At, B1); PG8_BAR; PG8_SCHED;
            PG8_LDA(At, 0, 1); PG8_STAGE(PG8_SB(0, 0), b2, voffB); PG8_STAGE(PG8_SB(0, 1), b2 + hstep, voffB); PG8_STAGE_G(PG8_SA(0, 0), a2, o2[0]);
            PG8_WAIT_V(8); PG8_WAIT_L(0); PG8_BAR; PG8_MMA(1, 0, At, B0); PG8_MMA(1, 1, At, B1); PG8_BAR; PG8_SCHED;
            PG8_LDB(B0, 1, 0); PG8_LDB(B1, 1, 1); PG8_SCHED; PG8_LDA(At, 1, 0); PG8_STAGE_G(PG8_SA(0, 1), a2, o2[1]);
            PG8_WAIT_V(8); PG8_WAIT_L(0); PG8_BAR; PG8_MMA(0, 0, At, B0); PG8_MMA(0, 1, At, B1); PG8_BAR; PG8_SCHED;
            PG8_LDA(At, 1, 1); PG8_STAGE(PG8_SB(1, 0), b3, voffB); PG8_STAGE(PG8_SB(1, 1), b3 + hstep, voffB); PG8_STAGE_G(PG8_SA(1, 0), a3, o2[0]);
            PG8_WAIT_V(8); PG8_WAIT_L(0); PG8_BAR; PG8_MMA(1, 0, At, B0); PG8_MMA(1, 1, At, B1); PG8_BAR; PG8_SCHED;
            } else {
            PG8_LDB(B0, 0, 0); PG8_SCHED; PG8_LDA(At, 0, 0); PG8_STAGE_G(PG8_SA(1, 1), a1, offc[1]);
            PG8_WAIT_L(8); PG8_BAR; PG8_WAIT_L(0); PG8_MMA(0, 0, At, B0); PG8_BAR; PG8_SCHED;
            PG8_LDB(B1, 0, 1); PG8_STAGE(PG8_SB(0, 0), b2, voffB);
            PG8_BAR; PG8_WAIT_L(0); PG8_MMA(0, 1, At, B1); PG8_BAR;
            PG8_LDA(At, 0, 1); PG8_STAGE_G(PG8_SA(0, 0), a2, o2[0]);
            PG8_BAR; PG8_WAIT_L(0); PG8_MMA(1, 0, At, B0); PG8_BAR; PG8_SCHED;
            PG8_STAGE(PG8_SB(0, 1), b2 + hstep, voffB);
            PG8_WAIT_V(6); PG8_BAR; PG8_MMA(1, 1, At, B1); PG8_BAR;
            PG8_LDB(B0, 1, 0); PG8_SCHED; PG8_LDA(At, 1, 0); PG8_STAGE_G(PG8_SA(0, 1), a2, o2[1]);
            PG8_WAIT_L(8); PG8_BAR; PG8_WAIT_L(0); PG8_MMA(0, 0, At, B0); PG8_BAR; PG8_SCHED;
            PG8_LDB(B1, 1, 1); PG8_STAGE(PG8_SB(1, 0), b3, voffB);
            PG8_BAR; PG8_WAIT_L(0); PG8_MMA(0, 1, At, B1); PG8_BAR;
            PG8_LDA(At, 1, 1); PG8_STAGE_G(PG8_SA(1, 0), a3, o2[0]);
            PG8_BAR; PG8_WAIT_L(0); PG8_MMA(1, 0, At, B0); PG8_BAR; PG8_SCHED;
            PG8_STAGE(PG8_SB(1, 1), b3 + hstep, voffB);
            PG8_WAIT_V(6); PG8_BAR; PG8_MMA(1, 1, At, B1); PG8_BAR;
            }
        }
        if constexpr (ALIGN_EPI) { if (wr == 0) PG8_BAR; }
        asm volatile("s_nop 15\n\ts_nop 15" ::: "memory");
        if constexpr (!Epi::AFTER_DRAIN) { E(acc, cur, wr, wc, fr, fq); S.done(cur); }
        if (!has_next) break;
#pragma unroll
        for (int a = 0; a < 2; ++a)
#pragma unroll
            for (int b = 0; b < 2; ++b)
#pragma unroll
                for (int m = 0; m < 4; ++m)
#pragma unroll
                    for (int n = 0; n < 2; ++n) acc[a][b][m][n] = (f32x4){0.f, 0.f, 0.f, 0.f};
        cur = nxt; cB = nB; ++ui;
#pragma unroll
        for (int h_ = 0; h_ < 2; ++h_) { offc[h_][0] = offn[h_][0]; offc[h_][1] = offn[h_][1]; }
        if constexpr (ALIGN_EPI) { if (wr == 1) PG8_BAR; }
    }
    PG8_WAIT_V(0);
    if constexpr (!ALIGN_EPI) { if (wr == 0) PG8_BAR; }
    PG8_BAR;
    if constexpr (Epi::AFTER_DRAIN) { E.fused(acc, cur, wr, wc, fr, fq, lds, wid, lane); S.done(cur); }
#undef PG8_SA
#undef PG8_SB
#undef PG8_STAGE
#undef PG8_STAGE_G
#undef PG8_LDIDX
#undef PG8_LDA
#undef PG8_LDB
#undef PG8_MMA
#undef PG8_WAIT_V
#undef PG8_WAIT_L
#undef PG8_BAR
#undef PG8_SCHED
}
template <class Epi, class Sched, bool ALIGN_EPI = false, bool SP2 = false>
__device__ __forceinline__ void gemm_phase_i8(PG8_LAS unsigned char* lds, const Gemm g, const Sched& S, const Epi& E, const float* __restrict__ rowscale) {
    const int tid = threadIdx.x, wid = __builtin_amdgcn_readfirstlane(tid >> 6), lane = tid & 63, wr = wid >> 2, wc = wid & 3, fr = lane & 15, fq = lane >> 4;
    const int K = g.K, nt = K / BK;
    unsigned voffA[2], voffB[2];
#pragma unroll
    for (int i = 0; i < 2; ++i) { int R, C; stage_rc(tid * 16 + i * 8192, R, C); const int Rb = Epi::PERM ? ((R & ~31) + perm32(R & 31)) : R;
        voffA[i] = (unsigned)(R * K + C) * 2u; voffB[i] = (unsigned)(Rb * K + C) * 2u; }
    const size_t kstep = (size_t)(BK * 2);
    const size_t hstep = (size_t)HALF * K * 2;
    const size_t tstep = 2 * hstep;
    const unsigned ldsw = (unsigned)wid * 1024u;
    const int aoff = lds_byte(wr * 64 + fr, fq * 8), boff = lds_byte(wc * 32 + fr, fq * 8);
#define PG8_SA(b, h) (((b) * 2 + (h)) * HTB)
#define PG8_SB(b, h) ((4 + (b) * 2 + (h)) * HTB)
#define PG8_STAGE(bufoff, gbase, voff) do { _Pragma("unroll") for (int _i = 0; _i < 2; ++_i) \
        __builtin_amdgcn_global_load_lds((const unsigned*)((const char*)(gbase) + (voff)[_i]), (PG8_LAS unsigned*)(lds + (bufoff) + ldsw + _i * 8192), 16, 0, 0); } while (0)
#define PG8_LDA(dst, b, h) do { _Pragma("unroll") for (int m = 0; m < 4; ++m) _Pragma("unroll") for (int k = 0; k < 2; ++k) dst[m][k] = *(const PG8_LAS bf16x8*)(lds + PG8_SA(b, h) + aoff + m * 2048 + k * 1024); } while (0)
#define PG8_LDB(dst, b, h) do { _Pragma("unroll") for (int n = 0; n < 2; ++n) _Pragma("unroll") for (int k = 0; k < 2; ++k) dst[n][k] = *(const PG8_LAS bf16x8*)(lds + PG8_SB(b, h) + boff + n * 2048 + k * 1024); } while (0)
#define PG8_MMA(ai, bj, At, Bt) do { __builtin_amdgcn_s_setprio(1); _Pragma("unroll") for (int m = 0; m < 4; ++m) _Pragma("unroll") for (int n = 0; n < 2; ++n) _Pragma("unroll") for (int k = 0; k < 2; ++k) \
        acc[ai][bj][m][n] = __builtin_bit_cast(f32x4, __builtin_amdgcn_mfma_i32_16x16x64_i8(__builtin_bit_cast(v4i, Bt[n][k]), __builtin_bit_cast(v4i, At[m][k]), __builtin_bit_cast(v4i, acc[ai][bj][m][n]), 0, 0, 0)); __builtin_amdgcn_s_setprio(0); } while (0)
#define PG8_WAIT_V(n) asm volatile("s_waitcnt vmcnt(" #n ")" ::: "memory")
#define PG8_WAIT_L(n) asm volatile("s_waitcnt lgkmcnt(" #n ")" ::: "memory")
#define PG8_BAR __builtin_amdgcn_s_barrier()
#define PG8_SCHED __builtin_amdgcn_sched_barrier(0)
    Unit cur, nxt; int ui = 0;
    if (!S.next(0, cur)) return;
    f32x4 acc[2][2][4][2];
#pragma unroll
    for (int a = 0; a < 2; ++a)
#pragma unroll
        for (int b = 0; b < 2; ++b)
#pragma unroll
            for (int m = 0; m < 4; ++m)
#pragma unroll
                for (int n = 0; n < 2; ++n) acc[a][b][m][n] = (f32x4){0.f, 0.f, 0.f, 0.f};
    bf16x8 At[4][2], B0[2][2], B1[2][2];
    const char* cA = (const char*)g.A + (size_t)cur.pm * tstep; const char* cB = (const char*)g.Bt + (size_t)cur.pb * tstep;
    constexpr int SCB_OFF = STAGE_BYTES + 2048;
    if (wid == 0) __builtin_amdgcn_global_load_lds((const unsigned*)(rowscale + cur.pm * BM + lane * 4), (PG8_LAS unsigned*)(lds + SCB_OFF), 16, 0, 0);
    S.a_ready(cur);
    if constexpr (SP2) {
        PG8_STAGE(PG8_SB(0, 0), cB, voffB); PG8_STAGE(PG8_SB(0, 1), cB + hstep, voffB); PG8_STAGE(PG8_SA(0, 0), cA, voffA); PG8_STAGE(PG8_SA(0, 1), cA + hstep, voffA);
        if (wr == 1) PG8_BAR;
        PG8_WAIT_V(2); PG8_BAR;
        PG8_STAGE(PG8_SB(1, 0), cB + kstep, voffB); PG8_STAGE(PG8_SA(1, 0), cA + kstep, voffA); PG8_STAGE(PG8_SB(1, 1), cB + hstep + kstep, voffB);
        PG8_WAIT_V(6); PG8_BAR;
    } else {
        PG8_STAGE(PG8_SB(0, 0), cB, voffB); PG8_STAGE(PG8_SA(0, 0), cA, voffA); PG8_STAGE(PG8_SB(0, 1), cB + hstep, voffB); PG8_STAGE(PG8_SA(0, 1), cA + hstep, voffA);
        if (wr == 1) PG8_BAR;
        PG8_WAIT_V(4); PG8_BAR;
        PG8_STAGE(PG8_SB(1, 0), cB + kstep, voffB); PG8_STAGE(PG8_SA(1, 0), cA + kstep, voffA); PG8_STAGE(PG8_SB(1, 1), cB + hstep + kstep, voffB);
        PG8_WAIT_V(6); PG8_BAR;
    }
    for (;;) {
        const bool has_next = S.next(ui + 1, nxt);
        const char* nA = has_next ? (const char*)g.A + (size_t)nxt.pm * tstep : cA; const char* nB = has_next ? (const char*)g.Bt + (size_t)nxt.pb * tstep : cB;
#pragma unroll 1
        for (int t = 0; t < nt; t += 2) {
            const bool last = (t == nt - 2);
            if (has_next && t == nt - 4 && wid == 0)
                __builtin_amdgcn_global_load_lds((const unsigned*)(rowscale + nxt.pm * BM + lane * 4), (PG8_LAS unsigned*)(lds + SCB_OFF + ((ui + 1) & 1) * 1024), 16, 0, 0);
            const char* a1 = cA + (size_t)(t + 1) * kstep;
            const char* a2 = last ? nA : cA + (size_t)(t + 2) * kstep; const char* b2 = last ? nB : cB + (size_t)(t + 2) * kstep;
            const char* a3 = a2 + kstep; const char* b3 = b2 + kstep;
            if (last && has_next) S.a_ready(nxt);
            if constexpr (SP2) {
            PG8_LDB(B0, 0, 0); PG8_LDB(B1, 0, 1); PG8_SCHED; PG8_LDA(At, 0, 0); PG8_STAGE(PG8_SA(1, 1), a1 + hstep, voffA);
            PG8_WAIT_V(8); PG8_WAIT_L(0); PG8_BAR; PG8_MMA(0, 0, At, B0); PG8_MMA(0, 1, At, B1); PG8_BAR; PG8_SCHED;
            PG8_LDA(At, 0, 1); PG8_STAGE(PG8_SB(0, 0), b2, voffB); PG8_STAGE(PG8_SB(0, 1), b2 + hstep, voffB); PG8_STAGE(PG8_SA(0, 0), a2, voffA);
            PG8_WAIT_V(8); PG8_WAIT_L(0); PG8_BAR; PG8_MMA(1, 0, At, B0); PG8_MMA(1, 1, At, B1); PG8_BAR; PG8_SCHED;
            PG8_LDB(B0, 1, 0); PG8_LDB(B1, 1, 1); PG8_SCHED; PG8_LDA(At, 1, 0); PG8_STAGE(PG8_SA(0, 1), a2 + hstep, voffA);
            PG8_WAIT_V(8); PG8_WAIT_L(0); PG8_BAR; PG8_MMA(0, 0, At, B0); PG8_MMA(0, 1, At, B1); PG8_BAR; PG8_SCHED;
            PG8_LDA(At, 1, 1); PG8_STAGE(PG8_SB(1, 0), b3, voffB); PG8_STAGE(PG8_SB(1, 1), b3 + hstep, voffB); PG8_STAGE(PG8_SA(1, 0), a3, voffA);
            PG8_WAIT_V(8); PG8_WAIT_L(0); PG8_BAR; PG8_MMA(1, 0, At, B0); PG8_MMA(1, 1, At, B1); PG8_BAR; PG8_SCHED;
            } else {
            PG8_LDB(B0, 0, 0); PG8_SCHED; PG8_LDA(At, 0, 0); PG8_STAGE(PG8_SA(1, 1), a1 + hstep, voffA);
            PG8_WAIT_L(8); PG8_BAR; PG8_WAIT_L(0); PG8_MMA(0, 0, At, B0); PG8_BAR; PG8_SCHED;
            PG8_LDB(B1, 0, 1); PG8_STAGE(PG8_SB(0, 0), b2, voffB);
            PG8_BAR; PG8_WAIT_L(0); PG8_MMA(0, 1, At, B1); PG8_BAR;
            PG8_LDA(At, 0, 1); PG8_STAGE(PG8_SA(0, 0), a2, voffA);
            PG8_BAR; PG8_WAIT_L(0); PG8_MMA(1, 0, At, B0); PG8_BAR; PG8_SCHED;
            PG8_STAGE(PG8_SB(0, 1), b2 + hstep, voffB);
            PG8_WAIT_V(6); PG8_BAR; PG8_MMA(1, 1, At, B1); PG8_BAR;
            PG8_LDB(B0, 1, 0); PG8_SCHED; PG8_LDA(At, 1, 0); PG8_STAGE(PG8_SA(0, 1), a2 + hstep, voffA);
            PG8_WAIT_L(8); PG8_BAR; PG8_WAIT_L(0); PG8_MMA(0, 0, At, B0); PG8_BAR; PG8_SCHED;
            PG8_LDB(B1, 1, 1); PG8_STAGE(PG8_SB(1, 0), b3, voffB);
            PG8_BAR; PG8_WAIT_L(0); PG8_MMA(0, 1, At, B1); PG8_BAR;
            PG8_LDA(At, 1, 1); PG8_STAGE(PG8_SA(1, 0), a3, voffA);
            PG8_BAR; PG8_WAIT_L(0); PG8_MMA(1, 0, At, B0); PG8_BAR; PG8_SCHED;
            PG8_STAGE(PG8_SB(1, 1), b3 + hstep, voffB);
            PG8_WAIT_V(6); PG8_BAR; PG8_MMA(1, 1, At, B1); PG8_BAR;
            }
        }
        if constexpr (ALIGN_EPI) { if (wr == 0) PG8_BAR; }
#pragma unroll
        for (int a = 0; a < 2; ++a)
#pragma unroll
            for (int b = 0; b < 2; ++b)
#pragma unroll
                for (int m = 0; m < 4; ++m)
#pragma unroll
                    for (int n = 0; n < 2; ++n) acc[a][b][m][n] = __builtin_convertvector(__builtin_bit_cast(v4i, acc[a][b][m][n]), f32x4);
        if constexpr (!Epi::AFTER_DRAIN) { E(acc, cur, wr, wc, fr, fq, (const PG8_LAS float*)(lds + SCB_OFF + (ui & 1) * 1024)); S.done(cur); }
        if (!has_next) break;
#pragma unroll
        for (int a = 0; a < 2; ++a)
#pragma unroll
            for (int b = 0; b < 2; ++b)
#pragma unroll
                for (int m = 0; m < 4; ++m)
#pragma unroll
                    for (int n = 0; n < 2; ++n) acc[a][b][m][n] = (f32x4){0.f, 0.f, 0.f, 0.f};
        cur = nxt; cA = nA; cB = nB; ++ui;
        if constexpr (ALIGN_EPI) { if (wr == 1) PG8_BAR; }
    }
    PG8_WAIT_V(0);
    if constexpr (!ALIGN_EPI) { if (wr == 0) PG8_BAR; }
    PG8_BAR;
    if constexpr (Epi::AFTER_DRAIN) { E.fused(acc, cur, wr, wc, fr, fq, lds, wid, lane); S.done(cur); }
#undef PG8_SA
#undef PG8_SB
#undef PG8_STAGE
#undef PG8_LDA
#undef PG8_LDB
#undef PG8_MMA
#undef PG8_WAIT_V
#undef PG8_WAIT_L
#undef PG8_BAR
#undef PG8_SCHED
}
template <class Epi, class Sched, bool ALIGN_EPI = false, bool SP2 = false>
__device__ __forceinline__ void gemm_phase_i8g(PG8_LAS unsigned char* lds, const Gemm g, const Sched& S, const Epi& E, const int* __restrict__ ridx, const float* __restrict__ rowscale) {
    const int tid = threadIdx.x, wid = __builtin_amdgcn_readfirstlane(tid >> 6), lane = tid & 63, wr = wid >> 2, wc = wid & 3, fr = lane & 15, fq = lane >> 4;
    const int K = g.K, nt = K / BK;
    unsigned voffB[2]; int arow[2]; unsigned acol[2];
#pragma unroll
    for (int i = 0; i < 2; ++i) { int R, C; stage_rc(tid * 16 + i * 8192, R, C); const int Rb = Epi::PERM ? ((R & ~31) + perm32(R & 31)) : R;
        arow[i] = R; acol[i] = (unsigned)C * 2u; voffB[i] = (unsigned)(Rb * K + C) * 2u; }
    constexpr int IDXB_OFF = STAGE_BYTES;
    unsigned offc[2][2], offn[2][2];
#define PG8_LDIDX(dst, pm_) do { _Pragma("unroll") for (int h_ = 0; h_ < 2; ++h_) _Pragma("unroll") for (int i_ = 0; i_ < 2; ++i_) \
        dst[h_][i_] = (unsigned)ridx[(pm_) * BM + h_ * HALF + arow[i_]] * (unsigned)(K * 2) + acol[i_]; } while (0)
#define PG8_STAGE_G(bufoff, gbase, off2) do { _Pragma("unroll") for (int _i = 0; _i < 2; ++_i) \
        __builtin_amdgcn_global_load_lds((const unsigned*)((const char*)(gbase) + (off2)[_i]), (PG8_LAS unsigned*)(lds + (bufoff) + ldsw + _i * 8192), 16, 0, 0); } while (0)
    const size_t kstep = (size_t)(BK * 2);
    const size_t hstep = (size_t)HALF * K * 2;
    const size_t tstep = 2 * hstep;
    const unsigned ldsw = (unsigned)wid * 1024u;
    const int aoff = lds_byte(wr * 64 + fr, fq * 8), boff = lds_byte(wc * 32 + fr, fq * 8);
#define PG8_SA(b, h) (((b) * 2 + (h)) * HTB)
#define PG8_SB(b, h) ((4 + (b) * 2 + (h)) * HTB)
#define PG8_STAGE(bufoff, gbase, voff) do { _Pragma("unroll") for (int _i = 0; _i < 2; ++_i) \
        __builtin_amdgcn_global_load_lds((const unsigned*)((const char*)(gbase) + (voff)[_i]), (PG8_LAS unsigned*)(lds + (bufoff) + ldsw + _i * 8192), 16, 0, 0); } while (0)
#define PG8_LDA(dst, b, h) do { _Pragma("unroll") for (int m = 0; m < 4; ++m) _Pragma("unroll") for (int k = 0; k < 2; ++k) dst[m][k] = *(const PG8_LAS bf16x8*)(lds + PG8_SA(b, h) + aoff + m * 2048 + k * 1024); } while (0)
#define PG8_LDB(dst, b, h) do { _Pragma("unroll") for (int n = 0; n < 2; ++n) _Pragma("unroll") for (int k = 0; k < 2; ++k) dst[n][k] = *(const PG8_LAS bf16x8*)(lds + PG8_SB(b, h) + boff + n * 2048 + k * 1024); } while (0)
#define PG8_MMA(ai, bj, At, Bt) do { __builtin_amdgcn_s_setprio(1); _Pragma("unroll") for (int m = 0; m < 4; ++m) _Pragma("unroll") for (int n = 0; n < 2; ++n) _Pragma("unroll") for (int k = 0; k < 2; ++k) \
        acc[ai][bj][m][n] = __builtin_bit_cast(f32x4, __builtin_amdgcn_mfma_i32_16x16x64_i8(__builtin_bit_cast(v4i, Bt[n][k]), __builtin_bit_cast(v4i, At[m][k]), __builtin_bit_cast(v4i, acc[ai][bj][m][n]), 0, 0, 0)); __builtin_amdgcn_s_setprio(0); } while (0)
#define PG8_WAIT_V(n) asm volatile("s_waitcnt vmcnt(" #n ")" ::: "memory")
#define PG8_WAIT_L(n) asm volatile("s_waitcnt lgkmcnt(" #n ")" ::: "memory")
#define PG8_BAR __builtin_amdgcn_s_barrier()
#define PG8_SCHED __builtin_amdgcn_sched_barrier(0)
    Unit cur, nxt; int ui = 0;
    if (!S.next(0, cur)) return;
    f32x4 acc[2][2][4][2];
#pragma unroll
    for (int a = 0; a < 2; ++a)
#pragma unroll
        for (int b = 0; b < 2; ++b)
#pragma unroll
            for (int m = 0; m < 4; ++m)
#pragma unroll
                for (int n = 0; n < 2; ++n) acc[a][b][m][n] = (f32x4){0.f, 0.f, 0.f, 0.f};
    bf16x8 At[4][2], B0[2][2], B1[2][2];
    const char* gA0 = (const char*)g.A; const char* cB = (const char*)g.Bt + (size_t)cur.pb * tstep; PG8_LDIDX(offc, cur.pm);
    constexpr int SCB_OFF = STAGE_BYTES + 2048;
    if (wid == 0) __builtin_amdgcn_global_load_lds((const unsigned*)(rowscale + cur.pm * BM + lane * 4), (PG8_LAS unsigned*)(lds + SCB_OFF), 16, 0, 0);
    S.a_ready(cur);
    if constexpr (SP2) {
        PG8_STAGE(PG8_SB(0, 0), cB, voffB); PG8_STAGE(PG8_SB(0, 1), cB + hstep, voffB); PG8_STAGE_G(PG8_SA(0, 0), gA0, offc[0]); PG8_STAGE_G(PG8_SA(0, 1), gA0, offc[1]);
        if (wr == 1) PG8_BAR;
        PG8_WAIT_V(2); PG8_BAR;
        PG8_STAGE(PG8_SB(1, 0), cB + kstep, voffB); PG8_STAGE_G(PG8_SA(1, 0), gA0 + kstep, offc[0]); PG8_STAGE(PG8_SB(1, 1), cB + hstep + kstep, voffB);
        PG8_WAIT_V(6); PG8_BAR;
    } else {
        PG8_STAGE(PG8_SB(0, 0), cB, voffB); PG8_STAGE_G(PG8_SA(0, 0), gA0, offc[0]); PG8_STAGE(PG8_SB(0, 1), cB + hstep, voffB); PG8_STAGE_G(PG8_SA(0, 1), gA0, offc[1]);
        if (wr == 1) PG8_BAR;
        PG8_WAIT_V(4); PG8_BAR;
        PG8_STAGE(PG8_SB(1, 0), cB + kstep, voffB); PG8_STAGE_G(PG8_SA(1, 0), gA0 + kstep, offc[0]); PG8_STAGE(PG8_SB(1, 1), cB + hstep + kstep, voffB);
        PG8_WAIT_V(6); PG8_BAR;
    }
    for (;;) {
        const bool has_next = S.next(ui + 1, nxt);
        const char* nB = has_next ? (const char*)g.Bt + (size_t)nxt.pb * tstep : cB;
        if (!has_next) {
#pragma unroll
            for (int h_ = 0; h_ < 2; ++h_) { offn[h_][0] = offc[h_][0]; offn[h_][1] = offc[h_][1]; } }
#pragma unroll 1
        for (int t = 0; t < nt; t += 2) {
            const bool last = (t == nt - 2);
            if (has_next && t == nt - 4 && wid == 0)
                __builtin_amdgcn_global_load_lds((const unsigned*)(ridx + nxt.pm * BM + lane * 4), (PG8_LAS unsigned*)(lds + IDXB_OFF + ((ui + 1) & 1) * 1024), 16, 0, 0);
            if (has_next && t == nt - 4 && wid == 0)
                __builtin_amdgcn_global_load_lds((const unsigned*)(rowscale + nxt.pm * BM + lane * 4), (PG8_LAS unsigned*)(lds + SCB_OFF + ((ui + 1) & 1) * 1024), 16, 0, 0);
            if (has_next && last) {
                const PG8_LAS int* ib = (const PG8_LAS int*)(lds + IDXB_OFF + ((ui + 1) & 1) * 1024);
#pragma unroll
                for (int h_ = 0; h_ < 2; ++h_)
#pragma unroll
                    for (int i_ = 0; i_ < 2; ++i_) offn[h_][i_] = (unsigned)ib[h_ * HALF + arow[i_]] * (unsigned)(K * 2) + acol[i_]; }
            const char* a1 = gA0 + (size_t)(t + 1) * kstep;
            const char* a2 = last ? gA0 : gA0 + (size_t)(t + 2) * kstep; const char* b2 = last ? nB : cB + (size_t)(t + 2) * kstep;
            const char* a3 = a2 + kstep; const char* b3 = b2 + kstep;
            unsigned o2[2][2];
#pragma unroll
            for (int h_ = 0; h_ < 2; ++h_) { o2[h_][0] = last ? offn[h_][0] : offc[h_][0]; o2[h_][1] = last ? offn[h_][1] : offc[h_][1]; }
            if (last && has_next) S.a_ready(nxt);
            if constexpr (SP2) {
            PG8_LDB(B0, 0, 0); PG8_LDB(B1, 0, 1); PG8_SCHED; PG8_LDA(At, 0, 0); PG8_STAGE_G(PG8_SA(1, 1), a1, offc[1]);
            PG8_WAIT_V(8); PG8_WAIT_L(0); PG8_BAR; PG8_MMA(0, 0, At, B0); PG8_MMA(0, 1, At, B1); PG8_BAR; PG8_SCHED;
            PG8_LDA(At, 0, 1); PG8_STAGE(PG8_SB(0, 0), b2, voffB); PG8_STAGE(PG8_SB(0, 1), b2 + hstep, voffB); PG8_STAGE_G(PG8_SA(0, 0), a2, o2[0]);
            PG8_WAIT_V(8); PG8_WAIT_L(0); PG8_BAR; PG8_MMA(1, 0, At, B0); PG8_MMA(1, 1, At, B1); PG8_BAR; PG8_SCHED;
            PG8_LDB(B0, 1, 0); PG8_LDB(B1, 1, 1); PG8_SCHED; PG8_LDA(At, 1, 0); PG8_STAGE_G(PG8_SA(0, 1), a2, o2[1]);
            PG8_WAIT_V(8); PG8_WAIT_L(0); PG8_BAR; PG8_MMA(0, 0, At, B0); PG8_MMA(0, 1, At, B1); PG8_BAR; PG8_SCHED;
            PG8_LDA(At, 1, 1); PG8_STAGE(PG8_SB(1, 0), b3, voffB); PG8_STAGE(PG8_SB(1, 1), b3 + hstep, voffB); PG8_STAGE_G(PG8_SA(1, 0), a3, o2[0]);
            PG8_WAIT_V(8); PG8_WAIT_L(0); PG8_BAR; PG8_MMA(1, 0, At, B0); PG8_MMA(1, 1, At, B1); PG8_BAR; PG8_SCHED;
            } else {
            PG8_LDB(B0, 0, 0); PG8_SCHED; PG8_LDA(At, 0, 0); PG8_STAGE_G(PG8_SA(1, 1), a1, offc[1]);
            PG8_WAIT_L(8); PG8_BAR; PG8_WAIT_L(0); PG8_MMA(0, 0, At, B0); PG8_BAR; PG8_SCHED;
            PG8_LDB(B1, 0, 1); PG8_STAGE(PG8_SB(0, 0), b2, voffB);
            PG8_BAR; PG8_WAIT_L(0); PG8_MMA(0, 1, At, B1); PG8_BAR;
            PG8_LDA(At, 0, 1); PG8_STAGE_G(PG8_SA(0, 0), a2, o2[0]);
            PG8_BAR; PG8_WAIT_L(0); PG8_MMA(1, 0, At, B0); PG8_BAR; PG8_SCHED;
            PG8_STAGE(PG8_SB(0, 1), b2 + hstep, voffB);
            PG8_WAIT_V(6); PG8_BAR; PG8_MMA(1, 1, At, B1); PG8_BAR;
            PG8_LDB(B0, 1, 0); PG8_SCHED; PG8_LDA(At, 1, 0); PG8_STAGE_G(PG8_SA(0, 1), a2, o2[1]);
            PG8_WAIT_L(8); PG8_BAR; PG8_WAIT_L(0); PG8_MMA(0, 0, At, B0); PG8_BAR; PG8_SCHED;
            PG8_LDB(B1, 1, 1); PG8_STAGE(PG8_SB(1, 0), b3, voffB);
            PG8_BAR; PG8_WAIT_L(0); PG8_MMA(0, 1, At, B1); PG8_BAR;
            PG8_LDA(At, 1, 1); PG8_STAGE_G(PG8_SA(1, 0), a3, o2[0]);
            PG8_BAR; PG8_WAIT_L(0); PG8_MMA(1, 0, At, B0); PG8_BAR; PG8_SCHED;
            PG8_STAGE(PG8_SB(1, 1), b3 + hstep, voffB);
            PG8_WAIT_V(6); PG8_BAR; PG8_MMA(1, 1, At, B1); PG8_BAR;
            }
        }
        if constexpr (ALIGN_EPI) { if (wr == 0) PG8_BAR; }
#pragma unroll
        for (int a = 0; a < 2; ++a)
#pragma unroll
            for (int b = 0; b < 2; ++b)
#pragma unroll
                for (int m = 0; m < 4; ++m)
#pragma unroll
                    for (int n = 0; n < 2; ++n) acc[a][b][m][n] = __builtin_convertvector(__builtin_bit_cast(v4i, acc[a][b][m][n]), f32x4);
        if constexpr (!Epi::AFTER_DRAIN) { E(acc, cur, wr, wc, fr, fq, (const PG8_LAS float*)(lds + SCB_OFF + (ui & 1) * 1024)); S.done(cur); }
        if (!has_next) break;
#pragma unroll
        for (int a = 0; a < 2; ++a)
#pragma unroll
            for (int b = 0; b < 2; ++b)
#pragma unroll
                for (int m = 0; m < 4; ++m)
#pragma unroll
                    for (int n = 0; n < 2; ++n) acc[a][b][m][n] = (f32x4){0.f, 0.f, 0.f, 0.f};
        cur = nxt; cB = nB; ++ui;
#pragma unroll
        for (int h_ = 0; h_ < 2; ++h_) { offc[h_][0] = offn[h_][0]; offc[h_][1] = offn[h_][1]; }
        if constexpr (ALIGN_EPI) { if (wr == 1) PG8_BAR; }
    }
    PG8_WAIT_V(0);
    if constexpr (!ALIGN_EPI) { if (wr == 0) PG8_BAR; }
    PG8_BAR;
    if constexpr (Epi::AFTER_DRAIN) { E.fused(acc, cur, wr, wc, fr, fq, lds, wid, lane); S.done(cur); }
#undef PG8_SA
#undef PG8_SB
#undef PG8_STAGE
#undef PG8_STAGE_G
#undef PG8_LDIDX
#undef PG8_LDA
#undef PG8_LDB
#undef PG8_MMA
#undef PG8_WAIT_V
#undef PG8_WAIT_L
#undef PG8_BAR
#undef PG8_SCHED
}

struct EpiPlain {
    static constexpr bool PERM = true, AFTER_DRAIN = false;
    bf16_t* O; int ldc; float scale;
    __device__ __forceinline__ void operator()(const f32x4 (&acc)[2][2][4][2], const Unit& u, int wr, int wc, int fr, int fq, const PG8_LAS float* rowscale = nullptr) const {
        const int row0 = u.pm * BM + wr * 64 + fr, col0 = u.pn * BM + wc * 32 + 8 * fq;
#pragma unroll
        for (int ai = 0; ai < 2; ++ai)
#pragma unroll
            for (int m = 0; m < 4; ++m) { bf16_t* rowp = O + (size_t)(row0 + ai * HALF + m * 16) * ldc + col0;
                const float sc = rowscale ? rowscale[wr * 64 + fr + ai * HALF + m * 16] * scale : scale;
#pragma unroll
                for (int bj = 0; bj < 2; ++bj) *(u32x4*)(rowp + bj * HALF) = pack8(acc[ai][bj][m][0] * sc, acc[ai][bj][m][1] * sc); }
    }
};
struct EpiPlain8 {
    static constexpr bool PERM = true, AFTER_DRAIN = false;
    unsigned char* O; int ldc; float scale;
    __device__ __forceinline__ void operator()(const f32x4 (&acc)[2][2][4][2], const Unit& u, int wr, int wc, int fr, int fq, const PG8_LAS float* = nullptr) const {
        const int row0 = u.pm * BM + wr * 64 + fr, col0 = u.pn * BM + wc * 32 + 8 * fq;
#pragma unroll
        for (int ai = 0; ai < 2; ++ai)
#pragma unroll
            for (int m = 0; m < 4; ++m) { unsigned char* rowp = O + (size_t)(row0 + ai * HALF + m * 16) * ldc + col0;
#pragma unroll
                for (int bj = 0; bj < 2; ++bj) { f32x4 v0 = acc[ai][bj][m][0] * scale, v1 = acc[ai][bj][m][1] * scale;
#pragma unroll
                    for (int j = 0; j < 4; ++j) { v0[j] = __builtin_amdgcn_fmed3f(v0[j], -416.f, 416.f); v1[j] = __builtin_amdgcn_fmed3f(v1[j], -416.f, 416.f); }
                    unsigned w0, w1; { int t = 0; t = __builtin_amdgcn_cvt_pk_fp8_f32(v0[0], v0[1], t, false); t = __builtin_amdgcn_cvt_pk_fp8_f32(v0[2], v0[3], t, true); w0 = (unsigned)t; }
                    { int t = 0; t = __builtin_amdgcn_cvt_pk_fp8_f32(v1[0], v1[1], t, false); t = __builtin_amdgcn_cvt_pk_fp8_f32(v1[2], v1[3], t, true); w1 = (unsigned)t; }
                    unsigned __attribute__((ext_vector_type(2))) w = {w0, w1};
                    *(unsigned __attribute__((ext_vector_type(2)))*)(rowp + bj * HALF) = w; } }
    }
};
struct EpiConvIn {
    static constexpr bool PERM = true, AFTER_DRAIN = false;
    bf16_t* U; bf16_t* Bg; float sb;
    __device__ __forceinline__ void operator()(const f32x4 (&acc)[2][2][4][2], const Unit& u, int wr, int wc, int fr, int fq, const PG8_LAS float* rowscale = nullptr) const {
        const int row0 = u.pm * BM + wr * 64 + fr;
        if (u.pn < 8) {
            const int col0 = u.pn * HALF + wc * 32 + 8 * fq;
#pragma unroll
            for (int ai = 0; ai < 2; ++ai)
#pragma unroll
                for (int m = 0; m < 4; ++m) { const int row = row0 + ai * HALF + m * 16; bf16_t* rowp = U + (size_t)row * 1024 + col0;
                    const float s = rowscale ? rowscale[row - u.pm * BM] * sb : sb, su = s * s;
                    *(u32x4*)rowp = pack8((acc[ai][0][m][0] * su) * acc[ai][1][m][0], (acc[ai][0][m][1] * su) * acc[ai][1][m][1]); }
        } else {
            const int col0 = (u.pn - 8) * BM + wc * 32 + 8 * fq;
#pragma unroll
            for (int ai = 0; ai < 2; ++ai)
#pragma unroll
                for (int m = 0; m < 4; ++m) { const int row = row0 + ai * HALF + m * 16; bf16_t* rowp = Bg + (size_t)row * 1024 + col0;
                    const float s = rowscale ? rowscale[row - u.pm * BM] * sb : sb;
#pragma unroll
                    for (int bj = 0; bj < 2; ++bj) *(u32x4*)(rowp + bj * HALF) = pack8(acc[ai][bj][m][0] * s, acc[ai][bj][m][1] * s); }
        }
    }
};
__device__ __forceinline__ float silu_mul(float g, float u) { return g * __builtin_amdgcn_rcpf(1.0f + __builtin_amdgcn_exp2f(-1.4426950408889634f * g)) * u; }
struct EpiSwiGLU {
    static constexpr bool PERM = true, AFTER_DRAIN = false;
    bf16_t* O; int ldc;
    __device__ __forceinline__ void operator()(const f32x4 (&acc)[2][2][4][2], const Unit& u, int wr, int wc, int fr, int fq, const PG8_LAS float* rowscale = nullptr) const {
        const int row0 = u.pm * BM + wr * 64 + fr, col0 = u.pn * HALF + wc * 32 + 8 * fq;
#pragma unroll
        for (int ai = 0; ai < 2; ++ai)
#pragma unroll
            for (int m = 0; m < 4; ++m) { bf16_t* rowp = O + (size_t)(row0 + ai * HALF + m * 16) * ldc + col0;
                f32x4 h0, h1;
#pragma unroll
                for (int j = 0; j < 4; ++j) { h0[j] = silu_mul(acc[ai][0][m][0][j], acc[ai][1][m][0][j]); h1[j] = silu_mul(acc[ai][0][m][1][j], acc[ai][1][m][1][j]); }
                *(u32x4*)rowp = pack8(h0, h1); }
    }
};
typedef unsigned u32x2 __attribute__((ext_vector_type(2)));
__device__ __forceinline__ unsigned pk4_i8(float a, float b, float c, float d) {
    const float M = 12582912.0f;
    const unsigned ua = __float_as_uint(__builtin_amdgcn_fmed3f(a, -127.f, 127.f) + M) & 0xffu, ub = __float_as_uint(__builtin_amdgcn_fmed3f(b, -127.f, 127.f) + M) & 0xffu;
    const unsigned uc = __float_as_uint(__builtin_amdgcn_fmed3f(c, -127.f, 127.f) + M) & 0xffu, ud = __float_as_uint(__builtin_amdgcn_fmed3f(d, -127.f, 127.f) + M) & 0xffu;
    return ua | (ub << 8) | (uc << 16) | (ud << 24);
}
__device__ __forceinline__ unsigned pk4_fp8(float a, float b, float c, float d) { int w = 0; w = __builtin_amdgcn_cvt_pk_fp8_f32(a, b, w, false); w = __builtin_amdgcn_cvt_pk_fp8_f32(c, d, w, true); return (unsigned)w; }
__device__ __forceinline__ f32x4 sigmoid_poly(f32x4 g) {
#pragma unroll
    for (int j = 0; j < 4; ++j) g[j] = __builtin_amdgcn_fmed3f(g[j], -6.0f, 6.0f);
    const f32x4 g2 = g * g;
    f32x4 p = g2 * -7.679571572410948e-09f + 9.237889806797302e-07f;
    p = p * g2 + -4.464401370582264e-05f; p = p * g2 + 0.0011428644842571107f; p = p * g2 + -0.018061106095597954f; p = p * g2 + 0.2474573026545305f;
    return g * p + 0.5f;
}
struct EpiSwiGLU8 {
    static constexpr bool PERM = true, AFTER_DRAIN = false;
    unsigned char* O; int ldc; float inscale0, outscale;
    __device__ __forceinline__ void operator()(const f32x4 (&acc)[2][2][4][2], const Unit& u, int wr, int wc, int fr, int fq, const PG8_LAS float* rowscale = nullptr) const {
        const int row0 = u.pm * BM + wr * 64 + fr, col0 = u.pn * HALF + wc * 32 + 8 * fq;
        const float s_ = inscale0, s2_ = s_ * s_, c2_ = s2_ * outscale, hk = 0.5f * c2_, lim = 6.0f / s_;
        const float k0 = 0.2474573026545305f * (c2_ * s_), k1 = -0.018061106095597954f * (c2_ * s_ * s2_), k2 = 0.0011428644842571107f * (c2_ * s_ * s2_ * s2_), k3 = -4.464401370582264e-05f * (c2_ * s_ * s2_ * s2_ * s2_),
                    k4 = 9.237889806797302e-07f * (c2_ * s_ * s2_ * s2_ * s2_ * s2_), k5 = -7.679571572410948e-09f * (c2_ * s_ * s2_ * s2_ * s2_ * s2_ * s2_);
#pragma unroll
        for (int ai = 0; ai < 2; ++ai)
#pragma unroll
            for (int m = 0; m < 4; ++m) { const int row = row0 + ai * HALF + m * 16; unsigned char* rowp = O + (size_t)row * ldc + col0;
                const float inscale = rowscale ? rowscale[row - u.pm * BM] * inscale0 : inscale0;
                const float c2 = inscale * inscale * outscale;
                f32x4 h[2];
#pragma unroll
                for (int n = 0; n < 2; ++n) { const f32x4 ag = acc[ai][0][m][n], au = acc[ai][1][m][n];
                    f32x4 p;
                    if (rowscale == nullptr) {
                        f32x4 agc;
#pragma unroll
                        for (int j = 0; j < 4; ++j) agc[j] = __builtin_amdgcn_fmed3f(ag[j], -lim, lim);
                        const f32x4 t = agc * agc; f32x4 q = t * k5 + k4; q = q * t + k3; q = q * t + k2; q = q * t + k1; q = q * t + k0;
                        p = (ag * au) * (agc * q + hk);
                    } else
                    p = ((ag * c2) * au) * sigmoid_poly(ag * inscale);
#pragma unroll
                    for (int j = 0; j < 4; ++j) p[j] = __builtin_amdgcn_fmed3f(p[j], -416.f, 416.f);
                    h[n] = p; }
                u32x2 w; w.x = pk4_fp8(h[0][0], h[0][1], h[0][2], h[0][3]); w.y = pk4_fp8(h[1][0], h[1][1], h[1][2], h[1][3]);
                *(u32x2*)rowp = w; }
    }
};
constexpr float QK8_QS = 4.0f, QK8_KS = 0.25f;
constexpr float VT_SCALE = 8.0f;
struct EpiQKV {
    static constexpr bool PERM = true, AFTER_DRAIN = false;
    bf16_t *Q, *K, *V; const float* rope; float qscale, oscale;
    __device__ __forceinline__ void operator()(const f32x4 (&acc)[2][2][4][2], const Unit& u, int wr, int wc, int fr, int fq, const PG8_LAS float* rowscale = nullptr) const {
        const int t = u.pn >> 2, colt = (u.pn & 3) * BM; const bool lat = u.pm < 128;
        bf16_t* base; int orow;
        if (t == 0) { base = Q; orow = u.pm * BM; }
        else { base = (t == 1) ? K : V; orow = lat ? ((u.pm >> 3) * 2304 + 256 + (u.pm & 7) * BM) : ((u.pm - 128) * 2304); }
        const int rloc = wr * 64 + fr, col0 = colt + wc * 32 + 8 * fq;
        unsigned char* kp = (unsigned char*)K + (unsigned)((((lat ? (u.pm >> 3) : (u.pm - 128)) * 16 + (colt >> 7) * 2 + (wc >> 1)) * 2304 + (lat ? 256 + (u.pm & 7) * BM : 0) + rloc) * 64 + (wc & 1) * 32 + 8 * fq);
        const bool dorope = lat && (t < 2);
        const int axis = wc & 1; const float sgn = (fq < 2) ? -1.f : 1.f; const float qs0 = ((t == 0) ? qscale * QK8_QS : QK8_KS) * oscale;
        if (t == 2) {
            unsigned char* vt = (unsigned char*)V; const int kb = lat ? 256 + (u.pm & 7) * BM : 0, bb = lat ? (u.pm >> 3) : (u.pm - 128);
            const int qi = fr & 3; const unsigned sel1 = (qi & 1) ? 0x03070105u : 0x06020400u, sel2 = (qi & 2) ? 0x03020706u : 0x05040100u;
#pragma unroll
            for (int ai = 0; ai < 2; ++ai)
#pragma unroll
                for (int m = 0; m < 4; ++m) { const int rl = rloc + ai * HALF + m * 16, kpos = kb + rl; const float qs = (rowscale ? rowscale[rl] * qs0 : qs0) * (VT_SCALE / QK8_KS);
#pragma unroll
                    for (int bj = 0; bj < 2; ++bj) { const int ch = col0 + bj * HALF; const f32x4 v0 = acc[ai][bj][m][0] * qs, v1 = acc[ai][bj][m][1] * qs;
                        const int kg = ((kpos & 63) - qi) >> 2;
                        unsigned char* p = vt + ((size_t)(((bb * 8 + (ch >> 7)) * 36 + (kpos >> 6)) * 128 + (ch & 127) + qi)) * 64 + (32 * (kg & 1) + 16 * (kg >> 3) + 4 * ((kg >> 1) & 3));
                        unsigned w[2] = {pk4_fp8(v0[0], v0[1], v0[2], v0[3]), pk4_fp8(v1[0], v1[1], v1[2], v1[3])};
#pragma unroll
                        for (int k = 0; k < 2; ++k) { const unsigned x = (unsigned)__builtin_amdgcn_mov_dpp((int)w[k], 0xB1, 0xF, 0xF, true), t1 = __builtin_amdgcn_perm(x, w[k], sel1);
                            const unsigned y = (unsigned)__builtin_amdgcn_mov_dpp((int)t1, 0x4E, 0xF, 0xF, true); w[k] = __builtin_amdgcn_perm(y, t1, sel2); }
                        *(unsigned*)p = w[0]; *(unsigned*)(p + 256) = w[1]; } }
            return; }
#pragma unroll
        for (int ai = 0; ai < 2; ++ai)
#pragma unroll
            for (int m = 0; m < 4; ++m) { const int rl = rloc + ai * HALF + m * 16; unsigned char* rowp = (unsigned char*)base + (size_t)(orow + rl) * 1024 + col0;
                const float qs = rowscale ? rowscale[rl] * qs0 : qs0;
                f32x4 c0 = {1.f, 1.f, 1.f, 1.f}, c1 = c0, s0 = {0.f, 0.f, 0.f, 0.f}, s1 = s0;
                if (dorope) { const int tok = (u.pm & 7) * BM + rl, pos = axis ? (tok & 63) : (tok >> 6); const float* tp = rope + pos * 32 + 8 * (fq & 1);
                    c0 = *(const f32x4*)tp; c1 = *(const f32x4*)(tp + 4); s0 = *(const f32x4*)(tp + 16); s1 = *(const f32x4*)(tp + 20); }
#pragma unroll
                for (int bj = 0; bj < 2; ++bj) { f32x4 v0 = acc[ai][bj][m][0], v1 = acc[ai][bj][m][1];
                    if (dorope) { f32x4 p0, p1;
#pragma unroll
                        for (int j = 0; j < 4; ++j) { p0[j] = __shfl_xor(v0[j], 32); p1[j] = __shfl_xor(v1[j], 32); }
                        v0 = v0 * c0 + (p0 * s0) * sgn; v1 = v1 * c1 + (p1 * s1) * sgn; }
                    v0 = v0 * qs; v1 = v1 * qs;
                    u32x2 w; w.x = pk4_fp8(v0[0], v0[1], v0[2], v0[3]); w.y = pk4_fp8(v1[0], v1[1], v1[2], v1[3]);
                    if (t == 1) *(u32x2*)(kp + (ai * HALF + m * 16) * 64 + bj * (2 * 2304 * 64)) = w;
                    else *(u32x2*)(rowp + bj * HALF) = w; } }
    }
};

struct EpiNull {
    static constexpr bool PERM = true, AFTER_DRAIN = false;
    __device__ __forceinline__ void operator()(const f32x4 (&acc)[2][2][4][2], const Unit& u, int wr, int wc, int fr, int fq, const PG8_LAS float* rowscale = nullptr) const {}
};
struct SchedGrid {
    int nM, nN, G, c;
    __device__ __forceinline__ bool next(int i, Unit& u) const { const long L = (long)i * G + c; if (L >= (long)nM * nN) return false; tile_decode((int)L, nM, nN, u.pm, u.pn); u.pb = u.pn; return true; }
    __device__ __forceinline__ void a_ready(const Unit&) const {}
    __device__ __forceinline__ void done(const Unit&) const {}
};
struct SchedMoE {
    int nM, nN, G, c;
    __device__ __forceinline__ bool next(int i, Unit& u) const { const long L = (long)i * G + c; if (L >= (long)nM * nN) return false; tile_decode((int)L, nM, nN, u.pm, u.pn);
        u.pb = ((u.pm < 256) ? (u.pm >> 4) : ((u.pm - 256) >> 1)) * nN + u.pn; return true; }
    __device__ __forceinline__ void a_ready(const Unit&) const {}
    __device__ __forceinline__ void done(const Unit&) const {}
};
struct SchedQKV {
    int G, c;
    __device__ __forceinline__ bool next(int i, Unit& u) const { const long L = (long)i * G + c;
        if (L < 1536) { tile_decode((int)L, 128, 12, u.pm, u.pn); u.pb = u.pn; return true; }
        if (L < 1664) { tile_decode((int)L - 1536, 16, 8, u.pm, u.pn); u.pm += 128; u.pn += 4; u.pb = u.pn; return true; }
        return false; }
    __device__ __forceinline__ void a_ready(const Unit&) const {}
    __device__ __forceinline__ void done(const Unit&) const {}
};
struct SchedSame {
    int nM, nN, G, c;
    __device__ __forceinline__ bool next(int i, Unit& u) const { const long L = (long)i * G + c; if (L >= (long)nM * nN) return false; u.pm = c & 7; u.pn = 0; u.pb = c & 3; return true; }
    __device__ __forceinline__ void a_ready(const Unit&) const {}
    __device__ __forceinline__ void done(const Unit&) const {}
};
}

namespace att {
using bf16 = unsigned short;
using bf16x8 = __attribute__((ext_vector_type(8))) short;
using s16x4  = __attribute__((ext_vector_type(4))) short;
using f32x16 = __attribute__((ext_vector_type(16))) float;
using u32x4  = __attribute__((ext_vector_type(4))) unsigned;
using v8i    = __attribute__((ext_vector_type(8))) int;
using v4i    = __attribute__((ext_vector_type(4))) int;
constexpr int NW = 8, QBLK = 32, KVBLK = 64, LDQ = 1024, LDK = 1024, LDO = 2048, NKEYS = 2304;
constexpr float THR2 = 3.0f, PBIAS = 5.0f;
constexpr float VT_UNSCALE = 1.0f / 8.0f;
constexpr size_t SHM_V = KVBLK * 128  , SHM_K = KVBLK * 64  , SHM_ATTN = 2 * SHM_V + 2 * SHM_K + NW * 64 * 4;
#define KSWZ64(row, colB) ((row) * 128 + ((colB) ^ ((((row) >> 1) & 7) << 4)))
#define SBAR() __builtin_amdgcn_sched_barrier(0)
__device__ __forceinline__ int crow(int r, int hi) { return (r & 3) + 8 * (r >> 2) + 4 * hi; }
__device__ __forceinline__ unsigned cvtpk(float lo, float hi) { unsigned r; asm volatile("v_cvt_pk_bf16_f32 %0, %1, %2" : "=v"(r) : "v"(lo), "v"(hi)); return r; }
__device__ __forceinline__ bf16x8 ld8(const bf16* p) { return *reinterpret_cast<const bf16x8*>(p); }

__device__ __forceinline__ int cvt4_fp8(float a, float b, float c, float d) { int w; asm volatile("" : "=v"(w));
  w = __builtin_amdgcn_cvt_pk_fp8_f32(a, b, w, false); w = __builtin_amdgcn_cvt_pk_fp8_f32(c, d, w, true); return w; }
template <int PM, bool FIRST>
__device__ __forceinline__ void partialSM(f32x16& p0, f32x16& p1, f32x16& minit, float& alpha, int (&pk)[6], float (&rest)[8]) {
  float pmax = p0[0];
#pragma unroll
  for (int r = 1; r < 16; ++r) pmax = fmaxf(pmax, p0[r]);
#pragma unroll
  for (int r = 0; r < 16; ++r) pmax = fmaxf(pmax, p1[r]);
  { auto rr = __builtin_amdgcn_permlane32_swap(__float_as_uint(pmax), __float_as_uint(pmax), false, false);
    pmax = fmaxf(__uint_as_float(rr[0]), __uint_as_float(rr[1])); }
  if (!FIRST && (PM >= 4 || __builtin_expect(__all(pmax <= THR2 + PBIAS), 1))) { alpha = 1.f; }
  else { const float d = FIRST ? pmax - PBIAS : fmaxf(pmax - PBIAS, 0.f); alpha = FIRST ? 0.f : __builtin_amdgcn_exp2f(-d);
#pragma unroll
    for (int r = 0; r < 16; ++r) { p0[r] -= d; p1[r] -= d; minit[r] -= d; } }
#pragma unroll
  for (int r = 0; r < 16; ++r) p0[r] = (PM == 1) ? p0[r] * 0.5f : __builtin_amdgcn_exp2f(p0[r]);
#pragma unroll
  for (int r = 0; r < 8; ++r) p1[r] = (PM == 1) ? p1[r] * 0.5f : __builtin_amdgcn_exp2f(p1[r]);
#pragma unroll
  for (int g = 0; g < 4; ++g) pk[g] = cvt4_fp8(p0[4 * g], p0[4 * g + 1], p0[4 * g + 2], p0[4 * g + 3]);
  pk[4] = cvt4_fp8(p1[0], p1[1], p1[2], p1[3]); pk[5] = cvt4_fp8(p1[4], p1[5], p1[6], p1[7]);
#pragma unroll
  for (int r = 0; r < 8; ++r) rest[r] = p1[8 + r];
}
__device__ __forceinline__ float sm_max16(const f32x16& p, float m) {
#pragma unroll
  for (int r = 0; r < 16; r += 2) m = fmaxf(fmaxf(m, p[r]), p[r + 1]);
  return m; }
__device__ __forceinline__ float sm_maxfin(float pmax) {
  auto rr = __builtin_amdgcn_permlane32_swap(__float_as_uint(pmax), __float_as_uint(pmax), false, false);
  return fmaxf(__uint_as_float(rr[0]), __uint_as_float(rr[1])); }
template <int PM>
__device__ __forceinline__ void sm_rebase(f32x16& p0, f32x16& p1, f32x16& minit, float pmax, float& alpha) {
  if (PM >= 4 || __builtin_expect(__all(pmax <= THR2 + PBIAS), 1)) { alpha = 1.f; }
  else { const float d = fmaxf(pmax - PBIAS, 0.f); alpha = __builtin_amdgcn_exp2f(-d);
#pragma unroll
    for (int r = 0; r < 16; ++r) { p0[r] -= d; p1[r] -= d; minit[r] -= d; } } }
template <int PM, int LO>
__device__ __forceinline__ void sm_exp8(f32x16& p) {
#pragma unroll
  for (int r = LO; r < LO + 8; ++r) p[r] = (PM == 1) ? p[r] * 0.5f : __builtin_amdgcn_exp2f(p[r]); }
template <int PM>
__device__ __forceinline__ void finishSM(const int (&pk)[6], float (&rest)[8], v8i& pop) {
#pragma unroll
  for (int r = 0; r < 8; ++r) rest[r] = (PM == 1) ? rest[r] * 0.5f : __builtin_amdgcn_exp2f(rest[r]);
  const int b2 = cvt4_fp8(rest[0], rest[1], rest[2], rest[3]), b3 = cvt4_fp8(rest[4], rest[5], rest[6], rest[7]);
  pop = v8i{pk[0], pk[1], pk[2], pk[3], pk[4], pk[5], b2, b3};
}
template <int OFF> __device__ __forceinline__ v4i lds_rd128(int addr) { v4i r; asm volatile("ds_read_b128 %0, %1 offset:%2" : "=&v"(r) : "v"(addr), "i"(OFF) : "memory"); return r; }
template <int OFF> __device__ __forceinline__ v4i lds_rd128g(int addr, const v8i& guard) { v4i r; asm volatile("ds_read_b128 %0, %1 offset:%2" : "=&v"(r) : "v"(addr), "i"(OFF), "v"(guard) : "memory"); return r; }
__device__ __forceinline__ void k_load(v8i (&kf)[2], int ka_lo, int ka_hi, const v8i& guard) {
  const v4i a0 = lds_rd128g<0>(ka_lo, guard), a1 = lds_rd128g<0>(ka_hi, guard), b0 = lds_rd128g<2048>(ka_lo, guard), b1 = lds_rd128g<2048>(ka_hi, guard);
  kf[0] = __builtin_shufflevector(a0, a1, 0, 1, 2, 3, 4, 5, 6, 7); kf[1] = __builtin_shufflevector(b0, b1, 0, 1, 2, 3, 4, 5, 6, 7);
}
template <int PM>
__device__ __forceinline__ void qk_mm(f32x16& p0, f32x16& p1, const f32x16& minit, const v8i (&kf)[2], const v8i& qr) {
  if constexpr (PM == 3) { p0 = minit; p1 = minit; asm volatile("" : "+v"(p0), "+v"(p1) : "v"(qr), "v"(kf[0]), "v"(kf[1])); return; }
  p0 = __builtin_amdgcn_mfma_scale_f32_32x32x64_f8f6f4(kf[0], qr, minit, 0, 0, 0, 0, 0, 0);
  p1 = __builtin_amdgcn_mfma_scale_f32_32x32x64_f8f6f4(kf[1], qr, minit, 0, 0, 0, 0, 0, 0);
}
__device__ __forceinline__ int v_st(int k, int c) { const int kk = (k & ~0xC) | ((k & 4) << 1) | ((k & 8) >> 1); return ((kk >> 3) * 4 + (c >> 5)) * 512 + ((kk & 7) * 32 + (c & 31)) * 2; }
__device__ __forceinline__ int v_rd_base(int lane) { return ((lane & 3) << 3) | (((lane >> 2) & 3) << 6) | (((lane >> 4) & 1) << 5) | (((lane >> 5) & 1) << 8); }
constexpr int v_rd_off(int d0, int ks, int half) { return d0 * 512 + ks * 4096 + half * 2048; }
template <int OFF> __device__ __forceinline__ s16x4 tr_read(int vb) {
  s16x4 r; asm volatile("ds_read_b64_tr_b16 %0, %1 offset:%2" : "=&v"(r) : "v"(vb), "i"(OFF) : "memory"); return r;
}
__device__ __forceinline__ void v_load(v8i (&vf)[4], int va_lo, int va_hi) {
  { const v4i lo = lds_rd128<0>(va_lo), hh = lds_rd128<0>(va_hi); vf[0] = __builtin_shufflevector(lo, hh, 0, 1, 2, 3, 4, 5, 6, 7); }
  { const v4i lo = lds_rd128<2048>(va_lo), hh = lds_rd128<2048>(va_hi); vf[1] = __builtin_shufflevector(lo, hh, 0, 1, 2, 3, 4, 5, 6, 7); }
  { const v4i lo = lds_rd128<4096>(va_lo), hh = lds_rd128<4096>(va_hi); vf[2] = __builtin_shufflevector(lo, hh, 0, 1, 2, 3, 4, 5, 6, 7); }
  { const v4i lo = lds_rd128<6144>(va_lo), hh = lds_rd128<6144>(va_hi); vf[3] = __builtin_shufflevector(lo, hh, 0, 1, 2, 3, 4, 5, 6, 7); }
}
__device__ __forceinline__ void pv_one(f32x16& od, const v8i& vfd, const v8i& pop) { asm volatile("v_mfma_f32_32x32x64_f8f6f4 %0, %1, %2, %0" : "+v"(od) : "v"(pop), "v"(vfd)); }
using f32x4a = __attribute__((ext_vector_type(4))) float;
__device__ __forceinline__ void pv_sum(f32x4a& lacc, const v8i& sel, const v8i& pop) { asm volatile("v_mfma_f32_16x16x128_f8f6f4 %0, %1, %2, %0" : "+v"(lacc) : "v"(pop), "v"(sel)); }
#define ATT_LAS __attribute__((address_space(3)))
constexpr int SHM_V2 = 2 * (int)SHM_V, SHM_K2 = 2 * (int)SHM_K;
constexpr int RING_V = 0, RING_K = 3 * SHM_V2, RING_WS = RING_K + 3 * SHM_K2, RING_END = RING_WS + NW * 64 * 4;
template <int PM>
__device__ __forceinline__ void attn_pass(const unsigned char* __restrict__ Qb, const unsigned char* __restrict__ Kh, const unsigned char* __restrict__ Vh, const unsigned char* Kn, const unsigned char* Vn, bool pre, char* lds, ATT_LAS unsigned char* lds3, f32x16 (&o)[4], float (&rli)[16]) {
  const int tid = threadIdx.x, wid = __builtin_amdgcn_readfirstlane(tid >> 6), lane = tid & 63, r32 = lane & 31, hi = lane >> 5;
#define LDS_WAIT_V() asm volatile("s_waitcnt lgkmcnt(0)" : "+v"(vfr[0]), "+v"(vfr[1]), "+v"(vfr[2]), "+v"(vfr[3]) :: "memory")
  char* V_lds = lds + RING_V; char* K_lds = lds + RING_K; const int vbase = (int)(uintptr_t)V_lds, kbase = (int)(uintptr_t)K_lds;
  float* ws = (float*)(lds + RING_WS) + wid * 64; float* al_l = ws + 32;
  v8i qr; f32x16 minit = f32x16{}; f32x4a lacc = f32x4a{};
  v8i ones; { int c1 = ((lane & 15) == ((lane >> 4) & 1)) ? 0x38383838 : 0; asm volatile("" : "+v"(c1)); ones = v8i{c1, c1, c1, c1, c1, c1, c1, c1}; }
#pragma unroll
  for (int d = 0; d < 4; ++d) o[d] = f32x16{};
  const unsigned qoff = (unsigned)((wid * QBLK + r32) * LDQ + hi * 32);
  const unsigned kgo = (unsigned)(wid * 1024 + (lane >> 2) * 64 + (((lane & 3) ^ ((lane >> 4) & 3)) << 4));
  const int voffl = r32 * 64 + (((2 * hi) ^ ((r32 >> 2) & 3)) << 4), voffh = r32 * 64 + (((2 * hi + 1) ^ ((r32 >> 2) & 3)) << 4);
  constexpr int NT = NKEYS / KVBLK;
  constexpr int NS = NT / 2;
#define DMA_KS(s_, slotoff) do { if constexpr (PM == 6) break; const bool nx_ = (s_) >= NS && Kn != nullptr; const int ss_ = (s_) < NS ? (s_) : (nx_ ? (s_) - NS : NS - 1); const char* kp_ = (const char*)(nx_ ? Kn : Kh); \
    __builtin_amdgcn_global_load_lds((const unsigned*)(kp_ + (size_t)ss_ * 8192 + kgo), (ATT_LAS unsigned*)(lds3 + RING_K + (slotoff) + wid * 1024), 16, 0, 0); } while (0)
#define DMA_VS(s_, slotoff) do { if constexpr (PM == 6) break; const bool nx_ = (s_) >= NS && Vn != nullptr; const int ss_ = (s_) < NS ? (s_) : (nx_ ? (s_) - NS : NS - 1); const char* vp_ = (const char*)(nx_ ? Vn : Vh); \
    __builtin_amdgcn_global_load_lds((const unsigned*)(vp_ + (size_t)ss_ * 16384 + kgo), (ATT_LAS unsigned*)(lds3 + RING_V + (slotoff) + wid * 1024), 16, 0, 0); \
    __builtin_amdgcn_global_load_lds((const unsigned*)(vp_ + (size_t)ss_ * 16384 + 8192 + kgo), (ATT_LAS unsigned*)(lds3 + RING_V + (slotoff) + 8192 + wid * 1024), 16, 0, 0); } while (0)
#define WAITBAR(n) do { if constexpr (PM == 4) asm volatile("s_waitcnt vmcnt(" #n ") lgkmcnt(0)" ::: "memory"); else if constexpr (PM == 6) asm volatile("s_waitcnt lgkmcnt(0)\n\ts_barrier" ::: "memory"); else asm volatile("s_waitcnt vmcnt(" #n ") lgkmcnt(0)\n\ts_barrier" ::: "memory"); } while (0)
#define MFMA_DRAIN() asm volatile("s_nop 15\n\ts_nop 7" ::: "memory")
#define RESC(a) do { if (__any((a) < 1.f)) { MFMA_DRAIN(); if (hi == 0) al_l[r32] = (a); asm volatile("s_waitcnt lgkmcnt(0)" ::: "memory"); \
    _Pragma("unroll") for (int r = 0; r < 16; ++r) { const float a_ = al_l[crow(r, hi)]; o[0][r] *= a_; o[1][r] *= a_; o[2][r] *= a_; o[3][r] *= a_; } \
    _Pragma("unroll") for (int r = 0; r < 4; ++r) lacc[r] *= al_l[16 * (lane & 1) + 4 * (lane >> 4) + r]; } } while (0)
  int kw0 = 0, kw1 = SHM_K2, kw2 = 2 * SHM_K2, vw0 = 0, vw1 = SHM_V2, vw2 = 2 * SHM_V2;
#define ROT() do { const int k_ = kw0; kw0 = kw1; kw1 = kw2; kw2 = k_; const int v_ = vw0; vw0 = vw1; vw1 = vw2; vw2 = v_; } while (0)
#define WAITBAR_K(n) do { if constexpr (PM == 4) asm volatile("s_waitcnt vmcnt(" #n ") lgkmcnt(0)" : "+v"(kfr[0]), "+v"(kfr[1]) :: "memory"); else if constexpr (PM == 6) asm volatile("s_waitcnt lgkmcnt(0)\n\ts_barrier" : "+v"(kfr[0]), "+v"(kfr[1]) :: "memory"); \
    else asm volatile("s_waitcnt vmcnt(" #n ") lgkmcnt(0)\n\ts_barrier" : "+v"(kfr[0]), "+v"(kfr[1]) :: "memory"); } while (0)
#define KLOAD(slot_) do { if constexpr (PM == 5) asm volatile("" : "=v"(kfr[0]), "=v"(kfr[1])); else k_load(kfr, kbase + (slot_) + voffl, kbase + (slot_) + voffh, pop); } while (0)
#define VLOAD(slot_) do { if constexpr (PM == 5) asm volatile("" : "=v"(vfr[0]), "=v"(vfr[1]), "=v"(vfr[2]), "=v"(vfr[3])); else v_load(vfr, vbase + (slot_) + voffl, vbase + (slot_) + voffh); } while (0)
#define PV1(d_) do { if constexpr (PM != 2) pv_one(o[d_], vfr[d_], pop); else asm volatile("" : "+v"(o[d_]) : "v"(pop), "v"(vfr[d_])); } while (0)
#define PVS() do { if constexpr (PM != 2) pv_sum(lacc, ones, pop); else asm volatile("" : "+v"(lacc) : "v"(pop)); } while (0)
#define STEP(pkN, rsN, alN, pkO, rsO, VOFF, KOFF, KRD) do { f32x16 p0_, p1_; float pm_; \
    SBAR(); VLOAD(VOFF); SBAR(); \
    qk_mm<PM>(p0_, p1_, minit, kfr, qr); \
    finishSM<PM>(pkO, rsO, pop); SBAR(); \
    LDS_WAIT_V(); \
    PV1(0); SBAR(); pm_ = sm_max16(p0_, p0_[0]); SBAR(); \
    PV1(1); SBAR(); pm_ = sm_maxfin(sm_max16(p1_, pm_)); SBAR(); \
    if (KRD) { KLOAD(KOFF); SBAR(); } \
    sm_rebase<PM>(p0_, p1_, minit, pm_, alN); SBAR(); \
    PV1(2); SBAR(); sm_exp8<PM, 0>(p0_); SBAR(); \
    PV1(3); SBAR(); sm_exp8<PM, 8>(p0_); SBAR(); \
    PVS();  SBAR(); sm_exp8<PM, 0>(p1_); \
    _Pragma("unroll") for (int g_ = 0; g_ < 4; ++g_) pkN[g_] = cvt4_fp8(p0_[4 * g_], p0_[4 * g_ + 1], p0_[4 * g_ + 2], p0_[4 * g_ + 3]); \
    pkN[4] = cvt4_fp8(p1_[0], p1_[1], p1_[2], p1_[3]); pkN[5] = cvt4_fp8(p1_[4], p1_[5], p1_[6], p1_[7]); \
    _Pragma("unroll") for (int r_ = 0; r_ < 8; ++r_) rsN[r_] = p1_[8 + r_]; \
    asm volatile("" : "+v"(pkN[0]), "+v"(pkN[1]), "+v"(pkN[2]), "+v"(pkN[3]), "+v"(pkN[4]), "+v"(pkN[5]), "+v"(rsN[0]), "+v"(rsN[1]), "+v"(rsN[2]), "+v"(rsN[3]), "+v"(rsN[4]), "+v"(rsN[5]), "+v"(rsN[6]), "+v"(rsN[7]));   \
    } while (0)
  if (!pre) { DMA_KS(0, 0); DMA_KS(1, SHM_K2); DMA_KS(2, 2 * SHM_K2); DMA_VS(0, 0); DMA_VS(1, SHM_V2); }
  { const v4i q0 = *reinterpret_cast<const v4i*>(Qb + qoff), q1 = *reinterpret_cast<const v4i*>(Qb + qoff + 16); qr = __builtin_shufflevector(q0, q1, 0, 1, 2, 3, 4, 5, 6, 7); }
  asm volatile("s_waitcnt vmcnt(0)" ::: "memory");
  int pkA[6], pkB[6]; float rsA[8], rsB[8]; float alA, alB; v8i pop = qr, kfr[2], vfr[4];
  asm volatile("s_barrier" ::: "memory");
  KLOAD(0); asm volatile("s_waitcnt lgkmcnt(0)" : "+v"(kfr[0]), "+v"(kfr[1]) :: "memory"); { f32x16 p0_, p1_; qk_mm<PM>(p0_, p1_, minit, kfr, qr); partialSM<PM, true>(p0_, p1_, minit, alA, pkA, rsA); }
  SBAR(); KLOAD(4096); SBAR();
  WAITBAR_K(0);
  if (wid >= 4) __builtin_amdgcn_s_setprio(1);
#pragma unroll 1
  for (int w = 0; w + 1 < NS; ++w) {
    DMA_KS(w + 3, kw0); DMA_VS(w + 2, vw2);
    STEP(pkB, rsB, alB, pkA, rsA, vw0, kw1, true);
    asm volatile("s_waitcnt lgkmcnt(0)" : "+v"(kfr[0]), "+v"(kfr[1]) :: "memory"); RESC(alB);
    STEP(pkA, rsA, alA, pkB, rsB, vw0 + 8192, kw1 + 4096, true);
    WAITBAR_K(3); ROT(); RESC(alA);
  }
  if (Kn != nullptr) { DMA_KS(NS + 2, kw0); DMA_VS(NS + 1, vw2); }
  STEP(pkB, rsB, alB, pkA, rsA, vw0, 0, false);
  RESC(alB);
  SBAR(); VLOAD(vw0 + 8192); SBAR();
  finishSM<PM>(pkB, rsB, pop); SBAR();
  LDS_WAIT_V(); PV1(0); PV1(1); PV1(2); PV1(3); PVS();
  MFMA_DRAIN();
  __builtin_amdgcn_s_setprio(0);
  if ((lane & 15) < 2) {
#pragma unroll
    for (int r = 0; r < 4; ++r) al_l[16 * (lane & 15) + 4 * (lane >> 4) + r] = lacc[r]; }
  asm volatile("s_waitcnt lgkmcnt(0)" ::: "memory");
#pragma unroll
  for (int r = 0; r < 16; ++r) rli[r] = __builtin_amdgcn_rcpf(al_l[crow(r, hi)]) * VT_UNSCALE;
  WAITBAR(0);
#undef LDS_WAIT_V
#undef STEP
#undef PV1
#undef PVS
#undef KLOAD
#undef VLOAD
#undef WAITBAR_K
#undef DMA_KS
#undef DMA_VS
#undef WAITBAR
#undef RESC
#undef MFMA_DRAIN
#undef ROT
}
constexpr int STASH_OFF = RING_END, ATTN_LDS_TOTAL = STASH_OFF + NW * 8192;
template <bool F8, int PM = 0>
__device__ __forceinline__ void attn_diff_unit(const unsigned char* __restrict__ Qb, const unsigned char* __restrict__ Kh, const unsigned char* __restrict__ Vh, const unsigned char* Knext, const unsigned char* Vnext, bool pre, unsigned char* __restrict__ Ob, float lam, const float* __restrict__ subln_g, float gscale, char* lds, ATT_LAS unsigned char* lds3) {
  const int tid = threadIdx.x, wid = tid >> 6, lane = tid & 63, r32 = lane & 31, hi = lane >> 5;
  unsigned* stash = (unsigned*)(lds + STASH_OFF + wid * 8192);
#pragma unroll 1
  for (int map = 0; map < 2; ++map) {
    f32x16 o[4]; float rli[16];
    attn_pass<PM>(Qb + 64 * map, Kh + map * (NKEYS * 64), Vh, map == 0 ? Kh + NKEYS * 64 : Knext, map == 0 ? Vh : Vnext, map == 0 ? pre : true, lds, lds3, o, rli);
    if (map == 0) {
#pragma unroll
      for (int r = 0; r < 16; ++r) { stash[(r * 2 + 0) * 64 + lane] = cvtpk(o[0][r] * rli[r], o[1][r] * rli[r]); stash[(r * 2 + 1) * 64 + lane] = cvtpk(o[2][r] * rli[r], o[3][r] * rli[r]); }
    } else {
  int lane; asm volatile("v_mbcnt_lo_u32_b32 %0, -1, 0\n\tv_mbcnt_hi_u32_b32 %0, -1, %0" : "=v"(lane));
  const int r32 = lane & 31, hi = lane >> 5;
  float ss[16];
#pragma unroll
  for (int r = 0; r < 16; ++r) { const unsigned w0 = stash[(r * 2 + 0) * 64 + lane], w1 = stash[(r * 2 + 1) * 64 + lane];
    o[0][r] = __uint_as_float(w0 << 16) - lam * (o[0][r] * rli[r]); o[1][r] = __uint_as_float(w0 & 0xffff0000u) - lam * (o[1][r] * rli[r]);
    o[2][r] = __uint_as_float(w1 << 16) - lam * (o[2][r] * rli[r]); o[3][r] = __uint_as_float(w1 & 0xffff0000u) - lam * (o[3][r] * rli[r]);
    float q = (o[0][r] * o[0][r] + o[1][r] * o[1][r]) + (o[2][r] * o[2][r] + o[3][r] * o[3][r]);
    q += __shfl_xor(q, 1); q += __shfl_xor(q, 2); q += __shfl_xor(q, 4); q += __shfl_xor(q, 8); q += __shfl_xor(q, 16);
    ss[r] = 1.0f / sqrtf(q * (1.0f / 128.0f) + 1e-6f); }
  float gs[4];
#pragma unroll
  for (int d0 = 0; d0 < 4; ++d0) gs[d0] = subln_g[d0 * 32 + r32] * gscale;
  if constexpr (F8) {
    unsigned char* stg = (unsigned char*)stash;
#pragma unroll
    for (int r = 0; r < 16; ++r) { const int row = crow(r, hi);
#pragma unroll
      for (int d0 = 0; d0 < 4; d0 += 2) { int w = 0; w = __builtin_amdgcn_cvt_pk_fp8_f32(o[d0][r] * ss[r] * gs[d0], o[d0 + 1][r] * ss[r] * gs[d0 + 1], w, false);
        stg[row * 128 + d0 * 32 + r32] = (unsigned char)(w & 0xff); stg[row * 128 + (d0 + 1) * 32 + r32] = (unsigned char)((w >> 8) & 0xff); } }
    asm volatile("s_waitcnt lgkmcnt(0)" ::: "memory");
#pragma unroll
    for (int i = 0; i < 4; ++i) { const int c = i * 64 + lane, row = c >> 3, ch = c & 7; const u32x4 v = *(const u32x4*)(stg + row * 128 + ch * 16);
      *(u32x4*)(Ob + (long)(wid * QBLK + row) * 1024 + ch * 16) = v; }
  } else {
    bf16* stg = (bf16*)(lds + wid * 8192);
#pragma unroll
    for (int r = 0; r < 16; ++r) { const int row = crow(r, hi);
#pragma unroll
      for (int d0 = 0; d0 < 4; d0 += 2) { const unsigned w = cvtpk(o[d0][r] * ss[r] * gs[d0], o[d0 + 1][r] * ss[r] * gs[d0 + 1]);
        stg[row * 128 + d0 * 32 + r32] = (bf16)(w & 0xffffu); stg[row * 128 + (d0 + 1) * 32 + r32] = (bf16)(w >> 16); } }
    asm volatile("s_waitcnt lgkmcnt(0)" ::: "memory");
#pragma unroll
    for (int i = 0; i < 8; ++i) { const int c = i * 64 + lane, row = c >> 4, ch = c & 15; const u32x4 v = *(const u32x4*)((const char*)stg + row * 256 + ch * 16);
      *(u32x4*)(Ob + (long)(wid * QBLK + row) * 2048 + ch * 16) = v; }
  }
    }
  }
  __syncthreads();
}
#undef SBAR
}

constexpr int NWAVES = 8;
constexpr int D = 1024, NB = 16, SEQ = 2048, CTX = 256, ML = NB * SEQ, MC = NB * CTX, MA = ML + MC;
constexpr int NE = 16, FF = 2048, CAPL = 256, CAPC = 32, NPL = 256, NPC = 32;
constexpr int NMOD = 6 * D;
constexpr float EPS = 1e-6f;
constexpr float QSCALE = 0.125f * 1.4426950408889634f;
constexpr size_t MiB = 1u << 20;
constexpr size_t WS_CTL = 0, CTL_ZERO_BYTES = 1 * MiB;
constexpr size_t WS_MOD = 1 * MiB;
constexpr size_t WS_ROPE = 2 * MiB;
constexpr size_t WS_AFF = 3 * MiB;
constexpr size_t WS_INV = 6 * MiB;
constexpr size_t WS_RIDX = 9 * MiB;
constexpr size_t WS_SAH = 10 * MiB, WS_SAH2 = 11 * MiB, WS_SAG = 12 * MiB;
constexpr size_t WS_WIN = 25 * MiB, WS_WOUT = 31 * MiB, WS_WQKV = 33 * MiB, WS_WO = 39 * MiB;
constexpr size_t WS_WGU8 = 41 * MiB;
constexpr size_t WS_WD8 = 169 * MiB;
constexpr size_t WS_H = 233 * MiB;
constexpr size_t WS_H8 = 305 * MiB;
constexpr size_t WS_BUF1 = 341 * MiB, WS_BUF2 = 413 * MiB, WS_BUF3 = 485 * MiB, WS_OPART = 549 * MiB;
constexpr size_t WS_XS8 = 341 * MiB, WS_HID8 = 413 * MiB, WS_Y = 557 * MiB;
constexpr size_t WS_XR = 701 * MiB;
constexpr size_t WS_END = 773 * MiB;
static_assert(WS_HID8 + (size_t)(NPL + NPC) * 256 * FF <= WS_Y && WS_OPART + (size_t)ML * 2048 * 2 <= WS_END && WS_XS8 + (size_t)(NPL + NPC) * 256 * D <= WS_HID8 && WS_Y + (size_t)(NPL + NPC) * 256 * D * 2 <= WS_END, "d_ws map");
#ifndef MIX8
#define MIX8 2
#endif
constexpr bool CONV8 = (MIX8 & 1) != 0, ATT8 = (MIX8 & 2) != 0, CONVO8 = (MIX8 & 4) != 0;
#ifndef I8MASK
#define I8MASK 9
#endif
constexpr bool CIN_I8 = (I8MASK & 1) != 0, QKV_I8 = (I8MASK & 2) != 0, UP_I8 = (I8MASK & 4) != 0, COUT_I8 = (I8MASK & 8) != 0;
constexpr float WS8 = 1024.0f;
constexpr float WSCALE = 64.0f, HSCALE = 4.0f, YSCALE = 8.0f;
constexpr int CW_TMO = 0, CW_BAR = 4096;
constexpr int RING_BYTES = 131072, LDS_BYTES = 147456, LDSCTL_OFF = LDS_BYTES - 1024, MISC_OFF = LDSCTL_OFF + 320;

#define GAS __attribute__((address_space(1)))
#define LAS __attribute__((address_space(3)))
typedef unsigned short bf16;
typedef unsigned v4u __attribute__((ext_vector_type(4)));
typedef unsigned v2u __attribute__((ext_vector_type(2)));
typedef float f32x4 __attribute__((ext_vector_type(4)));
typedef GAS unsigned gu32;
#define RLX_AGENT __ATOMIC_RELAXED, __HIP_MEMORY_SCOPE_AGENT
#define LDS_WAIT() asm volatile("s_waitcnt lgkmcnt(0)" ::: "memory")
#define VM_WAIT() asm volatile("s_waitcnt vmcnt(0)" ::: "memory")
__device__ __forceinline__ unsigned pk2(float lo, float hi) { return pg8::cvt_pk_bf16(lo, hi); }
__device__ __forceinline__ float bflo(unsigned w) { return __uint_as_float(w << 16); }
__device__ __forceinline__ float bfhi(unsigned w) { return __uint_as_float(w & 0xffff0000u); }

#define XB_TMO      128
#define XB_XCNT(j)  (256  + 64 * (j))
#define XB_XSUB(j)  (1280 + 64 * (j))
#define XB_XGEN(j)  (2304 + 64 * (j))
#define XB_TOP      3328
#define XB_TOPGEN   3392
#define XCD_BAR_WORDS 3456
#define XB_SPIN_CAP (1u << 18)

__device__ __forceinline__ unsigned xb_ld(unsigned* p)              { return __hip_atomic_load(p, __ATOMIC_RELAXED, __HIP_MEMORY_SCOPE_AGENT); }
__device__ __forceinline__ unsigned xb_add(unsigned* p, unsigned v) { return __hip_atomic_fetch_add(p, v, __ATOMIC_RELAXED, __HIP_MEMORY_SCOPE_AGENT); }
__device__ __forceinline__ unsigned xb_xcc_id() { return (unsigned)__builtin_amdgcn_s_getreg((3 << 11) | 20) & 0xFu; }
#define XB_SPIN(cond, bar) do { unsigned _sp = 0; while (cond) { __builtin_amdgcn_s_sleep(1); \
    if ((++_sp & 255u) == 0u) { if (xb_ld(&(bar)[XB_TMO])) break; if (_sp > XB_SPIN_CAP) { atomicAdd(&(bar)[XB_TMO], 1u); break; } } } } while (0)

struct XcdBarrier {
    unsigned* bar; unsigned x;
    volatile LAS unsigned* st;
};

__device__ __forceinline__ XcdBarrier xcd_barrier_post(unsigned* bar, volatile LAS unsigned* st) {
    XcdBarrier b; b.bar = bar; b.x = xb_xcc_id(); b.st = st;
    if (threadIdx.x == 0) (void)xb_add(&bar[XB_XCNT(b.x)], 1u);
    return b;
}
__device__ __forceinline__ void xcd_barrier_complete(unsigned* bar, unsigned x, unsigned& nloc, unsigned& nx) {
    const unsigned G = gridDim.x * gridDim.y * gridDim.z;
    unsigned sum, cnt, mine, sp = 0u;
    for (;;) {
        sum = 0u; cnt = 0u; mine = 0u;
#pragma unroll
        for (unsigned j = 0; j < 16; ++j) { const unsigned c = xb_ld(&bar[XB_XCNT(j)]); sum += c; cnt += (c > 0u) ? 1u : 0u; mine = (j == x) ? c : mine; }
        if (sum == G) break;
        __builtin_amdgcn_s_sleep(1);
        if ((++sp & 255u) == 0u) { if (xb_ld(&bar[XB_TMO])) break; if (sp > XB_SPIN_CAP) { atomicAdd(&bar[XB_TMO], 1u); break; } }
    }
    nloc = mine > 0u ? mine : 1u; nx = cnt > 0u ? cnt : 1u;
}

__device__ __forceinline__ void xcd_barrier(const XcdBarrier& b) {
    asm volatile("s_waitcnt vmcnt(0)" ::: "memory");
    __syncthreads();
    if (threadIdx.x == 0) {
        unsigned* bar = b.bar;
        __builtin_amdgcn_s_waitcnt(0);
        unsigned nloc = b.st[0], nx = b.st[1];
        if (nloc == 0u) { xcd_barrier_complete(bar, b.x, nloc, nx); b.st[0] = nloc; b.st[1] = nx; }
        const unsigned old = xb_add(&bar[XB_XSUB(b.x)], 1u);
        const unsigned gen = old / nloc;
        if (old + 1u == (gen + 1u) * nloc) {
            __builtin_amdgcn_fence(__ATOMIC_RELEASE, "agent");
            asm volatile("s_waitcnt vmcnt(0)" ::: "memory");
            const unsigned og = xb_add(&bar[XB_TOP], 1u);
            const unsigned tg = og / nx;
            if (og + 1u == (tg + 1u) * nx) xb_add(&bar[XB_TOPGEN], 1u);
            else XB_SPIN(xb_ld(&bar[XB_TOPGEN]) == tg, bar);
            __builtin_amdgcn_fence(__ATOMIC_ACQUIRE, "agent");
            xb_add(&bar[XB_XGEN(b.x)], 1u);
            asm volatile("s_waitcnt vmcnt(0)" ::: "memory");
        } else {
            XB_SPIN(xb_ld(&bar[XB_XGEN(b.x)]) == gen, bar);
            __builtin_amdgcn_fence(__ATOMIC_ACQUIRE, "agent");
            asm volatile("s_waitcnt vmcnt(0)" ::: "memory");
        }
    }
    __syncthreads();
}

struct R16 { f32x4 v[4]; };
__device__ __forceinline__ int lane_now() { int l; asm volatile("v_mbcnt_lo_u32_b32 %0, -1, 0\n\tv_mbcnt_hi_u32_b32 %0, -1, %0" : "=v"(l)); return l; }
__device__ __forceinline__ float wave_sum(float v) {
#pragma unroll
    for (int o = 1; o < 64; o <<= 1) v += __shfl_xor(v, o);
    return v;
}
__device__ __forceinline__ void ld_f32(R16& r, const float* p, int lane) {
#pragma unroll
    for (int j = 0; j < 4; ++j) r.v[j] = ((const f32x4*)p)[lane + 64 * j];
}
__device__ __forceinline__ void st_f32(float* p, int lane, const R16& r) {
#pragma unroll
    for (int j = 0; j < 4; ++j) ((f32x4*)p)[lane + 64 * j] = r.v[j];
}
__device__ __forceinline__ void ld_bf16(R16& r, const bf16* p, int lane) {
#pragma unroll
    for (int j = 0; j < 4; ++j) { const v2u w = ((const v2u*)p)[lane + 64 * j]; r.v[j] = (f32x4){bflo(w.x), bfhi(w.x), bflo(w.y), bfhi(w.y)}; }
}
__device__ __forceinline__ void st_bf16(bf16* p, int lane, const R16& r) {
#pragma unroll
    for (int j = 0; j < 4; ++j) { v2u w; w.x = pk2(r.v[j][0], r.v[j][1]); w.y = pk2(r.v[j][2], r.v[j][3]); ((v2u*)p)[lane + 64 * j] = w; }
}
__device__ __forceinline__ void st_fp8(unsigned char* p, int lane, const R16& r) {
#pragma unroll
    for (int j = 0; j < 4; ++j) ((unsigned*)p)[lane + 64 * j] = pg8::pk4_fp8(r.v[j][0], r.v[j][1], r.v[j][2], r.v[j][3]);
}
__device__ __forceinline__ void st_i8(unsigned char* p, float* scale_out, int lane, const R16& r) {
    float mx = 0.f;
#pragma unroll
    for (int j = 0; j < 4; ++j) mx = fmaxf(fmaxf(mx, fmaxf(fabsf(r.v[j][0]), fabsf(r.v[j][1]))), fmaxf(fabsf(r.v[j][2]), fabsf(r.v[j][3])));
#pragma unroll
    for (int o = 1; o < 64; o <<= 1) mx = fmaxf(mx, __shfl_xor(mx, o));
    const float inv = (mx > 0.f) ? 127.0f / mx : 0.f;
#pragma unroll
    for (int j = 0; j < 4; ++j) ((unsigned*)p)[lane + 64 * j] = pg8::pk4_i8(r.v[j][0] * inv, r.v[j][1] * inv, r.v[j][2] * inv, r.v[j][3] * inv);
    if (lane == 0) *scale_out = (mx > 0.f) ? mx * (1.0f / 127.0f) : 1.0f;
}
__device__ __forceinline__ float sumsq(const R16& r) {
    float s = 0.f;
#pragma unroll
    for (int j = 0; j < 4; ++j) s += (r.v[j][0] * r.v[j][0] + r.v[j][1] * r.v[j][1]) + (r.v[j][2] * r.v[j][2] + r.v[j][3] * r.v[j][3]);
    return s;
}
__device__ __forceinline__ float rms_scale(const R16& r) { return 1.0f / sqrtf(wave_sum(sumsq(r)) * (1.0f / 1024.0f) + EPS); }

struct Args { const float* in[24]; float* out; unsigned char* ws; int ph_lo, ph_hi; };
enum { I_X = 0, I_C, I_CTX, I_CCTX, I_ADAW, I_ADAB, I_PREMIX, I_POSTMIX, I_PREFFN, I_POSTFFN, I_CWIN, I_CK, I_CWOUT, I_WQKV, I_LQ1, I_LK1, I_LQ2, I_LK2, I_SUBLN, I_WO, I_ROUTER, I_WG, I_WU, I_WDN };
constexpr int N_PHASES = 19;

__device__ __forceinline__ void titem_decode(const Args& a, int it, const float*& src, unsigned char*& dst, int& N, int& K, int& f8) {
    unsigned char* ws = a.ws; int r = it;
    if (r < 768) {
        const int kb = r / 96, nb = r % 96, n0 = nb * 32, part = n0 >> 10, ch = n0 & 1023;
        const int drow = (part == 0) ? (2048 + ch) : ((ch >> 7) * 256 + (ch & 127) + (part == 2 ? 128 : 0));
        N = 3072; f8 = CIN_I8 ? 2 : (CONV8 ? 1 : 0); K = f8 ? 1024 : 2048; src = a.in[I_CWIN] + (size_t)(kb * 128) * 3072 + n0; dst = ws + WS_WIN + (size_t)drow * K + kb * (f8 ? 128 : 256); return; }
    r -= 768;
    if (r < 256) { const int kb = r / 32, nb = r % 32; N = 1024; f8 = COUT_I8 ? 2 : (CONVO8 ? 1 : 0); K = f8 ? 1024 : 2048; src = a.in[I_CWOUT] + (size_t)(kb * 128) * 1024 + nb * 32; dst = ws + WS_WOUT + (size_t)(nb * 32) * K + kb * (f8 ? 128 : 256); return; }
    r -= 256;
    if (r < 768) { const int kb = r / 96, nb = r % 96; N = 3072; f8 = QKV_I8 ? 2 : (ATT8 ? 1 : 0); K = f8 ? 1024 : 2048; src = a.in[I_WQKV] + (size_t)(kb * 128) * 3072 + nb * 32; dst = ws + WS_WQKV + (size_t)(nb * 32) * K + kb * (f8 ? 128 : 256); return; }
    r -= 768;
    if (r < 256) { const int kb = r / 32, nb = r % 32; N = 1024; f8 = ATT8 ? 1 : 0; K = ATT8 ? 1024 : 2048; src = a.in[I_WO] + (size_t)(kb * 128) * 1024 + nb * 32; dst = ws + WS_WO + (size_t)(nb * 32) * K + kb * (ATT8 ? 128 : 256); return; }
    r -= 256;
    const int seg = r >> 13, which = seg % 3, le = (seg / 3) * 16 + ((r & 8191) >> 9), item = r & 511;
    f8 = 1;
    if (which < 2) {             f8 = UP_I8 ? 2 : 1;
        const int kb = item >> 6, nb = item & 63, f0 = nb * 32, drow = (f0 >> 7) * 256 + (f0 & 127) + (which ? 128 : 0);
        N = 2048; K = 1024; src = a.in[which ? I_WU : I_WG] + (size_t)le * 1024 * 2048 + (size_t)(kb * 128) * 2048 + f0; dst = ws + WS_WGU8 + ((size_t)le * 4096 + drow) * 1024 + kb * 128;
    } else {
        const int kb = item >> 5, nb = item & 31;
        N = 1024; K = 2048; src = a.in[I_WDN] + (size_t)le * 2048 * 1024 + (size_t)(kb * 128) * 1024 + nb * 32; dst = ws + WS_WD8 + ((size_t)le * 1024 + nb * 32) * 2048 + kb * 128;
    }
}

constexpr int I_SMALL = 768 + 256 + 768 + 256, I_MOE = 16384, NITEMS = I_SMALL + 3 * I_MOE;
enum { DS_TOPK1 = 0, DS_QKV, DS_DOWN0, DS_TOPK0, DS_COUT, DS_CIN, DS_N };
#ifndef DEFQ
#define DEFQ {4, 3, 6, 4, 2, 6}
#endif
__device__ __forceinline__ int def_idle_waves(int slot, int G) {
    const int NGW = G * NWAVES;
    if (slot == DS_TOPK0) return NGW > 512 ? NGW - 512 : 0;
    if (slot == DS_TOPK1) return NGW > 256 ? NGW - 256 : 0;
    const int units = (slot == DS_CIN) ? (MA / 256) * 12 : (slot == DS_COUT) ? (MA / 256) * 4 : (slot == DS_DOWN0) ? (NPL + NPC) * 4 : 128 * 12 + 16 * 8, rem = units % G;
    return rem ? (G - rem) * NWAVES : 0; }
__device__ __forceinline__ int def_count(int slot, int G) { constexpr int q[DS_N] = DEFQ; return (G == 256) ? q[slot] * def_idle_waves(slot, G) : 0; }
__device__ __forceinline__ int def_base(int slot, int G) { int b = NITEMS; for (int s = 0; s <= slot; ++s) b -= def_count(s, G); return b; }
__device__ __forceinline__ void copy_items(const Args& a, LAS float* scr, int lane, int it0, int step, int it_end) {
    if (it0 < it_end) {
        const float* src; unsigned char* dst; int N, K; int f8;
        f32x4 buf[16];
#define ITEM_LOAD() do { _Pragma("unroll") for (int i = 0; i < 16; ++i) buf[i] = __builtin_nontemporal_load((const f32x4*)(src + (size_t)(8 * i + (lane >> 3)) * N + 4 * (lane & 7)));     } while (0)
        int it = it0;
        titem_decode(a, it, src, dst, N, K, f8); ITEM_LOAD();
        for (;;) {
#pragma unroll
            for (int i = 0; i < 16; ++i) { LAS float* d = scr + (8 * i + (lane >> 3)) * 33 + 4 * (lane & 7); d[0] = buf[i][0]; d[1] = buf[i][1]; d[2] = buf[i][2]; d[3] = buf[i][3]; }
            unsigned char* cdst = dst; const int cK = K; const int cf8 = f8;
            const int nxt = it + step; const bool has = nxt < it_end;
            if (has) { titem_decode(a, nxt, src, dst, N, K, f8); ITEM_LOAD(); }
            LDS_WAIT(); asm volatile("" ::: "memory");
            const int c = lane & 15;
            if (cf8 == 2) {
#pragma unroll
                for (int j = 0; j < 8; ++j) { const int n = (lane >> 4) + 4 * j; const LAS float* s = scr + (8 * c) * 33 + n;
                    v2u o; o.x = pg8::pk4_i8(s[0 * 33] * WS8, s[1 * 33] * WS8, s[2 * 33] * WS8, s[3 * 33] * WS8); o.y = pg8::pk4_i8(s[4 * 33] * WS8, s[5 * 33] * WS8, s[6 * 33] * WS8, s[7 * 33] * WS8);
                    *(GAS v2u*)(cdst + (size_t)n * cK + 8 * c) = o; }
            } else if (cf8 == 1) {
#pragma unroll
                for (int j = 0; j < 8; ++j) { const int n = (lane >> 4) + 4 * j; const LAS float* s = scr + (8 * c) * 33 + n;
                    v2u o; o.x = pg8::pk4_fp8(s[0 * 33] * WSCALE, s[1 * 33] * WSCALE, s[2 * 33] * WSCALE, s[3 * 33] * WSCALE); o.y = pg8::pk4_fp8(s[4 * 33] * WSCALE, s[5 * 33] * WSCALE, s[6 * 33] * WSCALE, s[7 * 33] * WSCALE);
                    *(GAS v2u*)(cdst + (size_t)n * cK + 8 * c) = o; }
            } else {
#pragma unroll
                for (int j = 0; j < 8; ++j) { const int n = (lane >> 4) + 4 * j; const LAS float* s = scr + (8 * c) * 33 + n;
                    v4u o; o.x = pk2(s[0 * 33], s[1 * 33]); o.y = pk2(s[2 * 33], s[3 * 33]); o.z = pk2(s[4 * 33], s[5 * 33]); o.w = pk2(s[6 * 33], s[7 * 33]);
                    *(GAS v4u*)(cdst + (size_t)n * cK + 16 * c) = o; }
            }
            LDS_WAIT(); asm volatile("" ::: "memory");
            if (!has) break;
            it = nxt;
        }
#undef ITEM_LOAD
    }
}
__device__ __forceinline__ void tail_items(const Args& a, LAS unsigned char* lds, int slot, int units, int G, int bx, int wave, int lane) {
    const int rem = units % G;
    if (rem != 0 && bx >= rem) { const int idle = def_idle_waves(slot, G), base = def_base(slot, G);
        copy_items(a, (LAS float*)(lds + wave * (128 * 33 * 4)), lane, base + (bx - rem) * NWAVES + wave, idle, base + def_count(slot, G)); }
}
__device__ __forceinline__ void phase_prologue_a(const Args& a, LAS unsigned char* lds, int vcu, int G, int wave, int lane, int tid) {
    unsigned char* ws = a.ws;
    if (vcu < 192) {
        LAS float* sl = (LAS float*)lds;
        LAS float* red = sl + 17 * 1024;
        const float* c = a.in[I_C]; const float* cc = a.in[I_CCTX];
        for (int idx = tid; idx < 17 * 1024; idx += 512) { const int r = idx >> 10, k = idx & 1023; const float v = (r < 16) ? c[r * 1024 + k] : cc[k]; sl[idx] = v / (1.0f + __expf(-v)); }
        __syncthreads();
        const int layer = vcu / 96, n0 = (vcu % 96) * 64;
        const float* W = a.in[I_ADAW] + (size_t)layer * 1024 * NMOD + n0 + lane;
        float acc[17];
#pragma unroll
        for (int r = 0; r < 17; ++r) acc[r] = 0.f;
        const int k0 = wave * 128;
#pragma unroll 2
        for (int kk = 0; kk < 128; kk += 4) {
            const float w0 = W[(size_t)(k0 + kk) * NMOD], w1 = W[(size_t)(k0 + kk + 1) * NMOD], w2 = W[(size_t)(k0 + kk + 2) * NMOD], w3 = W[(size_t)(k0 + kk + 3) * NMOD];
#pragma unroll
            for (int r = 0; r < 17; ++r) { const f32x4 s = *(const LAS f32x4*)(sl + r * 1024 + k0 + kk); acc[r] += (s[0] * w0 + s[1] * w1) + (s[2] * w2 + s[3] * w3); }
        }
#pragma unroll
        for (int r = 0; r < 17; ++r) red[(wave * 17 + r) * 64 + lane] = acc[r];
        __syncthreads();
        float* MOD = (float*)(ws + WS_MOD);
        for (int idx = tid; idx < 17 * 64; idx += 512) { const int r = idx >> 6, l = idx & 63; float s = 0.f;
#pragma unroll
            for (int w = 0; w < 8; ++w) s += red[(w * 17 + r) * 64 + l];
            MOD[(size_t)(layer * 17 + r) * NMOD + n0 + l] = s + a.in[I_ADAB][layer * NMOD + n0 + l]; }
        __syncthreads();
    }
    if (vcu == G - 1) { float* rt = (float*)(ws + WS_ROPE);
#pragma unroll 1
        for (int f = 2 * wave; f < 2 * wave + 2; ++f) { const float inv = 1.0f / powf(10000.0f, (float)f / 16.0f); const float ang = (float)lane * inv; rt[lane * 32 + f] = cosf(ang); rt[lane * 32 + 16 + f] = sinf(ang); } }
    LAS float* scr = (LAS float*)(lds + wave * (128 * 33 * 4));
    const int gw = vcu * NWAVES + wave, NGW = G * NWAVES;
    copy_items(a, scr, lane, gw, NGW, def_base(DS_N - 1, G));
}

__device__ __forceinline__ void phase_prologue_b(const Args& a, int gw, int NGW, int lane) {
    const float* MOD = (const float*)(a.ws + WS_MOD); bf16* H = (bf16*)(a.ws + WS_H);
    R16 g; ld_f32(g, a.in[I_PREMIX], lane);
    const int rpw = (MA + NGW - 1) / NGW, m_begin = gw * rpw, m_end = (m_begin + rpw < MA) ? m_begin + rpw : MA;
    int cur_b = -1; R16 sh, sc, nx;
#define PB_PREF(mrow_) do { const int m_ = (mrow_); ld_f32(nx, (m_ < ML) ? a.in[I_X] + (size_t)m_ * D : a.in[I_CTX] + (size_t)(m_ - ML) * D, lane); } while (0)
    if (m_begin < m_end) PB_PREF(m_begin);
    for (int m = m_begin; m < m_end; ++m) {
        const int brow = (m < ML) ? (m >> 11) : 16;
        if (brow != cur_b) { const float* md = MOD + (size_t)brow * NMOD; ld_f32(sh, md, lane); ld_f32(sc, md + 1024, lane); cur_b = brow; }
        R16 x = nx;
        if (m + 1 < m_end) PB_PREF(m + 1);
        const float rs = rms_scale(x);
#pragma unroll
        for (int j = 0; j < 4; ++j) x.v[j] = (x.v[j] * rs) * g.v[j] * (sc.v[j] + 1.0f) + sh.v[j];
        if constexpr (CIN_I8) st_i8(a.ws + WS_H + (size_t)m * D, (float*)(a.ws + WS_SAH) + m, lane, x);
        else if constexpr (CONV8) st_fp8(a.ws + WS_H + (size_t)m * D, lane, x); else st_bf16(H + (size_t)m * D, lane, x);
    }
#undef PB_PREF
}

__device__ __forceinline__ void phase_conv(const Args& a, int gw, int NGW, int lane) {
    const bf16* Bg = (const bf16*)(a.ws + WS_BUF1); const bf16* U = (const bf16*)(a.ws + WS_BUF2); bf16* Z = (bf16*)(a.ws + WS_H);
    float k0[16], k1[16], k2[16];
#pragma unroll
    for (int i = 0; i < 16; ++i) { k0[i] = a.in[I_CK][lane * 16 + i]; k1[i] = a.in[I_CK][1024 + lane * 16 + i]; k2[i] = a.in[I_CK][2048 + lane * 16 + i]; }
    const int rpw = (MA + NGW - 1) / NGW, m_begin = gw * rpw, m_end = (m_begin + rpw < MA) ? m_begin + rpw : MA;
    const v4u zero = {0u, 0u, 0u, 0u};
    v4u rm[2], r0[2], rp[2], nb[2];
#define CV_ROW(dst, mrow_) do { const int m_ = (mrow_); if (m_ >= 0 && m_ < MA) { const v4u* p_ = (const v4u*)(U + (size_t)m_ * D + lane * 16); dst[0] = p_[0]; dst[1] = p_[1]; } else { dst[0] = zero; dst[1] = zero; } } while (0)
    if (m_begin < m_end) { CV_ROW(rm, m_begin - 1); CV_ROW(r0, m_begin); CV_ROW(rp, m_begin + 1); const v4u* br = (const v4u*)(Bg + (size_t)m_begin * D + lane * 16); nb[0] = br[0]; nb[1] = br[1]; }
    for (int m = m_begin; m < m_end; ++m) {
        int t, n; if (m < ML) { t = m & 2047; n = 2048; } else { t = (m - ML) & 255; n = 256; }
        v4u b[2], u0[2], um[2], up[2];
        b[0] = nb[0]; b[1] = nb[1]; u0[0] = r0[0]; u0[1] = r0[1];
        if (t > 0) { um[0] = rm[0]; um[1] = rm[1]; } else { um[0] = zero; um[1] = zero; }
        if (t < n - 1) { up[0] = rp[0]; up[1] = rp[1]; } else { up[0] = zero; up[1] = zero; }
        rm[0] = r0[0]; rm[1] = r0[1]; r0[0] = rp[0]; r0[1] = rp[1];
        if (m + 1 < m_end) { CV_ROW(rp, m + 2); const v4u* br = (const v4u*)(Bg + (size_t)(m + 1) * D + lane * 16); nb[0] = br[0]; nb[1] = br[1]; }
        v4u z[2]; float zf[16];
#pragma unroll
        for (int h = 0; h < 2; ++h)
#pragma unroll
            for (int q = 0; q < 4; ++q) { const int i = h * 8 + q * 2;
                const float lo = bflo(b[h][q]) * (k0[i] * bflo(um[h][q]) + k1[i] * bflo(u0[h][q]) + k2[i] * bflo(up[h][q]));
                const float hi = bfhi(b[h][q]) * (k0[i + 1] * bfhi(um[h][q]) + k1[i + 1] * bfhi(u0[h][q]) + k2[i + 1] * bfhi(up[h][q]));
                if constexpr (COUT_I8) { zf[i] = lo; zf[i + 1] = hi; } else z[h][q] = pk2(lo, hi); }
        if constexpr (COUT_I8) {
            float mx = 0.f;
#pragma unroll
            for (int i = 0; i < 16; ++i) mx = fmaxf(mx, fabsf(zf[i]));
#pragma unroll
            for (int o = 1; o < 64; o <<= 1) mx = fmaxf(mx, __shfl_xor(mx, o));
            const float inv = (mx > 0.f) ? 127.0f / mx : 0.f; v4u w8;
#pragma unroll
            for (int q2 = 0; q2 < 4; ++q2) w8[q2] = pg8::pk4_i8(zf[4 * q2] * inv, zf[4 * q2 + 1] * inv, zf[4 * q2 + 2] * inv, zf[4 * q2 + 3] * inv);
            *(v4u*)(a.ws + WS_H + (size_t)m * D + lane * 16) = w8;
            if (lane == 0) ((float*)(a.ws + WS_SAH))[m] = (mx > 0.f) ? mx * (1.0f / 127.0f) : 1.0f;
        } else
        if constexpr (CONVO8) { v4u w8;
#pragma unroll
            for (int q2 = 0; q2 < 4; ++q2) { const unsigned lo = z[q2 >> 1][(q2 & 1) * 2], hi = z[q2 >> 1][(q2 & 1) * 2 + 1]; w8[q2] = pg8::pk4_fp8(bflo(lo), bfhi(lo), bflo(hi), bfhi(hi)); }
            *(v4u*)(a.ws + WS_H + (size_t)m * D + lane * 16) = w8; }
        else { v4u* zr = (v4u*)(Z + (size_t)m * D + lane * 16); zr[0] = z[0]; zr[1] = z[1]; }
    }
#undef CV_ROW
}

__device__ __forceinline__ void phase_postmix(const Args& a, int layer, LAS unsigned char* lds, int gw, int NGW, int lane, int tid) {
    const float* MOD = (const float*)(a.ws + WS_MOD); unsigned char* H8 = a.ws + WS_H8; const bf16* Mb = (const bf16*)(a.ws + WS_BUF1);
    float* AFF = (float*)(a.ws + WS_AFF); bf16* XR = (bf16*)(a.ws + WS_XR);
    const int nrows = (layer == 0) ? MA : ML;
    LAS f32x4* wl = (LAS f32x4*)lds;
    const f32x4* rw = (const f32x4*)(a.in[I_ROUTER] + (size_t)layer * D * NE);
    for (int idx = tid; idx < 4096; idx += 512) { const int k = idx >> 2, c = idx & 3, j = k >> 8, l = (k >> 2) & 63, i = k & 3; wl[((j * 4 + i) * 4 + c) * 64 + l] = rw[idx]; }
    __syncthreads();
    R16 gpm, gpf; ld_f32(gpm, a.in[I_POSTMIX] + layer * D, lane); ld_f32(gpf, a.in[I_PREFFN] + layer * D, lane);
    const int rpw = (nrows + NGW - 1) / NGW, m_begin = gw * rpw, m_end = (m_begin + rpw < nrows) ? m_begin + rpw : nrows;
    int cur_b = -1; R16 t0, sh, sc; v2u nmm[4], nxb[4]; f32x4 nxf[4];
#define PM_PREF(mrow_) do { const int m_ = (mrow_); _Pragma("unroll") for (int j = 0; j < 4; ++j) nmm[j] = ((const v2u*)(Mb + (size_t)m_ * D))[lane + 64 * j]; \
        if (layer == 0) { const f32x4* xp_ = (const f32x4*)((m_ < ML) ? a.in[I_X] + (size_t)m_ * D : a.in[I_CTX] + (size_t)(m_ - ML) * D); _Pragma("unroll") for (int j = 0; j < 4; ++j) nxf[j] = xp_[lane + 64 * j]; } \
        else { _Pragma("unroll") for (int j = 0; j < 4; ++j) nxb[j] = ((const v2u*)(XR + (size_t)m_ * D))[lane + 64 * j]; } } while (0)
    if (m_begin < m_end) PM_PREF(m_begin);
    for (int m = m_begin; m < m_end; ++m) {
        asm volatile("" ::: "memory");
        const int brow = (m < ML) ? (m >> 11) : 16;
        if (brow != cur_b) { const float* md = MOD + (size_t)(layer * 17 + brow) * NMOD; ld_f32(t0, md + 2048, lane); ld_f32(sh, md + 3072, lane); ld_f32(sc, md + 4096, lane); cur_b = brow; }
        R16 mm, x;
#pragma unroll
        for (int j = 0; j < 4; ++j) { mm.v[j] = (f32x4){bflo(nmm[j].x), bfhi(nmm[j].x), bflo(nmm[j].y), bfhi(nmm[j].y)};
            if (layer == 0) x.v[j] = nxf[j]; else x.v[j] = (f32x4){bflo(nxb[j].x), bfhi(nxb[j].x), bflo(nxb[j].y), bfhi(nxb[j].y)}; }
        if (m + 1 < m_end) PM_PREF(m + 1);
        const float rs = rms_scale(mm);
#pragma unroll
        for (int j = 0; j < 4; ++j) x.v[j] = x.v[j] + t0.v[j] * ((mm.v[j] * rs) * gpm.v[j]);
        st_bf16(XR + (size_t)m * D, lane, x);
        const float rs2 = rms_scale(x);
#pragma unroll
        for (int j = 0; j < 4; ++j) x.v[j] = (x.v[j] * rs2) * gpf.v[j] * (sc.v[j] + 1.0f) + sh.v[j];
#pragma unroll
        for (int j = 0; j < 4; ++j) if constexpr (!UP_I8) ((unsigned*)(H8 + (size_t)m * D))[lane + 64 * j] = pg8::pk4_fp8(x.v[j][0], x.v[j][1], x.v[j][2], x.v[j][3]);
        if constexpr (UP_I8) st_i8(H8 + (size_t)m * D, (float*)(a.ws + WS_SAH2) + m, lane, x);
        f32x4 lgv[4];
#pragma unroll
        for (int c = 0; c < 4; ++c) lgv[c] = (f32x4){0.f, 0.f, 0.f, 0.f};
#pragma unroll
        for (int j = 0; j < 4; ++j)
#pragma unroll
            for (int i = 0; i < 4; ++i) { const float hv = x.v[j][i];
#pragma unroll
                for (int c = 0; c < 4; ++c) { const f32x4 w = wl[((j * 4 + i) * 4 + c) * 64 + lane]; lgv[c] = lgv[c] + w * hv; } }
        float lg[16];
#pragma unroll
        for (int e = 0; e < 16; ++e) lg[e] = lgv[e >> 2][e & 3];
        { const bool up = (lane & 32) != 0;
#pragma unroll
          for (int i = 0; i < 8; ++i) { const float snd = up ? lg[i] : lg[i + 8]; const float rcv = __shfl_xor(snd, 32); lg[i] = (up ? lg[i + 8] : lg[i]) + rcv; } }
        { const bool up = (lane & 16) != 0;
#pragma unroll
          for (int i = 0; i < 4; ++i) { const float snd = up ? lg[i] : lg[i + 4]; const float rcv = __shfl_xor(snd, 16); lg[i] = (up ? lg[i + 4] : lg[i]) + rcv; } }
        { const bool up = (lane & 8) != 0;
#pragma unroll
          for (int i = 0; i < 2; ++i) { const float snd = up ? lg[i] : lg[i + 2]; const float rcv = __shfl_xor(snd, 8); lg[i] = (up ? lg[i + 2] : lg[i]) + rcv; } }
        { const bool up = (lane & 4) != 0; const float snd = up ? lg[0] : lg[1]; const float rcv = __shfl_xor(snd, 4); lg[0] = (up ? lg[1] : lg[0]) + rcv; }
        float lgt = lg[0]; lgt += __shfl_xor(lgt, 2); lgt += __shfl_xor(lgt, 1);
        float mx = lgt;
#pragma unroll
        for (int o = 4; o < 64; o <<= 1) mx = fmaxf(mx, __shfl_xor(mx, o));
        const float ex = __expf(lgt - mx); float sm = ex;
#pragma unroll
        for (int o = 4; o < 64; o <<= 1) sm += __shfl_xor(sm, o);
        if ((lane & 3) == 0) AFF[(size_t)(lane >> 2) * MA + m] = ex / sm;
    }
#undef PM_PREF
    __syncthreads();
}

template <int NJ>
__device__ __forceinline__ void topk_select(const float* AFF, int* INV, int* RIDX, const float* SAH2, float* SAG, int rowbase, int e, int cap, int xsbase, int lane) {
    unsigned key[NJ];
#pragma unroll
    for (int j = 0; j < NJ; ++j) key[j] = __float_as_uint(AFF[(size_t)e * MA + rowbase + j * 64 + lane]);
    unsigned prefix = 0u;
    for (int bit = 30; bit >= 0; --bit) {
        const unsigned cand = prefix | (1u << bit); int cnt = 0;
#pragma unroll
        for (int j = 0; j < NJ; ++j) cnt += __popcll(__ballot(key[j] >= cand));
        if (cnt >= cap) prefix = cand;
    }
    const unsigned T = prefix; int ngt = 0;
#pragma unroll
    for (int j = 0; j < NJ; ++j) ngt += __popcll(__ballot(key[j] > T));
    const int need = cap - ngt; const unsigned long long lt = (1ull << lane) - 1ull;
    int selbase = 0, eqbase = 0;
#pragma unroll
    for (int j = 0; j < NJ; ++j) {
        const bool gt = key[j] > T, eq = key[j] == T; const unsigned long long eqm = __ballot(eq); const int eqr = eqbase + __popcll(eqm & lt);
        const bool sel = gt || (eq && eqr < need); const unsigned long long sm = __ballot(sel); const int slot = selbase + __popcll(sm & lt);
        const int t = j * 64 + lane;
        if (sel) { RIDX[xsbase + slot] = rowbase + t; if constexpr (UP_I8) SAG[xsbase + slot] = SAH2[rowbase + t]; }
        INV[(size_t)e * MA + rowbase + t] = sel ? (xsbase + slot) : -1;
        selbase += __popcll(sm); eqbase += __popcll(eqm);
    }
}
__device__ __forceinline__ void phase_topk(const Args& a, int layer, LAS unsigned char* lds, int gw, int NGW, int lane) {
    const float* AFF = (const float*)(a.ws + WS_AFF); int* INV = (int*)(a.ws + WS_INV); int* RIDX = (int*)(a.ws + WS_RIDX);
    const float* SAH2 = (const float*)(a.ws + WS_SAH2); float* SAG = (float*)(a.ws + WS_SAG);
    const int nitems = (layer == 0) ? 512 : 256;
    for (int it = gw; it < nitems; it += NGW) {
        if (it < 256) { const int e = it >> 4, b = it & 15; topk_select<32>(AFF, INV, RIDX, SAH2, SAG, b * SEQ, e, CAPL, it * 256, lane); }
        else { const int j = it - 256, e = j >> 4, b = j & 15; topk_select<4>(AFF, INV, RIDX, SAH2, SAG, ML + b * CTX, e, CAPC, (NPL + e * 2 + (b >> 3)) * 256 + (b & 7) * CAPC, lane); }
    }
    if (gw >= nitems) { const int G_ = NGW / NWAVES, slot = (layer == 0) ? DS_TOPK0 : DS_TOPK1, idle = def_idle_waves(slot, G_), base = def_base(slot, G_);
        copy_items(a, (LAS float*)(lds + (gw / G_) * (128 * 33 * 4)), lane, base + (gw - nitems), idle, base + def_count(slot, G_)); }
}

__device__ __forceinline__ void phase_combine(const Args& a, int layer, int gw, int NGW, int lane) {
    const float* MOD = (const float*)(a.ws + WS_MOD); bf16* H = (bf16*)(a.ws + WS_H); const unsigned char* Y = a.ws + WS_Y;
    const float* AFF = (const float*)(a.ws + WS_AFF); const int* INV = (const int*)(a.ws + WS_INV); bf16* XR = (bf16*)(a.ws + WS_XR);
    const int nrows = (layer == 0) ? MA : ML;
    R16 gpo, gnx; ld_f32(gpo, a.in[I_POSTFFN] + layer * D, lane); ld_f32(gnx, a.in[I_PREMIX] + D, lane);
    const int rpw = (nrows + NGW - 1) / NGW, m_begin = gw * rpw, m_end = (m_begin + rpw < nrows) ? m_begin + rpw : nrows;
    int cur_b = -1; R16 g2, sh1, sc1;
    int inv_n = -1; float af_n = 0.f;
    int ninv_c = -1; float naf_c = 0.f; unsigned nyw[4][4]; float ngk[4]; unsigned nrest = 0; v2u nxr[4];
#define CB_IDX(mrow_, iv_, av_) do { const int m_ = (mrow_); const bool ok_ = (lane < 16) && (m_ < m_end); iv_ = ok_ ? INV[(size_t)lane * MA + m_] : -1; av_ = ok_ ? AFF[(size_t)lane * MA + m_] : 0.f; } while (0)
#define CB_REQ(mrow_, iv_, av_) do { const int m_ = (mrow_); unsigned mk_ = (unsigned)__ballot((iv_) >= 0) & 0xffffu; \
        _Pragma("unroll") for (int k = 0; k < 4; ++k) { int yr_ = 0; float g_ = 0.f;         \
            if (mk_ != 0) { const int e_ = __builtin_ctz(mk_); mk_ &= mk_ - 1; yr_ = __builtin_amdgcn_readlane((iv_), e_); g_ = __uint_as_float((unsigned)__builtin_amdgcn_readlane((int)__float_as_uint(av_), e_)) * (1.0f / YSCALE); } \
            ngk[k] = g_; _Pragma("unroll") for (int j = 0; j < 4; ++j) nyw[k][j] = ((const unsigned*)(Y + (size_t)yr_ * D))[lane + 64 * j]; } \
        nrest = mk_; ninv_c = (iv_); naf_c = (av_); \
        _Pragma("unroll") for (int j = 0; j < 4; ++j) nxr[j] = ((const v2u*)(XR + (size_t)m_ * D))[lane + 64 * j]; } while (0)
    if (m_begin < m_end) { int iv0; float av0; CB_IDX(m_begin, iv0, av0); CB_REQ(m_begin, iv0, av0); CB_IDX(m_begin + 1, inv_n, af_n); }
    for (int m = m_begin; m < m_end; ++m) {
        const int brow = (m < ML) ? (m >> 11) : 16;
        if (brow != cur_b) { const float* md = MOD + (size_t)(layer * 17 + brow) * NMOD; ld_f32(g2, md + 5120, lane);
            if (layer == 0) { const float* md1 = MOD + (size_t)(17 + brow) * NMOD; ld_f32(sh1, md1, lane); ld_f32(sc1, md1 + 1024, lane); } cur_b = brow; }
        unsigned yw[4][4]; float gk[4]; const unsigned rest = nrest; const int inv = ninv_c; const float af = naf_c; R16 x;
#pragma unroll
        for (int k = 0; k < 4; ++k) { gk[k] = ngk[k];
#pragma unroll
            for (int j = 0; j < 4; ++j) yw[k][j] = nyw[k][j]; }
#pragma unroll
        for (int j = 0; j < 4; ++j) x.v[j] = (f32x4){bflo(nxr[j].x), bfhi(nxr[j].x), bflo(nxr[j].y), bfhi(nxr[j].y)};
        if (m + 1 < m_end) { CB_REQ(m + 1, inv_n, af_n); CB_IDX(m + 2, inv_n, af_n); }
        R16 f;
#pragma unroll
        for (int j = 0; j < 4; ++j) f.v[j] = (f32x4){0.f, 0.f, 0.f, 0.f};
#pragma unroll
        for (int k = 0; k < 4; ++k)
#pragma unroll
            for (int j = 0; j < 4; ++j) { const auto lo = __builtin_amdgcn_cvt_pk_f32_fp8((int)yw[k][j], false), hi = __builtin_amdgcn_cvt_pk_f32_fp8((int)yw[k][j], true);
                f.v[j] = f.v[j] + (f32x4){lo[0], lo[1], hi[0], hi[1]} * gk[k]; }
        for (unsigned mk = rest; mk != 0; mk &= mk - 1) { const int e = __builtin_ctz(mk); const int yr = __builtin_amdgcn_readlane(inv, e);
            const float gt = __uint_as_float((unsigned)__builtin_amdgcn_readlane((int)__float_as_uint(af), e)) * (1.0f / YSCALE);
#pragma unroll
            for (int j = 0; j < 4; ++j) { const unsigned w = ((const unsigned*)(Y + (size_t)yr * D))[lane + 64 * j];
                const auto lo = __builtin_amdgcn_cvt_pk_f32_fp8((int)w, false), hi = __builtin_amdgcn_cvt_pk_f32_fp8((int)w, true); f.v[j] = f.v[j] + (f32x4){lo[0], lo[1], hi[0], hi[1]} * gt; } }
        const float rs = rms_scale(f);
#pragma unroll
        for (int j = 0; j < 4; ++j) x.v[j] = x.v[j] + g2.v[j] * ((f.v[j] * rs) * gpo.v[j]);
        if (layer == 0) st_bf16(XR + (size_t)m * D, lane, x); else st_f32(a.out + (size_t)m * D, lane, x);
        if (layer == 0) {
            const float rs2 = rms_scale(x);
#pragma unroll
            for (int j = 0; j < 4; ++j) x.v[j] = (x.v[j] * rs2) * gnx.v[j] * (sc1.v[j] + 1.0f) + sh1.v[j];
            if constexpr (QKV_I8) st_i8(a.ws + WS_H + (size_t)m * D, (float*)(a.ws + WS_SAH) + m, lane, x);
            else if constexpr (ATT8) st_fp8(a.ws + WS_H + (size_t)m * D, lane, x); else st_bf16(H + (size_t)m * D, lane, x);
        }
    }
#undef CB_IDX
#undef CB_REQ
}

constexpr float LAM_INIT = 0.35550906759096926f;
__device__ __forceinline__ void phase_finish(const Args& a, int gw, int NGW, int lane) {
    const bf16* OP = (const bf16*)(a.ws + WS_OPART); bf16* A2 = (bf16*)(a.ws + WS_BUF3);
    const float s1 = wave_sum(a.in[I_LQ1][lane] * a.in[I_LK1][lane]), s2 = wave_sum(a.in[I_LQ2][lane] * a.in[I_LK2][lane]);
    const float lam = expf(s1) - expf(s2) + LAM_INIT;
    const int h = lane >> 3, sub = lane & 7;
    float g[16];
#pragma unroll
    for (int i = 0; i < 16; ++i) g[i] = a.in[I_SUBLN][sub * 16 + i] * (1.0f - LAM_INIT);
    for (int m = gw; m < ML; m += NGW) {
        const v4u* p0 = (const v4u*)(OP + (size_t)m * 2048 + h * 256 + sub * 16); const v4u* p1 = (const v4u*)(OP + (size_t)m * 2048 + h * 256 + 128 + sub * 16);
        v4u x0[2], x1[2]; x0[0] = p0[0]; x0[1] = p0[1]; x1[0] = p1[0]; x1[1] = p1[1];
        float o[16]; float ss = 0.f;
#pragma unroll
        for (int hh = 0; hh < 2; ++hh)
#pragma unroll
            for (int q = 0; q < 4; ++q) { const int i = hh * 8 + q * 2; o[i] = bflo(x0[hh][q]) - lam * bflo(x1[hh][q]); o[i + 1] = bfhi(x0[hh][q]) - lam * bfhi(x1[hh][q]); ss += o[i] * o[i] + o[i + 1] * o[i + 1]; }
        ss += __shfl_xor(ss, 1); ss += __shfl_xor(ss, 2); ss += __shfl_xor(ss, 4);
        const float rs = 1.0f / sqrtf(ss * (1.0f / 128.0f) + EPS);
        v4u w[2];
#pragma unroll
        for (int hh = 0; hh < 2; ++hh)
#pragma unroll
            for (int q = 0; q < 4; ++q) { const int i = hh * 8 + q * 2; w[hh][q] = pk2(o[i] * rs * g[i], o[i + 1] * rs * g[i + 1]); }
        if constexpr (ATT8) { v4u w8;
#pragma unroll
            for (int q2 = 0; q2 < 4; ++q2) { const int i = q2 * 4; w8[q2] = pg8::pk4_fp8(o[i] * rs * g[i], o[i + 1] * rs * g[i + 1], o[i + 2] * rs * g[i + 2], o[i + 3] * rs * g[i + 3]); }
            *(v4u*)(a.ws + WS_BUF3 + (size_t)m * D + h * 128 + sub * 16) = w8; }
        else { v4u* dst = (v4u*)(A2 + (size_t)m * D + h * 128 + sub * 16); dst[0] = w[0]; dst[1] = w[1]; }
    }
}

__global__ void __launch_bounds__(NWAVES * 64, 2) fwd_kernel(Args args) {
    extern __shared__ __attribute__((aligned(16))) unsigned char lds_raw[];
    LAS unsigned char* lds = (LAS unsigned char*)lds_raw;
    volatile LAS unsigned* MISC = (volatile LAS unsigned*)(lds + MISC_OFF);
    const int tid = threadIdx.x, lane = tid & 63, wave = __builtin_amdgcn_readfirstlane(tid >> 6);
    const int G = gridDim.x; const int bx = blockIdx.x; const int vcu = (G % 8 == 0) ? (bx % 8) * (G / 8) + bx / 8 : bx;
    const int gw = vcu * NWAVES + wave, NGW = G * NWAVES;
    unsigned char* ws = args.ws;
    gu32* ctl = (gu32*)(ws + WS_CTL);
    for (int u = tid; u < (LDS_BYTES - LDSCTL_OFF) / 4; u += NWAVES * 64) ((LAS unsigned*)(lds + LDSCTL_OFF))[u] = 0u;
    __syncthreads();
    XcdBarrier bar; bar.bar = (unsigned*)(ctl + CW_BAR); bar.x = 0; bar.st = nullptr;
    if (!MK_SPLIT) bar = xcd_barrier_post((unsigned*)(ctl + CW_BAR), MISC + 8);
    const int lo = args.ph_lo, hi = args.ph_hi;
#ifndef PH_MASK
#define PH_MASK 0xFFFFFFFFu
#endif
#define IN(k) (((PH_MASK >> (((k) >= 14) ? (k) - 9 : (k))) & 1u) && lo <= (k) && (k) < hi)
#define SEAM(k) do { if (IN(k) && IN((k) + 1)) xcd_barrier(bar); } while (0)
#ifndef DUP_MASK
#define DUP_MASK 0u
#endif
#ifndef PROBE_NULLEPI
#define PROBE_NULLEPI 0
#endif
#ifndef PROBE_ATT
#define PROBE_ATT 0
#endif
#define REPS(k) (((DUP_MASK >> (k)) & 1u) ? 2 : 1)
#define DUPLOOP(k) _Pragma("unroll") for (int rep_ = 0; rep_ < REPS(k); (++rep_ < REPS(k)) ? xcd_barrier(bar) : (void)0)

    bf16* Hb = (bf16*)(ws + WS_H);
    if (IN(0)) DUPLOOP(0) { phase_prologue_a(args, lds, vcu, G, wave, lane_now(), wave * 64 + lane_now()); } SEAM(0);
    if (IN(1)) DUPLOOP(1) { phase_prologue_b(args, gw, NGW, lane_now()); } SEAM(1);

    if (IN(2)) DUPLOOP(2) {
        pg8::Gemm g{Hb, (const bf16*)(ws + WS_WIN), MA, 3072, (CIN_I8 || CONV8) ? D / 2 : D}; pg8::SchedGrid S{MA / 256, 12, G, bx};
        pg8::EpiConvIn E{(bf16*)(ws + WS_BUF2), (bf16*)(ws + WS_BUF1), CIN_I8 ? 1.0f / WS8 : (CONV8 ? 1.0f / WSCALE : 1.0f)};
        if constexpr (CIN_I8) pg8::gemm_phase_i8<pg8::EpiConvIn, pg8::SchedGrid, true, true>(lds, g, S, E, (const float*)(ws + WS_SAH));
        else if constexpr (CONV8) pg8::gemm_phase8<pg8::EpiConvIn, pg8::SchedGrid, true, true>(lds, g, S, E); else pg8::gemm_phase<pg8::EpiConvIn, pg8::SchedGrid, true, true>(lds, g, S, E);
        tail_items(args, lds, DS_CIN, (MA / 256) * 12, G, bx, wave, lane_now());
    } SEAM(2);
    if (IN(3)) DUPLOOP(3) { phase_conv(args, gw, NGW, lane_now()); } SEAM(3);
    if (IN(4)) DUPLOOP(4) {
        pg8::Gemm g{Hb, (const bf16*)(ws + WS_WOUT), MA, D, (COUT_I8 || CONVO8) ? D / 2 : D}; pg8::SchedGrid S{MA / 256, 4, G, bx};
        pg8::EpiPlain E{(bf16*)(ws + WS_BUF1), D, COUT_I8 ? 1.0f / WS8 : (CONVO8 ? 1.0f / WSCALE : 1.0f)};
        if constexpr (COUT_I8) pg8::gemm_phase_i8<pg8::EpiPlain, pg8::SchedGrid, true, true>(lds, g, S, E, (const float*)(ws + WS_SAH));
        else if constexpr (CONVO8) pg8::gemm_phase8<pg8::EpiPlain, pg8::SchedGrid, true, true>(lds, g, S, E); else pg8::gemm_phase<pg8::EpiPlain, pg8::SchedGrid, true, true>(lds, g, S, E);
        tail_items(args, lds, DS_COUT, (MA / 256) * 4, G, bx, wave, lane_now());
    } SEAM(4);

#define FFN_BLOCK(layer, pb) do { \
        constexpr int npanels = ((layer) == 0) ? (NPL + NPC) : NPL; \
        if (IN(pb)) DUPLOOP(pb) { phase_postmix(args, (layer), lds, gw, NGW, lane_now(), wave * 64 + lane_now()); } SEAM(pb); \
        if (IN((pb) + 1)) DUPLOOP((pb) + 1) { phase_topk(args, (layer), lds, wave * G + vcu, NGW, lane_now());     } SEAM((pb) + 1); \
        if (IN((pb) + 2)) DUPLOOP((pb) + 2) { \
            pg8::Gemm g{(const bf16*)(ws + WS_H8), (const bf16*)(ws + WS_WGU8 + (size_t)(layer) * NE * 4096 * D), npanels * 256, 4096, D / 2}; pg8::SchedMoE S{npanels, 16, G, bx}; \
            pg8::EpiSwiGLU8 E{ws + WS_HID8, FF, UP_I8 ? 1.0f / WS8 : 1.0f / WSCALE, HSCALE}; \
            if (PROBE_NULLEPI == 1 && REPS((pb) + 2) == 2 && rep_ == 0) { pg8::EpiNull E0; pg8::gemm_phase8g<pg8::EpiNull, pg8::SchedMoE, true, true>(lds, g, S, E0, (const int*)(ws + WS_RIDX)); } else \
            if (PROBE_NULLEPI == 2 && REPS((pb) + 2) == 2 && rep_ == 0) { pg8::EpiNull E0; pg8::SchedSame S0{npanels, 16, G, bx}; pg8::gemm_phase8g<pg8::EpiNull, pg8::SchedSame, true, true>(lds, g, S0, E0, (const int*)(ws + WS_RIDX)); } else \
            if constexpr (UP_I8) pg8::gemm_phase_i8g<pg8::EpiSwiGLU8, pg8::SchedMoE, true, true>(lds, g, S, E, (const int*)(ws + WS_RIDX), (const float*)(ws + WS_SAG)); else \
            pg8::gemm_phase8g<pg8::EpiSwiGLU8, pg8::SchedMoE, true, true>(lds, g, S, E, (const int*)(ws + WS_RIDX)); \
        } SEAM((pb) + 2); \
        if (IN((pb) + 3)) DUPLOOP((pb) + 3) { \
            pg8::Gemm g{(const bf16*)(ws + WS_HID8), (const bf16*)(ws + WS_WD8 + (size_t)(layer) * NE * D * FF), npanels * 256, D, FF / 2}; pg8::SchedMoE S{npanels, 4, G, bx}; \
            pg8::EpiPlain8 E{ws + WS_Y, D, YSCALE / (WSCALE * HSCALE)}; \
            pg8::gemm_phase8<pg8::EpiPlain8, pg8::SchedMoE, true, true>(lds, g, S, E); \
            if ((layer) == 0) tail_items(args, lds, DS_DOWN0, npanels * 4, G, bx, wave, lane_now()); \
        } SEAM((pb) + 3); \
        if (IN((pb) + 4)) DUPLOOP((pb) + 4) { phase_combine(args, (layer), gw, NGW, lane_now()); } \
    } while (0)

    FFN_BLOCK(0, 5); SEAM(9);

    if (IN(10)) DUPLOOP(10) {
        pg8::Gemm g{Hb, (const bf16*)(ws + WS_WQKV), MA, 3072, (QKV_I8 || ATT8) ? D / 2 : D}; pg8::SchedQKV S{G, bx};
        pg8::EpiQKV E{(bf16*)(ws + WS_BUF3), (bf16*)(ws + WS_BUF1), (bf16*)(ws + WS_BUF2), (const float*)(ws + WS_ROPE), QSCALE, QKV_I8 ? 1.0f / WS8 : (ATT8 ? 1.0f / WSCALE : 1.0f)};
        if constexpr (QKV_I8) pg8::gemm_phase_i8<pg8::EpiQKV, pg8::SchedQKV, true, true>(lds, g, S, E, (const float*)(ws + WS_SAH));
        else if constexpr (ATT8) pg8::gemm_phase8<pg8::EpiQKV, pg8::SchedQKV, true, true>(lds, g, S, E); else pg8::gemm_phase<pg8::EpiQKV, pg8::SchedQKV, true, true>(lds, g, S, E);
        tail_items(args, lds, DS_QKV, 128 * 12 + 16 * 8, G, bx, wave, lane_now());
    } SEAM(10);
    if (IN(11)) DUPLOOP(11) {
        static_assert(att::ATTN_LDS_TOTAL <= LDSCTL_OFF, "attention LDS");
        const unsigned char* Q = ws + WS_BUF3; const unsigned char* Kb = ws + WS_BUF1;   const unsigned char* Vt = ws + WS_BUF2;   unsigned char* A2 = ws + WS_OPART;
        const float s1 = wave_sum(args.in[I_LQ1][lane_now()] * args.in[I_LK1][lane_now()]), s2 = wave_sum(args.in[I_LQ2][lane_now()] * args.in[I_LK2][lane_now()]);
        const float lam = __uint_as_float(__builtin_amdgcn_readfirstlane(__float_as_uint(expf(s1) - expf(s2) + LAM_INIT)));
        for (int L = vcu; L < 1024; L += G) { const int qb = L & 7, h = (L >> 3) & 7, b = L >> 6;
            const int Ln = L + G; const bool hn = Ln < 1024; const int bhn = hn ? (Ln >> 3) : 0;
            const unsigned char* Kn = hn ? Kb + (size_t)bhn * (2 * 2304 * 64) : nullptr; const unsigned char* Vn = hn ? Vt + (size_t)bhn * (36 * 8192) : nullptr;
            if (PROBE_ATT != 0 && REPS(11) == 2 && rep_ == 0) att::attn_diff_unit<ATT8, PROBE_ATT>(Q + ((size_t)b * SEQ + qb * 256) * D + h * 128, Kb + (size_t)(b * 8 + h) * (2 * 2304 * 64), Vt + (size_t)(b * 8 + h) * (36 * 8192), nullptr, nullptr, false,
                                      A2 + ((size_t)b * SEQ + qb * 256) * (ATT8 ? D : 2 * D) + h * (ATT8 ? 128 : 256), lam, args.in[I_SUBLN], 1.0f - LAM_INIT, (char*)lds_raw, lds); else
            att::attn_diff_unit<ATT8>(Q + ((size_t)b * SEQ + qb * 256) * D + h * 128, Kb + (size_t)(b * 8 + h) * (2 * 2304 * 64), Vt + (size_t)(b * 8 + h) * (36 * 8192), Kn, Vn, L != vcu,
                                      A2 + ((size_t)b * SEQ + qb * 256) * (ATT8 ? D : 2 * D) + h * (ATT8 ? 128 : 256), lam, args.in[I_SUBLN], 1.0f - LAM_INIT, (char*)lds_raw, lds); }
    } SEAM(11);
    if (IN(13)) DUPLOOP(13) {
        pg8::Gemm g{(const bf16*)(ws + WS_OPART), (const bf16*)(ws + WS_WO), ML, D, ATT8 ? D / 2 : D}; pg8::SchedGrid S{ML / 256, 4, G, bx};
        pg8::EpiPlain E{(bf16*)(ws + WS_BUF1), D, ATT8 ? 1.0f / WSCALE : 1.0f};
        if constexpr (ATT8) pg8::gemm_phase8<pg8::EpiPlain, pg8::SchedGrid, true, true>(lds, g, S, E); else pg8::gemm_phase<pg8::EpiPlain, pg8::SchedGrid, true, true>(lds, g, S, E);
    } SEAM(13);

    FFN_BLOCK(1, 14);
#undef FFN_BLOCK
#undef IN
#undef SEAM
}

extern "C" void kernel_launch(void* const* d_in, const int* in_sizes, int n_in, void* d_out, int out_size, void* d_ws, size_t ws_size, hipStream_t stream) {
    static int grid = 0;
    if (grid == 0) {
        if (n_in != 24 || in_sizes[0] != ML * D || out_size != ML * D || ws_size < WS_END) {
            fprintf(stderr, "kernel_launch: shape mismatch: n_in %d in0 %d out %d ws %zu (need >= %zu); nothing launched\n", n_in, n_in > 0 ? in_sizes[0] : -1, out_size, ws_size, (size_t)WS_END); grid = -1; return; }
        int dev = 0, cus = 0, per_cu = 0;
        if (hipGetDevice(&dev) != hipSuccess || hipDeviceGetAttribute(&cus, hipDeviceAttributeMultiprocessorCount, dev) != hipSuccess) { fprintf(stderr, "kernel_launch: device query failed\n"); grid = -1; return; }
        if (hipFuncSetAttribute((const void*)fwd_kernel, hipFuncAttributeMaxDynamicSharedMemorySize, LDS_BYTES) != hipSuccess) { fprintf(stderr, "kernel_launch: hipFuncSetAttribute failed\n"); grid = -1; return; }
        if (hipOccupancyMaxActiveBlocksPerMultiprocessor(&per_cu, (const void*)fwd_kernel, NWAVES * 64, LDS_BYTES) != hipSuccess || per_cu < 1)
            fprintf(stderr, "kernel_launch: note: occupancy query reports %d workgroups per CU\n", per_cu);
        (void)hipGetLastError();
        grid = cus;
    }
    if (grid < 0) return;
    if (hipMemsetAsync((char*)d_ws + WS_CTL, 0, CTL_ZERO_BYTES, stream) != hipSuccess) { fprintf(stderr, "kernel_launch: memset failed\n"); return; }
    Args a{};
    for (int i = 0; i < 24; ++i) a.in[i] = (const float*)d_in[i];
    a.out = (float*)d_out; a.ws = (unsigned char*)d_ws;
#if MK_SPLIT
    for (int p = 0; p < N_PHASES; ++p) { a.ph_lo = p; a.ph_hi = p + 1; hipLaunchKernelGGL(fwd_kernel, dim3(grid), dim3(NWAVES * 64), LDS_BYTES, stream, a); }
#else
    a.ph_lo = 0; a.ph_hi = N_PHASES;
    hipLaunchKernelGGL(fwd_kernel, dim3(grid), dim3(NWAVES * 64), LDS_BYTES, stream, a);
#endif
    const hipError_t le = hipPeekAtLastError();
    if (le != hipSuccess) fprintf(stderr, "kernel_launch: launch failed: %s\n", hipGetErrorName(le));
}
```

```cpp
#include <hip/hip_runtime.h>
#include <hip/hip_bf16.h>
#include <cstdio>
#include <cstdint>
#include <cmath>

#ifndef MK_SPLIT
#define MK_SPLIT 0
#endif

namespace pg8 {
#define PG8_LAS __attribute__((address_space(3)))
typedef unsigned short bf16_t;
typedef short bf16x8 __attribute__((ext_vector_type(8)));
typedef float f32x4 __attribute__((ext_vector_type(4)));
typedef unsigned u32x4 __attribute__((ext_vector_type(4)));
constexpr int BM = 256, BK = 64, HALF = 128, HTB = HALF * BK * 2  , STAGE_BYTES = 8 * HTB, NXCD = 8, WGM = 8;

__host__ __device__ __forceinline__ int lds_byte(int r, int c) { const int st = (r >> 4) * 2 + (c >> 5), rr = r & 15, cc = c & 31, ob = rr * 64 + cc * 2; return st * 1024 + (ob ^ (((ob >> 9) & 1) << 5)); }
__host__ __device__ __forceinline__ void stage_rc(int b, int& R, int& C) { const int st = b / 1024, sb = b % 1024, swz = sb ^ (((sb >> 9) & 1) << 5); R = (st >> 1) * 16 + swz / 64; C = (st & 1) * 32 + (swz % 64) / 2; }
__host__ __device__ __forceinline__ int perm32(int rho) { const int n = rho >> 4, i = rho & 15; return 8 * (i >> 2) + 4 * n + (i & 3); }

struct Unit { int pm, pn, pb; };
struct Gemm { const bf16_t* A; const bf16_t* Bt; int M, N, K; };

__device__ __forceinline__ void tile_decode(int L, int nM, int nN, int& pm, int& pn) {
    const int nwg = nM * nN; int wgid = L;
    { const int q = nwg / NXCD, r = nwg % NXCD, xcd = wgid % NXCD, off = wgid / NXCD; wgid = (xcd < r ? xcd * (q + 1) : r * (q + 1) + (xcd - r) * q) + off; }
    const int nig = WGM * nN, gid = wgid / nig, fm = gid * WGM, gsz = (nM - fm) < WGM ? (nM - fm) : WGM;
    pm = fm + ((wgid % nig) % gsz); pn = (wgid % nig) / gsz;
}
__device__ __forceinline__ unsigned cvt_pk_bf16(float lo, float hi) { unsigned r; asm volatile("v_cvt_pk_bf16_f32 %0, %1, %2" : "=v"(r) : "v"(lo), "v"(hi)); return r; }
__device__ __forceinline__ u32x4 pack8(const f32x4 v0, const f32x4 v1) { u32x4 w; w.x = cvt_pk_bf16(v0[0], v0[1]); w.y = cvt_pk_bf16(v0[2], v0[3]); w.z = cvt_pk_bf16(v1[0], v1[1]); w.w = cvt_pk_bf16(v1[2], v1[3]); return w; }

template <class Epi, class Sched, bool ALIGN_EPI = false, bool SP2 = false>
__device__ __forceinline__ void gemm_phase(PG8_LAS unsigned char* lds, const Gemm g, const Sched& S, const Epi& E) {
    const int tid = threadIdx.x, wid = __builtin_amdgcn_readfirstlane(tid >> 6), lane = tid & 63, wr = wid >> 2, wc = wid & 3, fr = lane & 15, fq = lane >> 4;
    const int K = g.K, nt = K / BK;
    unsigned voffA[2], voffB[2];
#pragma unroll
    for (int i = 0; i < 2; ++i) { int R, C; stage_rc(tid * 16 + i * 8192, R, C); const int Rb = Epi::PERM ? ((R & ~31) + perm32(R & 31)) : R;
        voffA[i] = (unsigned)(R * K + C) * 2u; voffB[i] = (unsigned)(Rb * K + C) * 2u; }
    const size_t kstep = (size_t)(BK * 2);
    const size_t hstep = (size_t)HALF * K * 2;
    const size_t tstep = 2 * hstep;
    const unsigned ldsw = (unsigned)wid * 1024u;
    const int aoff = lds_byte(wr * 64 + fr, fq * 8), boff = lds_byte(wc * 32 + fr, fq * 8);
#define PG8_SA(b, h) (((b) * 2 + (h)) * HTB)
#define PG8_SB(b, h) ((4 + (b) * 2 + (h)) * HTB)
#define PG8_STAGE(bufoff, gbase, voff) do { _Pragma("unroll") for (int _i = 0; _i < 2; ++_i) \
        __builtin_amdgcn_global_load_lds((const unsigned*)((const char*)(gbase) + (voff)[_i]), (PG8_LAS unsigned*)(lds + (bufoff) + ldsw + _i * 8192), 16, 0, 0); } while (0)
#define PG8_LDA(dst, b, h) do { _Pragma("unroll") for (int m = 0; m < 4; ++m) _Pragma("unroll") for (int k = 0; k < 2; ++k) dst[m][k] = *(const PG8_LAS bf16x8*)(lds + PG8_SA(b, h) + aoff + m * 2048 + k * 1024); } while (0)
#define PG8_LDB(dst, b, h) do { _Pragma("unroll") for (int n = 0; n < 2; ++n) _Pragma("unroll") for (int k = 0; k < 2; ++k) dst[n][k] = *(const PG8_LAS bf16x8*)(lds + PG8_SB(b, h) + boff + n * 2048 + k * 1024); } while (0)
#define PG8_MMA(ai, bj, At, Bt) do { __builtin_amdgcn_s_setprio(1); _Pragma("unroll") for (int m = 0; m < 4; ++m) _Pragma("unroll") for (int n = 0; n < 2; ++n) _Pragma("unroll") for (int k = 0; k < 2; ++k) \
        acc[ai][bj][m][n] = __builtin_amdgcn_mfma_f32_16x16x32_bf16(Bt[n][k], At[m][k], acc[ai][bj][m][n], 0, 0, 0); __builtin_amdgcn_s_setprio(0); } while (0)
#define PG8_WAIT_V(n) asm volatile("s_waitcnt vmcnt(" #n ")" ::: "memory")
#define PG8_WAIT_L(n) asm volatile("s_waitcnt lgkmcnt(" #n ")" ::: "memory")
#define PG8_BAR __builtin_amdgcn_s_barrier()
#define PG8_SCHED __builtin_amdgcn_sched_barrier(0)
    Unit cur, nxt; int ui = 0;
    if (!S.next(0, cur)) return;
    f32x4 acc[2][2][4][2];
#pragma unroll
    for (int a = 0; a < 2; ++a)
#pragma unroll
        for (int b = 0; b < 2; ++b)
#pragma unroll
            for (int m = 0; m < 4; ++m)
#pragma unroll
                for (int n = 0; n < 2; ++n) acc[a][b][m][n] = (f32x4){0.f, 0.f, 0.f, 0.f};
    bf16x8 At[4][2], B0[2][2], B1[2][2];
    const char* cA = (const char*)g.A + (size_t)cur.pm * tstep; const char* cB = (const char*)g.Bt + (size_t)cur.pb * tstep;
    S.a_ready(cur);
    if constexpr (SP2) {
        PG8_STAGE(PG8_SB(0, 0), cB, voffB); PG8_STAGE(PG8_SB(0, 1), cB + hstep, voffB); PG8_STAGE(PG8_SA(0, 0), cA, voffA); PG8_STAGE(PG8_SA(0, 1), cA + hstep, voffA);
        if (wr == 1) PG8_BAR;
        PG8_WAIT_V(2); PG8_BAR;
        PG8_STAGE(PG8_SB(1, 0), cB + kstep, voffB); PG8_STAGE(PG8_SA(1, 0), cA + kstep, voffA); PG8_STAGE(PG8_SB(1, 1), cB + hstep + kstep, voffB);
        PG8_WAIT_V(6); PG8_BAR;
    } else {
        PG8_STAGE(PG8_SB(0, 0), cB, voffB); PG8_STAGE(PG8_SA(0, 0), cA, voffA); PG8_STAGE(PG8_SB(0, 1), cB + hstep, voffB); PG8_STAGE(PG8_SA(0, 1), cA + hstep, voffA);
        if (wr == 1) PG8_BAR;
        PG8_WAIT_V(4); PG8_BAR;
        PG8_STAGE(PG8_SB(1, 0), cB + kstep, voffB); PG8_STAGE(PG8_SA(1, 0), cA + kstep, voffA); PG8_STAGE(PG8_SB(1, 1), cB + hstep + kstep, voffB);
        PG8_WAIT_V(6); PG8_BAR;
    }
    for (;;) {
        const bool has_next = S.next(ui + 1, nxt);
        const char* nA = has_next ? (const char*)g.A + (size_t)nxt.pm * tstep : cA; const char* nB = has_next ? (const char*)g.Bt + (size_t)nxt.pb * tstep : cB;
        for (int t = 0; t < nt; t += 2) {
            const bool last = (t == nt - 2);
            const char* a1 = cA + (size_t)(t + 1) * kstep;
            const char* a2 = last ? nA : cA + (size_t)(t + 2) * kstep; const char* b2 = last ? nB : cB + (size_t)(t + 2) * kstep;
            const char* a3 = a2 + kstep; const char* b3 = b2 + kstep;
            if (last && has_next) S.a_ready(nxt);
            if constexpr (SP2) {
            PG8_LDB(B0, 0, 0); PG8_LDB(B1, 0, 1); PG8_SCHED; PG8_LDA(At, 0, 0); PG8_STAGE(PG8_SA(1, 1), a1 + hstep, voffA);
            PG8_WAIT_V(8); PG8_WAIT_L(0); PG8_BAR; PG8_MMA(0, 0, At, B0); PG8_MMA(0, 1, At, B1); PG8_BAR; PG8_SCHED;
            PG8_LDA(At, 0, 1); PG8_STAGE(PG8_SB(0, 0), b2, voffB); PG8_STAGE(PG8_SB(0, 1), b2 + hstep, voffB); PG8_STAGE(PG8_SA(0, 0), a2, voffA);
            PG8_WAIT_V(8); PG8_WAIT_L(0); PG8_BAR; PG8_MMA(1, 0, At, B0); PG8_MMA(1, 1, At, B1); PG8_BAR; PG8_SCHED;
            PG8_LDB(B0, 1, 0); PG8_LDB(B1, 1, 1); PG8_SCHED; PG8_LDA(At, 1, 0); PG8_STAGE(PG8_SA(0, 1), a2 + hstep, voffA);
            PG8_WAIT_V(8); PG8_WAIT_L(0); PG8_BAR; PG8_MMA(0, 0, At, B0); PG8_MMA(0, 1, At, B1); PG8_BAR; PG8_SCHED;
            PG8_LDA(At, 1, 1); PG8_STAGE(PG8_SB(1, 0), b3, voffB); PG8_STAGE(PG8_SB(1, 1), b3 + hstep, voffB); PG8_STAGE(PG8_SA(1, 0), a3, voffA);
            PG8_WAIT_V(8); PG8_WAIT_L(0); PG8_BAR; PG8_MMA(1, 0, At, B0); PG8_MMA(1, 1, At, B1); PG8_BAR; PG8_SCHED;
            } else {
            PG8_LDB(B0, 0, 0); PG8_SCHED; PG8_LDA(At, 0, 0); PG8_STAGE(PG8_SA(1, 1), a1 + hstep, voffA);
            PG8_WAIT_L(8); PG8_BAR; PG8_WAIT_L(0); PG8_MMA(0, 0, At, B0); PG8_BAR; PG8_SCHED;
            PG8_LDB(B1, 0, 1); PG8_STAGE(PG8_SB(0, 0), b2, voffB);
            PG8_BAR; PG8_WAIT_L(0); PG8_MMA(0, 1, At, B1); PG8_BAR;
            PG8_LDA(At, 0, 1); PG8_STAGE(PG8_SA(0, 0), a2, voffA);
            PG8_BAR; PG8_WAIT_L(0); PG8_MMA(1, 0, At, B0); PG8_BAR; PG8_SCHED;
            PG8_STAGE(PG8_SB(0, 1), b2 + hstep, voffB);
            PG8_WAIT_V(6); PG8_BAR; PG8_MMA(1, 1, At, B1); PG8_BAR;
            PG8_LDB(B0, 1, 0); PG8_SCHED; PG8_LDA(At, 1, 0); PG8_STAGE(PG8_SA(0, 1), a2 + hstep, voffA);
            PG8_WAIT_L(8); PG8_BAR; PG8_WAIT_L(0); PG8_MMA(0, 0, At, B0); PG8_BAR; PG8_SCHED;
            PG8_LDB(B1, 1, 1); PG8_STAGE(PG8_SB(1, 0), b3, voffB);
            PG8_BAR; PG8_WAIT_L(0); PG8_MMA(0, 1, At, B1); PG8_BAR;
            PG8_LDA(At, 1, 1); PG8_STAGE(PG8_SA(1, 0), a3, voffA);
            PG8_BAR; PG8_WAIT_L(0); PG8_MMA(1, 0, At, B0); PG8_BAR; PG8_SCHED;
            PG8_STAGE(PG8_SB(1, 1), b3 + hstep, voffB);
            PG8_WAIT_V(6); PG8_BAR; PG8_MMA(1, 1, At, B1); PG8_BAR;
            }
        }
        if constexpr (ALIGN_EPI) { if (wr == 0) PG8_BAR; }
        if constexpr (!Epi::AFTER_DRAIN) { E(acc, cur, wr, wc, fr, fq); S.done(cur); }
        if (!has_next) break;
#pragma unroll
        for (int a = 0; a < 2; ++a)
#pragma unroll
            for (int b = 0; b < 2; ++b)
#pragma unroll
                for (int m = 0; m < 4; ++m)
#pragma unroll
                    for (int n = 0; n < 2; ++n) acc[a][b][m][n] = (f32x4){0.f, 0.f, 0.f, 0.f};
        cur = nxt; cA = nA; cB = nB; ++ui;
        if constexpr (ALIGN_EPI) { if (wr == 1) PG8_BAR; }
    }
    PG8_WAIT_V(0);
    if constexpr (!ALIGN_EPI) { if (wr == 0) PG8_BAR; }
    PG8_BAR;
    if constexpr (Epi::AFTER_DRAIN) { E.fused(acc, cur, wr, wc, fr, fq, lds, wid, lane); S.done(cur); }
#undef PG8_SA
#undef PG8_SB
#undef PG8_STAGE
#undef PG8_LDA
#undef PG8_LDB
#undef PG8_MMA
#undef PG8_WAIT_V
#undef PG8_WAIT_L
#undef PG8_BAR
#undef PG8_SCHED
}
typedef int v4i __attribute__((ext_vector_type(4)));
typedef int v8i __attribute__((ext_vector_type(8)));
template <class Epi, class Sched, bool ALIGN_EPI = false, bool SP2 = false>
__device__ __forceinline__ void gemm_phase8(PG8_LAS unsigned char* lds, const Gemm g, const Sched& S, const Epi& E) {
    const int tid = threadIdx.x, wid = __builtin_amdgcn_readfirstlane(tid >> 6), lane = tid & 63, wr = wid >> 2, wc = wid & 3, fr = lane & 15, fq = lane >> 4;
    const int K = g.K, nt = K / BK;
    unsigned voffA[2], voffB[2];
#pragma unroll
    for (int i = 0; i < 2; ++i) { int R, C; stage_rc(tid * 16 + i * 8192, R, C); const int Rb = Epi::PERM ? ((R & ~31) + perm32(R & 31)) : R;
        voffA[i] = (unsigned)(R * K + C) * 2u; voffB[i] = (unsigned)(Rb * K + C) * 2u; }
    const size_t kstep = (size_t)(BK * 2);
    const size_t hstep = (size_t)HALF * K * 2;
    const size_t tstep = 2 * hstep;
    const unsigned ldsw = (unsigned)wid * 1024u;
    const int aoff = lds_byte(wr * 64 + fr, fq * 8), boff = lds_byte(wc * 32 + fr, fq * 8);
#define PG8_SA(b, h) (((b) * 2 + (h)) * HTB)
#define PG8_SB(b, h) ((4 + (b) * 2 + (h)) * HTB)
#define PG8_STAGE(bufoff, gbase, voff) do { _Pragma("unroll") for (int _i = 0; _i < 2; ++_i) \
        __builtin_amdgcn_global_load_lds((const unsigned*)((const char*)(gbase) + (voff)[_i]), (PG8_LAS unsigned*)(lds + (bufoff) + ldsw + _i * 8192), 16, 0, 0); } while (0)
#define PG8_LDA(dst, b, h) do { _Pragma("unroll") for (int m = 0; m < 4; ++m) { const v4i lo_ = *(const PG8_LAS v4i*)(lds + PG8_SA(b, h) + aoff + m * 2048), hi_ = *(const PG8_LAS v4i*)(lds + PG8_SA(b, h) + aoff + m * 2048 + 1024); dst[m] = __builtin_shufflevector(lo_, hi_, 0, 1, 2, 3, 4, 5, 6, 7); } } while (0)
#define PG8_LDB(dst, b, h) do { _Pragma("unroll") for (int n = 0; n < 2; ++n) { const v4i lo_ = *(const PG8_LAS v4i*)(lds + PG8_SB(b, h) + boff + n * 2048), hi_ = *(const PG8_LAS v4i*)(lds + PG8_SB(b, h) + boff + n * 2048 + 1024); dst[n] = __builtin_shufflevector(lo_, hi_, 0, 1, 2, 3, 4, 5, 6, 7); } } while (0)
#define PG8_MMA(ai, bj, At, Bt) do { __builtin_amdgcn_s_setprio(1); _Pragma("unroll") for (int m = 0; m < 4; ++m) _Pragma("unroll") for (int n = 0; n < 2; ++n) \
        asm volatile("v_mfma_f32_16x16x128_f8f6f4 %0, %1, %2, %0" : "+v"(acc[ai][bj][m][n]) : "v"(Bt[n]), "v"(At[m])); __builtin_amdgcn_s_setprio(0); } while (0)
#define PG8_WAIT_V(n) asm volatile("s_waitcnt vmcnt(" #n ")" ::: "memory")
#define PG8_WAIT_L(n) asm volatile("s_waitcnt lgkmcnt(" #n ")" ::: "memory")
#define PG8_BAR __builtin_amdgcn_s_barrier()
#define PG8_SCHED __builtin_amdgcn_sched_barrier(0)
    Unit cur, nxt; int ui = 0;
    if (!S.next(0, cur)) return;
    f32x4 acc[2][2][4][2];
#pragma unroll
    for (int a = 0; a < 2; ++a)
#pragma unroll
        for (int b = 0; b < 2; ++b)
#pragma unroll
            for (int m = 0; m < 4; ++m)
#pragma unroll
                for (int n = 0; n < 2; ++n) acc[a][b][m][n] = (f32x4){0.f, 0.f, 0.f, 0.f};
    v8i At[4], B0[2], B1[2];
    const char* cA = (const char*)g.A + (size_t)cur.pm * tstep; const char* cB = (const char*)g.Bt + (size_t)cur.pb * tstep;
    S.a_ready(cur);
    if constexpr (SP2) {
        PG8_STAGE(PG8_SB(0, 0), cB, voffB); PG8_STAGE(PG8_SB(0, 1), cB + hstep, voffB); PG8_STAGE(PG8_SA(0, 0), cA, voffA); PG8_STAGE(PG8_SA(0, 1), cA + hstep, voffA);
        if (wr == 1) PG8_BAR;
        PG8_WAIT_V(2); PG8_BAR;
        PG8_STAGE(PG8_SB(1, 0), cB + kstep, voffB); PG8_STAGE(PG8_SA(1, 0), cA + kstep, voffA); PG8_STAGE(PG8_SB(1, 1), cB + hstep + kstep, voffB);
        PG8_WAIT_V(6); PG8_BAR;
    } else {
        PG8_STAGE(PG8_SB(0, 0), cB, voffB); PG8_STAGE(PG8_SA(0, 0), cA, voffA); PG8_STAGE(PG8_SB(0, 1), cB + hstep, voffB); PG8_STAGE(PG8_SA(0, 1), cA + hstep, voffA);
        if (wr == 1) PG8_BAR;
        PG8_WAIT_V(4); PG8_BAR;
        PG8_STAGE(PG8_SB(1, 0), cB + kstep, voffB); PG8_STAGE(PG8_SA(1, 0), cA + kstep, voffA); PG8_STAGE(PG8_SB(1, 1), cB + hstep + kstep, voffB);
        PG8_WAIT_V(6); PG8_BAR;
    }
    for (;;) {
        const bool has_next = S.next(ui + 1, nxt);
        const char* nA = has_next ? (const char*)g.A + (size_t)nxt.pm * tstep : cA; const char* nB = has_next ? (const char*)g.Bt + (size_t)nxt.pb * tstep : cB;
#pragma unroll 1
        for (int t = 0; t < nt; t += 2) {
            const bool last = (t == nt - 2);
            const char* a1 = cA + (size_t)(t + 1) * kstep;
            const char* a2 = last ? nA : cA + (size_t)(t + 2) * kstep; const char* b2 = last ? nB : cB + (size_t)(t + 2) * kstep;
            const char* a3 = a2 + kstep; const char* b3 = b2 + kstep;
            if (last && has_next) S.a_ready(nxt);
            if constexpr (SP2) {
            PG8_LDB(B0, 0, 0); PG8_LDB(B1, 0, 1); PG8_SCHED; PG8_LDA(At, 0, 0); PG8_STAGE(PG8_SA(1, 1), a1 + hstep, voffA);
            PG8_WAIT_V(8); PG8_WAIT_L(0); PG8_BAR; PG8_MMA(0, 0, At, B0); PG8_MMA(0, 1, At, B1); PG8_BAR; PG8_SCHED;
            PG8_LDA(At, 0, 1); PG8_STAGE(PG8_SB(0, 0), b2, voffB); PG8_STAGE(PG8_SB(0, 1), b2 + hstep, voffB); PG8_STAGE(PG8_SA(0, 0), a2, voffA);
            PG8_WAIT_V(8); PG8_WAIT_L(0); PG8_BAR; PG8_MMA(1, 0, At, B0); PG8_MMA(1, 1, At, B1); PG8_BAR; PG8_SCHED;
            PG8_LDB(B0, 1, 0); PG8_LDB(B1, 1, 1); PG8_SCHED; PG8_LDA(At, 1, 0); PG8_STAGE(PG8_SA(0, 1), a2 + hstep, voffA);
            PG8_WAIT_V(8); PG8_WAIT_L(0); PG8_BAR; PG8_MMA(0, 0, At, B0); PG8_MMA(0, 1, At, B1); PG8_BAR; PG8_SCHED;
            PG8_LDA(At, 1, 1); PG8_STAGE(PG8_SB(1, 0), b3, voffB); PG8_STAGE(PG8_SB(1, 1), b3 + hstep, voffB); PG8_STAGE(PG8_SA(1, 0), a3, voffA);
            PG8_WAIT_V(8); PG8_WAIT_L(0); PG8_BAR; PG8_MMA(1, 0, At, B0); PG8_MMA(1, 1, At, B1); PG8_BAR; PG8_SCHED;
            } else {
            PG8_LDB(B0, 0, 0); PG8_SCHED; PG8_LDA(At, 0, 0); PG8_STAGE(PG8_SA(1, 1), a1 + hstep, voffA);
            PG8_WAIT_L(8); PG8_BAR; PG8_WAIT_L(0); PG8_MMA(0, 0, At, B0); PG8_BAR; PG8_SCHED;
            PG8_LDB(B1, 0, 1); PG8_STAGE(PG8_SB(0, 0), b2, voffB);
            PG8_BAR; PG8_WAIT_L(0); PG8_MMA(0, 1, At, B1); PG8_BAR;
            PG8_LDA(At, 0, 1); PG8_STAGE(PG8_SA(0, 0), a2, voffA);
            PG8_BAR; PG8_WAIT_L(0); PG8_MMA(1, 0, At, B0); PG8_BAR; PG8_SCHED;
            PG8_STAGE(PG8_SB(0, 1), b2 + hstep, voffB);
            PG8_WAIT_V(6); PG8_BAR; PG8_MMA(1, 1, At, B1); PG8_BAR;
            PG8_LDB(B0, 1, 0); PG8_SCHED; PG8_LDA(At, 1, 0); PG8_STAGE(PG8_SA(0, 1), a2 + hstep, voffA);
            PG8_WAIT_L(8); PG8_BAR; PG8_WAIT_L(0); PG8_MMA(0, 0, At, B0); PG8_BAR; PG8_SCHED;
            PG8_LDB(B1, 1, 1); PG8_STAGE(PG8_SB(1, 0), b3, voffB);
            PG8_BAR; PG8_WAIT_L(0); PG8_MMA(0, 1, At, B1); PG8_BAR;
            PG8_LDA(At, 1, 1); PG8_STAGE(PG8_SA(1, 0), a3, voffA);
            PG8_BAR; PG8_WAIT_L(0); PG8_MMA(1, 0, At, B0); PG8_BAR; PG8_SCHED;
            PG8_STAGE(PG8_SB(1, 1), b3 + hstep, voffB);
            PG8_WAIT_V(6); PG8_BAR; PG8_MMA(1, 1, At, B1); PG8_BAR;
            }
        }
        if constexpr (ALIGN_EPI) { if (wr == 0) PG8_BAR; }
        asm volatile("s_nop 15\n\ts_nop 15" ::: "memory");
        if constexpr (!Epi::AFTER_DRAIN) { E(acc, cur, wr, wc, fr, fq); S.done(cur); }
        if (!has_next) break;
#pragma unroll
        for (int a = 0; a < 2; ++a)
#pragma unroll
            for (int b = 0; b < 2; ++b)
#pragma unroll
                for (int m = 0; m < 4; ++m)
#pragma unroll
                    for (int n = 0; n < 2; ++n) acc[a][b][m][n] = (f32x4){0.f, 0.f, 0.f, 0.f};
        cur = nxt; cA = nA; cB = nB; ++ui;
        if constexpr (ALIGN_EPI) { if (wr == 1) PG8_BAR; }
    }
    PG8_WAIT_V(0);
    if constexpr (!ALIGN_EPI) { if (wr == 0) PG8_BAR; }
    PG8_BAR;
    if constexpr (Epi::AFTER_DRAIN) { E.fused(acc, cur, wr, wc, fr, fq, lds, wid, lane); S.done(cur); }
#undef PG8_SA
#undef PG8_SB
#undef PG8_STAGE
#undef PG8_LDA
#undef PG8_LDB
#undef PG8_MMA
#undef PG8_WAIT_V
#undef PG8_WAIT_L
#undef PG8_BAR
#undef PG8_SCHED
}
template <class Epi, class Sched, bool ALIGN_EPI = false, bool SP2 = false>
__device__ __forceinline__ void gemm_phase8g(PG8_LAS unsigned char* lds, const Gemm g, const Sched& S, const Epi& E, const int* __restrict__ ridx) {
    const int tid = threadIdx.x, wid = __builtin_amdgcn_readfirstlane(tid >> 6), lane = tid & 63, wr = wid >> 2, wc = wid & 3, fr = lane & 15, fq = lane >> 4;
    const int K = g.K, nt = K / BK;
    unsigned voffB[2]; int arow[2]; unsigned acol[2];
#pragma unroll
    for (int i = 0; i < 2; ++i) { int R, C; stage_rc(tid * 16 + i * 8192, R, C); const int Rb = Epi::PERM ? ((R & ~31) + perm32(R & 31)) : R;
        arow[i] = R; acol[i] = (unsigned)C * 2u; voffB[i] = (unsigned)(Rb * K + C) * 2u; }
    constexpr int IDXB_OFF = STAGE_BYTES;
    unsigned offc[2][2], offn[2][2];
#define PG8_LDIDX(dst, pm_) do { _Pragma("unroll") for (int h_ = 0; h_ < 2; ++h_) _Pragma("unroll") for (int i_ = 0; i_ < 2; ++i_) \
        dst[h_][i_] = (unsigned)ridx[(pm_) * BM + h_ * HALF + arow[i_]] * (unsigned)(K * 2) + acol[i_]; } while (0)
#define PG8_STAGE_G(bufoff, gbase, off2) do { _Pragma("unroll") for (int _i = 0; _i < 2; ++_i) \
        __builtin_amdgcn_global_load_lds((const unsigned*)((const char*)(gbase) + (off2)[_i]), (PG8_LAS unsigned*)(lds + (bufoff) + ldsw + _i * 8192), 16, 0, 0); } while (0)
    const size_t kstep = (size_t)(BK * 2);
    const size_t hstep = (size_t)HALF * K * 2;
    const size_t tstep = 2 * hstep;
    const unsigned ldsw = (unsigned)wid * 1024u;
    const int aoff = lds_byte(wr * 64 + fr, fq * 8), boff = lds_byte(wc * 32 + fr, fq * 8);
#define PG8_SA(b, h) (((b) * 2 + (h)) * HTB)
#define PG8_SB(b, h) ((4 + (b) * 2 + (h)) * HTB)
#define PG8_STAGE(bufoff, gbase, voff) do { _Pragma("unroll") for (int _i = 0; _i < 2; ++_i) \
        __builtin_amdgcn_global_load_lds((const unsigned*)((const char*)(gbase) + (voff)[_i]), (PG8_LAS unsigned*)(lds + (bufoff) + ldsw + _i * 8192), 16, 0, 0); } while (0)
#define PG8_LDA(dst, b, h) do { _Pragma("unroll") for (int m = 0; m < 4; ++m) { const v4i lo_ = *(const PG8_LAS v4i*)(lds + PG8_SA(b, h) + aoff + m * 2048), hi_ = *(const PG8_LAS v4i*)(lds + PG8_SA(b, h) + aoff + m * 2048 + 1024); dst[m] = __builtin_shufflevector(lo_, hi_, 0, 1, 2, 3, 4, 5, 6, 7); } } while (0)
#define PG8_LDB(dst, b, h) do { _Pragma("unroll") for (int n = 0; n < 2; ++n) { const v4i lo_ = *(const PG8_LAS v4i*)(lds + PG8_SB(b, h) + boff + n * 2048), hi_ = *(const PG8_LAS v4i*)(lds + PG8_SB(b, h) + boff + n * 2048 + 1024); dst[n] = __builtin_shufflevector(lo_, hi_, 0, 1, 2, 3, 4, 5, 6, 7); } } while (0)
#define PG8_MMA(ai, bj, At, Bt) do { __builtin_amdgcn_s_setprio(1); _Pragma("unroll") for (int m = 0; m < 4; ++m) _Pragma("unroll") for (int n = 0; n < 2; ++n) \
        asm volatile("v_mfma_f32_16x16x128_f8f6f4 %0, %1, %2, %0" : "+v"(acc[ai][bj][m][n]) : "v"(Bt[n]), "v"(At[m])); __builtin_amdgcn_s_setprio(0); } while (0)
#define PG8_WAIT_V(n) asm volatile("s_waitcnt vmcnt(" #n ")" ::: "memory")
#define PG8_WAIT_L(n) asm volatile("s_waitcnt lgkmcnt(" #n ")" ::: "memory")
#define PG8_BAR __builtin_amdgcn_s_barrier()
#define PG8_SCHED __builtin_amdgcn_sched_barrier(0)
    Unit cur, nxt; int ui = 0;
    if (!S.next(0, cur)) return;
    f32x4 acc[2][2][4][2];
#pragma unroll
    for (int a = 0; a < 2; ++a)
#pragma unroll
        for (int b = 0; b < 2; ++b)
#pragma unroll
            for (int m = 0; m < 4; ++m)
#pragma unroll
                for (int n = 0; n < 2; ++n) acc[a][b][m][n] = (f32x4){0.f, 0.f, 0.f, 0.f};
    v8i At[4], B0[2], B1[2];
    const char* gA0 = (const char*)g.A; const char* cB = (const char*)g.Bt + (size_t)cur.pb * tstep; PG8_LDIDX(offc, cur.pm);
    S.a_ready(cur);
    if constexpr (SP2) {
        PG8_STAGE(PG8_SB(0, 0), cB, voffB); PG8_STAGE(PG8_SB(0, 1), cB + hstep, voffB); PG8_STAGE_G(PG8_SA(0, 0), gA0, offc[0]); PG8_STAGE_G(PG8_SA(0, 1), gA0, offc[1]);
        if (wr == 1) PG8_BAR;
        PG8_WAIT_V(2); PG8_BAR;
        PG8_STAGE(PG8_SB(1, 0), cB + kstep, voffB); PG8_STAGE_G(PG8_SA(1, 0), gA0 + kstep, offc[0]); PG8_STAGE(PG8_SB(1, 1), cB + hstep + kstep, voffB);
        PG8_WAIT_V(6); PG8_BAR;
    } else {
        PG8_STAGE(PG8_SB(0, 0), cB, voffB); PG8_STAGE_G(PG8_SA(0, 0), gA0, offc[0]); PG8_STAGE(PG8_SB(0, 1), cB + hstep, voffB); PG8_STAGE_G(PG8_SA(0, 1), gA0, offc[1]);
        if (wr == 1) PG8_BAR;
        PG8_WAIT_V(4); PG8_BAR;
        PG8_STAGE(PG8_SB(1, 0), cB + kstep, voffB); PG8_STAGE_G(PG8_SA(1, 0), gA0 + kstep, offc[0]); PG8_STAGE(PG8_SB(1, 1), cB + hstep + kstep, voffB);
        PG8_WAIT_V(6); PG8_BAR;
    }
    for (;;) {
        const bool has_next = S.next(ui + 1, nxt);
        const char* nB = has_next ? (const char*)g.Bt + (size_t)nxt.pb * tstep : cB;
        if (!has_next) {
#pragma unroll
            for (int h_ = 0; h_ < 2; ++h_) { offn[h_][0] = offc[h_][0]; offn[h_][1] = offc[h_][1]; } }
#pragma unroll 1
        for (int t = 0; t < nt; t += 2) {
            const bool last = (t == nt - 2);
            if (has_next && t == nt - 4 && wid == 0)
                __builtin_amdgcn_global_load_lds((const unsigned*)(ridx + nxt.pm * BM + lane * 4), (PG8_LAS unsigned*)(lds + IDXB_OFF + ((ui + 1) & 1) * 1024), 16, 0, 0);
            if (has_next && last) {
                const PG8_LAS int* ib = (const PG8_LAS int*)(lds + IDXB_OFF + ((ui + 1) & 1) * 1024);
#pragma unroll
                for (int h_ = 0; h_ < 2; ++h_)
#pragma unroll
                    for (int i_ = 0; i_ < 2; ++i_) offn[h_][i_] = (unsigned)ib[h_ * HALF + arow[i_]] * (unsigned)(K * 2) + acol[i_]; }
            const char* a1 = gA0 + (size_t)(t + 1) * kstep;
            const char* a2 = last ? gA0 : gA0 + (size_t)(t + 2) * kstep; const char* b2 = last ? nB : cB + (size_t)(t + 2) * kstep;
            const char* a3 = a2 + kstep; const char* b3 = b2 + kstep;
            unsigned o2[2][2];
#pragma unroll
            for (int h_ = 0; h_ < 2; ++h_) { o2[h_][0] = last ? offn[h_][0] : offc[h_][0]; o2[h_][1] = last ? offn[h_][1] : offc[h_][1]; }
            if (last && has_next) S.a_ready(nxt);
            if constexpr (SP2) {
            PG8_LDB(B0, 0, 0); PG8_LDB(B1, 0, 1); PG8_SCHED; PG8_LDA(At, 0, 0); PG8_STAGE_G(PG8_SA(1, 1), a1, offc[1]);
            PG8_WAIT_V(8); PG8_WAIT_L(0); PG8_BAR; PG8_MMA(0, 0, At, B0); PG8_MMA(0, 1, At, B1); PG8_BAR; PG8_SCHED;
            PG8_LDA(At, 0, 1); PG8_STAGE(PG8_SB(0, 0), b2, voffB); PG8_STAGE(PG8_SB(0, 1), b2 + hstep, voffB); PG8_STAGE_G(PG8_SA(0, 0), a2, o2[0]);
            PG8_WAIT_V(8); PG8_WAIT_L(0); PG8_BAR; PG8_MMA(1, 0, At, B0); PG8_MMA(1, 1, At, B1); PG8_BAR; PG8_SCHED;
            PG8_LDB(B0, 1, 0); PG8_LDB(B1, 1, 1); PG8_SCHED; PG8_LDA(At, 1, 0); PG8_STAGE_G(PG8_SA(0, 1), a2, o2[1]);
            PG8_WAIT_V(8); PG8_WAIT_L(0); PG8_BAR; PG8_MMA(0, 0, At, B0); PG8_MMA(0, 1, At, B1); PG8_BAR; PG8_SCHED;
            PG8_LDA(At, 1, 1); PG8_STAGE(PG8_SB(1, 0), b3, voffB); PG8_STAGE(PG8_SB(1, 1), b3 + hstep, voffB); PG8_STAGE_G(PG8_SA(1, 0), a3, o2[0]);
            PG8_WAIT_V(8); PG8_WAIT_L(0); PG8_BAR; PG8_MMA(1, 0, At, B0); PG8_MMA(1, 1, At, B1); PG8_BAR; PG8_SCHED;
            } else {
            PG8_LDB(B0, 0, 0); PG8_SCHED; PG8_LDA(At, 0, 0); PG8_STAGE_G(PG8_SA(1, 1), a1, offc[1]);
            PG8_WAIT_L(8); PG8_BAR; PG8_WAIT_L(0); PG8_MMA(0, 0, At, B0); PG8_BAR; PG8_SCHED;
            PG8_LDB(B1, 0, 1); PG8_STAGE(PG8_SB(0, 0), b2, voffB);
            PG8_BAR; PG8_WAIT_L(0); PG8_MMA(0, 1, At, B1); PG8_BAR;
            PG8_LDA(At, 0, 1); PG8_STAGE_G(PG8_SA(0, 0), a2, o2[0]);
            PG8_BAR; PG8_WAIT_L(0); PG8_MMA(1, 0, At, B0); PG8_BAR; PG8_SCHED;
            PG8_STAGE(PG8_SB(0, 1), b2 + hstep, voffB);
            PG8_WAIT_V(6); PG8_BAR; PG8_MMA(1, 1, At, B1); PG8_BAR;
            PG8_LDB(B0, 1, 0); PG8_SCHED; PG8_LDA(At, 1, 0); PG8_STAGE_G(PG8_SA(0, 1), a2, o2[1]);
            PG8_WAIT_L(8); PG8_BAR; PG8_WAIT_L(0); PG8_MMA(0, 0, At, B0); PG8_BAR; PG8_SCHED;
            PG8_LDB(B1, 1, 1); PG8_STAGE(PG8_SB(1, 0), b3, voffB);
            PG8_BAR; PG8_WAIT_L(0); PG8_MMA(0, 1, At, B1); PG8_BAR;
            PG8_LDA(At, 1, 1); PG8_STAGE_G(PG8_SA(1, 0), a3, o2[0]);
            PG8_BAR; PG8_WAIT_L(0); PG8_MMA(1, 0, At, B0); PG8_BAR; PG8_SCHED;
            PG8_STAGE(PG8_SB(1, 1), b3 + hstep, voffB);
            PG8_WAIT_V(6); PG8_BAR; PG8_MMA(1, 1, At, B1); PG8_BAR;
            }
        }
        if constexpr (ALIGN_EPI) { if (wr == 0) PG8_BAR; }
        asm volatile("s_nop 15\n\ts_nop 15" ::: "memory");
        if constexpr (!Epi::AFTER_DRAIN) { E(acc, cur, wr, wc, fr, fq); S.done(cur); }
        if (!has_next) break;
#pragma unroll
        for (int a = 0; a < 2; ++a)
#pragma unroll
            for (int b = 0; b < 2; ++b)
#pragma unroll
                for (int m = 0; m < 4; ++m)
#pragma unroll
                    for (int n = 0; n < 2; ++n) acc[a][b][m][n] = (f32x4){0.f, 0.f, 0.f, 0.f};
        cur = nxt; cB = nB; ++ui;
#pragma unroll
        for (int h_ = 0; h_ < 2; ++h_) { offc[h_][0] = offn[h_][0]; offc[h_][1] = offn[h_][1]; }
        if constexpr (ALIGN_EPI) { if (wr == 1) PG8_BAR; }
    }
    PG8_WAIT_V(0);
    if constexpr (!ALIGN_EPI) { if (wr == 0) PG8_BAR; }
    PG8_BAR;
    if constexpr (Epi::AFTER_DRAIN) { E.fused(acc, cur, wr, wc, fr, fq, lds, wid, lane); S.done(cur); }
#undef PG8_SA
#undef PG8_SB
#undef PG8_STAGE
#undef PG8_STAGE_G
#undef PG8_LDIDX
#undef PG8_LDA
#undef PG8_LDB
#undef PG8_MMA
#undef PG8_WAIT_V
#undef PG8_WAIT_L
#undef PG8_BAR
#undef PG8_SCHED
}
template <class Epi, class Sched, bool ALIGN_EPI = false, bool SP2 = false>
__device__ __forceinline__ void gemm_phase_i8(PG8_LAS unsigned char* lds, const Gemm g, const Sched& S, const Epi& E, const float* __restrict__ rowscale) {
    const int tid = threadIdx.x, wid = __builtin_amdgcn_readfirstlane(tid >> 6), lane = tid & 63, wr = wid >> 2, wc = wid & 3, fr = lane & 15, fq = lane >> 4;
    const int K = g.K, nt = K / BK;
    unsigned voffA[2], voffB[2];
#pragma unroll
    for (int i = 0; i < 2; ++i) { int R, C; stage_rc(tid * 16 + i * 8192, R, C); const int Rb = Epi::PERM ? ((R & ~31) + perm32(R & 31)) : R;
        voffA[i] = (unsigned)(R * K + C) * 2u; voffB[i] = (unsigned)(Rb * K + C) * 2u; }
    const size_t kstep = (size_t)(BK * 2);
    const size_t hstep = (size_t)HALF * K * 2;
    const size_t tstep = 2 * hstep;
    const unsigned ldsw = (unsigned)wid * 1024u;
    const int aoff = lds_byte(wr * 64 + fr, fq * 8), boff = lds_byte(wc * 32 + fr, fq * 8);
#define PG8_SA(b, h) (((b) * 2 + (h)) * HTB)
#define PG8_SB(b, h) ((4 + (b) * 2 + (h)) * HTB)
#define PG8_STAGE(bufoff, gbase, voff) do { _Pragma("unroll") for (int _i = 0; _i < 2; ++_i) \
        __builtin_amdgcn_global_load_lds((const unsigned*)((const char*)(gbase) + (voff)[_i]), (PG8_LAS unsigned*)(lds + (bufoff) + ldsw + _i * 8192), 16, 0, 0); } while (0)
#define PG8_LDA(dst, b, h) do { _Pragma("unroll") for (int m = 0; m < 4; ++m) _Pragma("unroll") for (int k = 0; k < 2; ++k) dst[m][k] = *(const PG8_LAS bf16x8*)(lds + PG8_SA(b, h) + aoff + m * 2048 + k * 1024); } while (0)
#define PG8_LDB(dst, b, h) do { _Pragma("unroll") for (int n = 0; n < 2; ++n) _Pragma("unroll") for (int k = 0; k < 2; ++k) dst[n][k] = *(const PG8_LAS bf16x8*)(lds + PG8_SB(b, h) + boff + n * 2048 + k * 1024); } while (0)
#define PG8_MMA(ai, bj, At, Bt) do { __builtin_amdgcn_s_setprio(1); _Pragma("unroll") for (int m = 0; m < 4; ++m) _Pragma("unroll") for (int n = 0; n < 2; ++n) _Pragma("unroll") for (int k = 0; k < 2; ++k) \
        acc[ai][bj][m][n] = __builtin_bit_cast(f32x4, __builtin_amdgcn_mfma_i32_16x16x64_i8(__builtin_bit_cast(v4i, Bt[n][k]), __builtin_bit_cast(v4i, At[m][k]), __builtin_bit_cast(v4i, acc[ai][bj][m][n]), 0, 0, 0)); __builtin_amdgcn_s_setprio(0); } while (0)
#define PG8_WAIT_V(n) asm volatile("s_waitcnt vmcnt(" #n ")" ::: "memory")
#define PG8_WAIT_L(n) asm volatile("s_waitcnt lgkmcnt(" #n ")" ::: "memory")
#define PG8_BAR __builtin_amdgcn_s_barrier()
#define PG8_SCHED __builtin_amdgcn_sched_barrier(0)
    Unit cur, nxt; int ui = 0;
    if (!S.next(0, cur)) return;
    f32x4 acc[2][2][4][2];
#pragma unroll
    for (int a = 0; a < 2; ++a)
#pragma unroll
        for (int b = 0; b < 2; ++b)
#pragma unroll
            for (int m = 0; m < 4; ++m)
#pragma unroll
                for (int n = 0; n < 2; ++n) acc[a][b][m][n] = (f32x4){0.f, 0.f, 0.f, 0.f};
    bf16x8 At[4][2], B0[2][2], B1[2][2];
    const char* cA = (const char*)g.A + (size_t)cur.pm * tstep; const char* cB = (const char*)g.Bt + (size_t)cur.pb * tstep;
    constexpr int SCB_OFF = STAGE_BYTES + 2048;
    if (wid == 0) __builtin_amdgcn_global_load_lds((const unsigned*)(rowscale + cur.pm * BM + lane * 4), (PG8_LAS unsigned*)(lds + SCB_OFF), 16, 0, 0);
    S.a_ready(cur);
    if constexpr (SP2) {
        PG8_STAGE(PG8_SB(0, 0), cB, voffB); PG8_STAGE(PG8_SB(0, 1), cB + hstep, voffB); PG8_STAGE(PG8_SA(0, 0), cA, voffA); PG8_STAGE(PG8_SA(0, 1), cA + hstep, voffA);
        if (wr == 1) PG8_BAR;
        PG8_WAIT_V(2); PG8_BAR;
        PG8_STAGE(PG8_SB(1, 0), cB + kstep, voffB); PG8_STAGE(PG8_SA(1, 0), cA + kstep, voffA); PG8_STAGE(PG8_SB(1, 1), cB + hstep + kstep, voffB);
        PG8_WAIT_V(6); PG8_BAR;
    } else {
        PG8_STAGE(PG8_SB(0, 0), cB, voffB); PG8_STAGE(PG8_SA(0, 0), cA, voffA); PG8_STAGE(PG8_SB(0, 1), cB + hstep, voffB); PG8_STAGE(PG8_SA(0, 1), cA + hstep, voffA);
        if (wr == 1) PG8_BAR;
        PG8_WAIT_V(4); PG8_BAR;
        PG8_STAGE(PG8_SB(1, 0), cB + kstep, voffB); PG8_STAGE(PG8_SA(1, 0), cA + kstep, voffA); PG8_STAGE(PG8_SB(1, 1), cB + hstep + kstep, voffB);
        PG8_WAIT_V(6); PG8_BAR;
    }
    for (;;) {
        const bool has_next = S.next(ui + 1, nxt);
        const char* nA = has_next ? (const char*)g.A + (size_t)nxt.pm * tstep : cA; const char* nB = has_next ? (const char*)g.Bt + (size_t)nxt.pb * tstep : cB;
#pragma unroll 1
        for (int t = 0; t < nt; t += 2) {
            const bool last = (t == nt - 2);
            if (has_next && t == nt - 4 && wid == 0)
                __builtin_amdgcn_global_load_lds((const unsigned*)(rowscale + nxt.pm * BM + lane * 4), (PG8_LAS unsigned*)(lds + SCB_OFF + ((ui + 1) & 1) * 1024), 16, 0, 0);
            const char* a1 = cA + (size_t)(t + 1) * kstep;
            const char* a2 = last ? nA : cA + (size_t)(t + 2) * kstep; const char* b2 = last ? nB : cB + (size_t)(t + 2) * kstep;
            const char* a3 = a2 + kstep; const char* b3 = b2 + kstep;
            if (last && has_next) S.a_ready(nxt);
            if constexpr (SP2) {
            PG8_LDB(B0, 0, 0); PG8_LDB(B1, 0, 1); PG8_SCHED; PG8_LDA(At, 0, 0); PG8_STAGE(PG8_SA(1, 1), a1 + hstep, voffA);
            PG8_WAIT_V(8); PG8_WAIT_L(0); PG8_BAR; PG8_MMA(0, 0, At, B0); PG8_MMA(0, 1, At, B1); PG8_BAR; PG8_SCHED;
            PG8_LDA(At, 0, 1); PG8_STAGE(PG8_SB(0, 0), b2, voffB); PG8_STAGE(PG8_SB(0, 1), b2 + hstep, voffB); PG8_STAGE(PG8_SA(0, 0), a2, voffA);
            PG8_WAIT_V(8); PG8_WAIT_L(0); PG8_BAR; PG8_MMA(1, 0, At, B0); PG8_MMA(1, 1, At, B1); PG8_BAR; PG8_SCHED;
            PG8_LDB(B0, 1, 0); PG8_LDB(B1, 1, 1); PG8_SCHED; PG8_LDA(At, 1, 0); PG8_STAGE(PG8_SA(0, 1), a2 + hstep, voffA);
            PG8_WAIT_V(8); PG8_WAIT_L(0); PG8_BAR; PG8_MMA(0, 0, At, B0); PG8_MMA(0, 1, At, B1); PG8_BAR; PG8_SCHED;
            PG8_LDA(At, 1, 1); PG8_STAGE(PG8_SB(1, 0), b3, voffB); PG8_STAGE(PG8_SB(1, 1), b3 + hstep, voffB); PG8_STAGE(PG8_SA(1, 0), a3, voffA);
            PG8_WAIT_V(8); PG8_WAIT_L(0); PG8_BAR; PG8_MMA(1, 0, At, B0); PG8_MMA(1, 1, At, B1); PG8_BAR; PG8_SCHED;
            } else {
            PG8_LDB(B0, 0, 0); PG8_SCHED; PG8_LDA(At, 0, 0); PG8_STAGE(PG8_SA(1, 1), a1 + hstep, voffA);
            PG8_WAIT_L(8); PG8_BAR; PG8_WAIT_L(0); PG8_MMA(0, 0, At, B0); PG8_BAR; PG8_SCHED;
            PG8_LDB(B1, 0, 1); PG8_STAGE(PG8_SB(0, 0), b2, voffB);
            PG8_BAR; PG8_WAIT_L(0); PG8_MMA(0, 1, At, B1); PG8_BAR;
            PG8_LDA(At, 0, 1); PG8_STAGE(PG8_SA(0, 0), a2, voffA);
            PG8_BAR; PG8_WAIT_L(0); PG8_MMA(1, 0, At, B0); PG8_BAR; PG8_SCHED;
            PG8_STAGE(PG8_SB(0, 1), b2 + hstep, voffB);
            PG8_WAIT_V(6); PG8_BAR; PG8_MMA(1, 1, At, B1); PG8_BAR;
            PG8_LDB(B0, 1, 0); PG8_SCHED; PG8_LDA(At, 1, 0); PG8_STAGE(PG8_SA(0, 1), a2 + hstep, voffA);
            PG8_WAIT_L(8); PG8_BAR; PG8_WAIT_L(0); PG8_MMA(0, 0, At, B0); PG8_BAR; PG8_SCHED;
            PG8_LDB(B1, 1, 1); PG8_STAGE(PG8_SB(1, 0), b3, voffB);
            PG8_BAR; PG8_WAIT_L(0); PG8_MMA(0, 1, At, B1); PG8_BAR;
            PG8_LDA(At, 1, 1); PG8_STAGE(PG8_SA(1, 0), a3, voffA);
            PG8_BAR; PG8_WAIT_L(0); PG8_MMA(1, 0, At, B0); PG8_BAR; PG8_SCHED;
            PG8_STAGE(PG8_SB(1, 1), b3 + hstep, voffB);
            PG8_WAIT_V(6); PG8_BAR; PG8_MMA(1, 1, At, B1); PG8_BAR;
            }
        }
        if constexpr (ALIGN_EPI) { if (wr == 0) PG8_BAR; }
#pragma unroll
        for (int a = 0; a < 2; ++a)
#pragma unroll
            for (int b = 0; b < 2; ++b)
#pragma unroll
                for (int m = 0; m < 4; ++m)
#pragma unroll
                    for (int n = 0; n < 2; ++n) acc[a][b][m][n] = __builtin_convertvector(__builtin_bit_cast(v4i, acc[a][b][m][n]), f32x4);
        if constexpr (!Epi::AFTER_DRAIN) { E(acc, cur, wr, wc, fr, fq, (const PG8_LAS float*)(lds + SCB_OFF + (ui & 1) * 1024)); S.done(cur); }
        if (!has_next) break;
#pragma unroll
        for (int a = 0; a < 2; ++a)
#pragma unroll
            for (int b = 0; b < 2; ++b)
#pragma unroll
                for (int m = 0; m < 4; ++m)
#pragma unroll
                    for (int n = 0; n < 2; ++n) acc[a][b][m][n] = (f32x4){0.f, 0.f, 0.f, 0.f};
        cur = nxt; cA = nA; cB = nB; ++ui;
        if constexpr (ALIGN_EPI) { if (wr == 1) PG8_BAR; }
    }
    PG8_WAIT_V(0);
    if constexpr (!ALIGN_EPI) { if (wr == 0) PG8_BAR; }
    PG8_BAR;
    if constexpr (Epi::AFTER_DRAIN) { E.fused(acc, cur, wr, wc, fr, fq, lds, wid, lane); S.done(cur); }
#undef PG8_SA
#undef PG8_SB
#undef PG8_STAGE
#undef PG8_LDA
#undef PG8_LDB
#undef PG8_MMA
#undef PG8_WAIT_V
#undef PG8_WAIT_L
#undef PG8_BAR
#undef PG8_SCHED
}
template <class Epi, class Sched, bool ALIGN_EPI = false, bool SP2 = false>
__device__ __forceinline__ void gemm_phase_i8g(PG8_LAS unsigned char* lds, const Gemm g, const Sched& S, const Epi& E, const int* __restrict__ ridx, const float* __restrict__ rowscale) {
    const int tid = threadIdx.x, wid = __builtin_amdgcn_readfirstlane(tid >> 6), lane = tid & 63, wr = wid >> 2, wc = wid & 3, fr = lane & 15, fq = lane >> 4;
    const int K = g.K, nt = K / BK;
    unsigned voffB[2]; int arow[2]; unsigned acol[2];
#pragma unroll
    for (int i = 0; i < 2; ++i) { int R, C; stage_rc(tid * 16 + i * 8192, R, C); const int Rb = Epi::PERM ? ((R & ~31) + perm32(R & 31)) : R;
        arow[i] = R; acol[i] = (unsigned)C * 2u; voffB[i] = (unsigned)(Rb * K + C) * 2u; }
    constexpr int IDXB_OFF = STAGE_BYTES;
    unsigned offc[2][2], offn[2][2];
#define PG8_LDIDX(dst, pm_) do { _Pragma("unroll") for (int h_ = 0; h_ < 2; ++h_) _Pragma("unroll") for (int i_ = 0; i_ < 2; ++i_) \
        dst[h_][i_] = (unsigned)ridx[(pm_) * BM + h_ * HALF + arow[i_]] * (unsigned)(K * 2) + acol[i_]; } while (0)
#define PG8_STAGE_G(bufoff, gbase, off2) do { _Pragma("unroll") for (int _i = 0; _i < 2; ++_i) \
        __builtin_amdgcn_global_load_lds((const unsigned*)((const char*)(gbase) + (off2)[_i]), (PG8_LAS unsigned*)(lds + (bufoff) + ldsw + _i * 8192), 16, 0, 0); } while (0)
    const size_t kstep = (size_t)(BK * 2);
    const size_t hstep = (size_t)HALF * K * 2;
    const size_t tstep = 2 * hstep;
    const unsigned ldsw = (unsigned)wid * 1024u;
    const int aoff = lds_byte(wr * 64 + fr, fq * 8), boff = lds_byte(wc * 32 + fr, fq * 8);
#define PG8_SA(b, h) (((b) * 2 + (h)) * HTB)
#define PG8_SB(b, h) ((4 + (b) * 2 + (h)) * HTB)
#define PG8_STAGE(bufoff, gbase, voff) do { _Pragma("unroll") for (int _i = 0; _i < 2; ++_i) \
        __builtin_amdgcn_global_load_lds((const unsigned*)((const char*)(gbase) + (voff)[_i]), (PG8_LAS unsigned*)(lds + (bufoff) + ldsw + _i * 8192), 16, 0, 0); } while (0)
#define PG8_LDA(dst, b, h) do { _Pragma("unroll") for (int m = 0; m < 4; ++m) _Pragma("unroll") for (int k = 0; k < 2; ++k) dst[m][k] = *(const PG8_LAS bf16x8*)(lds + PG8_SA(b, h) + aoff + m * 2048 + k * 1024); } while (0)
#define PG8_LDB(dst, b, h) do { _Pragma("unroll") for (int n = 0; n < 2; ++n) _Pragma("unroll") for (int k = 0; k < 2; ++k) dst[n][k] = *(const PG8_LAS bf16x8*)(lds + PG8_SB(b, h) + boff + n * 2048 + k * 1024); } while (0)
#define PG8_MMA(ai, bj, At, Bt) do { __builtin_amdgcn_s_setprio(1); _Pragma("unroll") for (int m = 0; m < 4; ++m) _Pragma("unroll") for (int n = 0; n < 2; ++n) _Pragma("unroll") for (int k = 0; k < 2; ++k) \
        acc[ai][bj][m][n] = __builtin_bit_cast(f32x4, __builtin_amdgcn_mfma_i32_16x16x64_i8(__builtin_bit_cast(v4i, Bt[n][k]), __builtin_bit_cast(v4i, At[m][k]), __builtin_bit_cast(v4i, acc[ai][bj][m][n]), 0, 0, 0)); __builtin_amdgcn_s_setprio(0); } while (0)
#define PG8_WAIT_V(n) asm volatile("s_waitcnt vmcnt(" #n ")" ::: "memory")
#define PG8_WAIT_L(n) asm volatile("s_waitcnt lgkmcnt(" #n ")" ::: "memory")
#define PG8_BAR __builtin_amdgcn_s_barrier()
#define PG8_SCHED __builtin_amdgcn_sched_barrier(0)
    Unit cur, nxt; int ui = 0;
    if (!S.next(0, cur)) return;
    f32x4 acc[2][2][4][2];
#pragma unroll
    for (int a = 0; a < 2; ++a)
#pragma unroll
        for (int b = 0; b < 2; ++b)
#pragma unroll
            for (int m = 0; m < 4; ++m)
#pragma unroll
                for (int n = 0; n < 2; ++n) acc[a][b][m][n] = (f32x4){0.f, 0.f, 0.f, 0.f};
    bf16x8 At[4][2], B0[2][2], B1[2][2];
    const char* gA0 = (const char*)g.A; const char* cB = (const char*)g.Bt + (size_t)cur.pb * tstep; PG8_LDIDX(offc, cur.pm);
    constexpr int SCB_OFF = STAGE_BYTES + 2048;
    if (wid == 0) __builtin_amdgcn_global_load_lds((const unsigned*)(rowscale + cur.pm * BM + lane * 4), (PG8_LAS unsigned*)(lds + SCB_OFF), 16, 0, 0);
    S.a_ready(cur);
    if constexpr (SP2) {
        PG8_STAGE(PG8_SB(0, 0), cB, voffB); PG8_STAGE(PG8_SB(0, 1), cB + hstep, voffB); PG8_STAGE_G(PG8_SA(0, 0), gA0, offc[0]); PG8_STAGE_G(PG8_SA(0, 1), gA0, offc[1]);
        if (wr == 1) PG8_BAR;
        PG8_WAIT_V(2); PG8_BAR;
        PG8_STAGE(PG8_SB(1, 0), cB + kstep, voffB); PG8_STAGE_G(PG8_SA(1, 0), gA0 + kstep, offc[0]); PG8_STAGE(PG8_SB(1, 1), cB + hstep + kstep, voffB);
        PG8_WAIT_V(6); PG8_BAR;
    } else {
        PG8_STAGE(PG8_SB(0, 0), cB, voffB); PG8_STAGE_G(PG8_SA(0, 0), gA0, offc[0]); PG8_STAGE(PG8_SB(0, 1), cB + hstep, voffB); PG8_STAGE_G(PG8_SA(0, 1), gA0, offc[1]);
        if (wr == 1) PG8_BAR;
        PG8_WAIT_V(4); PG8_BAR;
        PG8_STAGE(PG8_SB(1, 0), cB + kstep, voffB); PG8_STAGE_G(PG8_SA(1, 0), gA0 + kstep, offc[0]); PG8_STAGE(PG8_SB(1, 1), cB + hstep + kstep, voffB);
        PG8_WAIT_V(6); PG8_BAR;
    }
    for (;;) {
        const bool has_next = S.next(ui + 1, nxt);
        const char* nB = has_next ? (const char*)g.Bt + (size_t)nxt.pb * tstep : cB;
        if (!has_next) {
#pragma unroll
            for (int h_ = 0; h_ < 2; ++h_) { offn[h_][0] = offc[h_][0]; offn[h_][1] = offc[h_][1]; } }
#pragma unroll 1
        for (int t = 0; t < nt; t += 2) {
            const bool last = (t == nt - 2);
            if (has_next && t == nt - 4 && wid == 0)
                __builtin_amdgcn_global_load_lds((const unsigned*)(ridx + nxt.pm * BM + lane * 4), (PG8_LAS unsigned*)(lds + IDXB_OFF + ((ui + 1) & 1) * 1024), 16, 0, 0);
            if (has_next && t == nt - 4 && wid == 0)
                __builtin_amdgcn_global_load_lds((const unsigned*)(rowscale + nxt.pm * BM + lane * 4), (PG8_LAS unsigned*)(lds + SCB_OFF + ((ui + 1) & 1) * 1024), 16, 0, 0);
            if (has_next && last) {
                const PG8_LAS int* ib = (const PG8_LAS int*)(lds + IDXB_OFF + ((ui + 1) & 1) * 1024);
#pragma unroll
                for (int h_ = 0; h_ < 2; ++h_)
#pragma unroll
                    for (int i_ = 0; i_ < 2; ++i_) offn[h_][i_] = (unsigned)ib[h_ * HALF + arow[i_]] * (unsigned)(K * 2) + acol[i_]; }
            const char* a1 = gA0 + (size_t)(t + 1) * kstep;
            const char* a2 = last ? gA0 : gA0 + (size_t)(t + 2) * kstep; const char* b2 = last ? nB : cB + (size_t)(t + 2) * kstep;
            const char* a3 = a2 + kstep; const char* b3 = b2 + kstep;
            unsigned o2[2][2];
#pragma unroll
            for (int h_ = 0; h_ < 2; ++h_) { o2[h_][0] = last ? offn[h_][0] : offc[h_][0]; o2[h_][1] = last ? offn[h_][1] : offc[h_][1]; }
            if (last && has_next) S.a_ready(nxt);
            if constexpr (SP2) {
            PG8_LDB(B0, 0, 0); PG8_LDB(B1, 0, 1); PG8_SCHED; PG8_LDA(At, 0, 0); PG8_STAGE_G(PG8_SA(1, 1), a1, offc[1]);
            PG8_WAIT_V(8); PG8_WAIT_L(0); PG8_BAR; PG8_MMA(0, 0, At, B0); PG8_MMA(0, 1, At, B1); PG8_BAR; PG8_SCHED;
            PG8_LDA(At, 0, 1); PG8_STAGE(PG8_SB(0, 0), b2, voffB); PG8_STAGE(PG8_SB(0, 1), b2 + hstep, voffB); PG8_STAGE_G(PG8_SA(0, 0), a2, o2[0]);
            PG8_WAIT_V(8); PG8_WAIT_L(0); PG8_BAR; PG8_MMA(1, 0, At, B0); PG8_MMA(1, 1, At, B1); PG8_BAR; PG8_SCHED;
            PG8_LDB(B0, 1, 0); PG8_LDB(B1, 1, 1); PG8_SCHED; PG8_LDA(At, 1, 0); PG8_STAGE_G(PG8_SA(0, 1), a2, o2[1]);
            PG8_WAIT_V(8); PG8_WAIT_L(0); PG8_BAR; PG8_MMA(0, 0, At, B0); PG8_MMA(0, 1, At, B1); PG8_BAR; PG8_SCHED;
            PG8_LDA(At, 1, 1); PG8_STAGE(PG8_SB(1, 0), b3, voffB); PG8_STAGE(PG8_SB(1, 1), b3 + hstep, voffB); PG8_STAGE_G(PG8_SA(1, 0), a3, o2[0]);
            PG8_WAIT_V(8); PG8_WAIT_L(0); PG8_BAR; PG8_MMA(1, 0, At, B0); PG8_MMA(1, 1, At, B1); PG8_BAR; PG8_SCHED;
            } else {
            PG8_LDB(B0, 0, 0); PG8_SCHED; PG8_LDA(At, 0, 0); PG8_STAGE_G(PG8_SA(1, 1), a1, offc[1]);
            PG8_WAIT_L(8); PG8_BAR; PG8_WAIT_L(0); PG8_MMA(0, 0, At, B0); PG8_BAR; PG8_SCHED;
            PG8_LDB(B1, 0, 1); PG8_STAGE(PG8_SB(0, 0), b2, voffB);
            PG8_BAR; PG8_WAIT_L(0); PG8_MMA(0, 1, At, B1); PG8_BAR;
            PG8_LDA(At, 0, 1); PG8_STAGE_G(PG8_SA(0, 0), a2, o2[0]);
            PG8_BAR; PG8_WAIT_L(0); PG8_MMA(1, 0, At, B0); PG8_BAR; PG8_SCHED;
            PG8_STAGE(PG8_SB(0, 1), b2 + hstep, voffB);
            PG8_WAIT_V(6); PG8_BAR; PG8_MMA(1, 1, At, B1); PG8_BAR;
            PG8_LDB(B0, 1, 0); PG8_SCHED; PG8_LDA(At, 1, 0); PG8_STAGE_G(PG8_SA(0, 1), a2, o2[1]);
            PG8_WAIT_L(8); PG8_BAR; PG8_WAIT_L(0); PG8_MMA(0, 0, At, B0); PG8_BAR; PG8_SCHED;
            PG8_LDB(B1, 1, 1); PG8_STAGE(PG8_SB(1, 0), b3, voffB);
            PG8_BAR; PG8_WAIT_L(0); PG8_MMA(0, 1, At, B1); PG8_BAR;
            PG8_LDA(At, 1, 1); PG8_STAGE_G(PG8_SA(1, 0), a3, o2[0]);
            PG8_BAR; PG8_WAIT_L(0); PG8_MMA(1, 0, At, B0); PG8_BAR; PG8_SCHED;
            PG8_STAGE(PG8_SB(1, 1), b3 + hstep, voffB);
            PG8_WAIT_V(6); PG8_BAR; PG8_MMA(1, 1, At, B1); PG8_BAR;
            }
        }
        if constexpr (ALIGN_EPI) { if (wr == 0) PG8_BAR; }
#pragma unroll
        for (int a = 0; a < 2; ++a)
#pragma unroll
            for (int b = 0; b < 2; ++b)
#pragma unroll
                for (int m = 0; m < 4; ++m)
#pragma unroll
                    for (int n = 0; n < 2; ++n) acc[a][b][m][n] = __builtin_convertvector(__builtin_bit_cast(v4i, acc[a][b][m][n]), f32x4);
        if constexpr (!Epi::AFTER_DRAIN) { E(acc, cur, wr, wc, fr, fq, (const PG8_LAS float*)(lds + SCB_OFF + (ui & 1) * 1024)); S.done(cur); }
        if (!has_next) break;
#pragma unroll
        for (int a = 0; a < 2; ++a)
#pragma unroll
            for (int b = 0; b < 2; ++b)
#pragma unroll
                for (int m = 0; m < 4; ++m)
#pragma unroll
                    for (int n = 0; n < 2; ++n) acc[a][b][m][n] = (f32x4){0.f, 0.f, 0.f, 0.f};
        cur = nxt; cB = nB; ++ui;
#pragma unroll
        for (int h_ = 0; h_ < 2; ++h_) { offc[h_][0] = offn[h_][0]; offc[h_][1] = offn[h_][1]; }
        if constexpr (ALIGN_EPI) { if (wr == 1) PG8_BAR; }
    }
    PG8_WAIT_V(0);
    if constexpr (!ALIGN_EPI) { if (wr == 0) PG8_BAR; }
    PG8_BAR;
    if constexpr (Epi::AFTER_DRAIN) { E.fused(acc, cur, wr, wc, fr, fq, lds, wid, lane); S.done(cur); }
#undef PG8_SA
#undef PG8_SB
#undef PG8_STAGE
#undef PG8_STAGE_G
#undef PG8_LDIDX
#undef PG8_LDA
#undef PG8_LDB
#undef PG8_MMA
#undef PG8_WAIT_V
#undef PG8_WAIT_L
#undef PG8_BAR
#undef PG8_SCHED
}

struct EpiPlain {
    static constexpr bool PERM = true, AFTER_DRAIN = false;
    bf16_t* O; int ldc; float scale;
    __device__ __forceinline__ void operator()(const f32x4 (&acc)[2][2][4][2], const Unit& u, int wr, int wc, int fr, int fq, const PG8_LAS float* rowscale = nullptr) const {
        const int row0 = u.pm * BM + wr * 64 + fr, col0 = u.pn * BM + wc * 32 + 8 * fq;
#pragma unroll
        for (int ai = 0; ai < 2; ++ai)
#pragma unroll
            for (int m = 0; m < 4; ++m) { bf16_t* rowp = O + (size_t)(row0 + ai * HALF + m * 16) * ldc + col0;
                const float sc = rowscale ? rowscale[wr * 64 + fr + ai * HALF + m * 16] * scale : scale;
#pragma unroll
                for (int bj = 0; bj < 2; ++bj) *(u32x4*)(rowp + bj * HALF) = pack8(acc[ai][bj][m][0] * sc, acc[ai][bj][m][1] * sc); }
    }
};
struct EpiPlain8 {
    static constexpr bool PERM = true, AFTER_DRAIN = false;
    unsigned char* O; int ldc; float scale;
    __device__ __forceinline__ void operator()(const f32x4 (&acc)[2][2][4][2], const Unit& u, int wr, int wc, int fr, int fq, const PG8_LAS float* = nullptr) const {
        const int row0 = u.pm * BM + wr * 64 + fr, col0 = u.pn * BM + wc * 32 + 8 * fq;
#pragma unroll
        for (int ai = 0; ai < 2; ++ai)
#pragma unroll
            for (int m = 0; m < 4; ++m) { unsigned char* rowp = O + (size_t)(row0 + ai * HALF + m * 16) * ldc + col0;
#pragma unroll
                for (int bj = 0; bj < 2; ++bj) { f32x4 v0 = acc[ai][bj][m][0] * scale, v1 = acc[ai][bj][m][1] * scale;
#pragma unroll
                    for (int j = 0; j < 4; ++j) { v0[j] = __builtin_amdgcn_fmed3f(v0[j], -416.f, 416.f); v1[j] = __builtin_amdgcn_fmed3f(v1[j], -416.f, 416.f); }
                    unsigned w0, w1; { int t = 0; t = __builtin_amdgcn_cvt_pk_fp8_f32(v0[0], v0[1], t, false); t = __builtin_amdgcn_cvt_pk_fp8_f32(v0[2], v0[3], t, true); w0 = (unsigned)t; }
                    { int t = 0; t = __builtin_amdgcn_cvt_pk_fp8_f32(v1[0], v1[1], t, false); t = __builtin_amdgcn_cvt_pk_fp8_f32(v1[2], v1[3], t, true); w1 = (unsigned)t; }
                    unsigned __attribute__((ext_vector_type(2))) w = {w0, w1};
                    *(unsigned __attribute__((ext_vector_type(2)))*)(rowp + bj * HALF) = w; } }
    }
};
struct EpiConvIn {
    static constexpr bool PERM = true, AFTER_DRAIN = false;
    bf16_t* U; bf16_t* Bg; float sb;
    __device__ __forceinline__ void operator()(const f32x4 (&acc)[2][2][4][2], const Unit& u, int wr, int wc, int fr, int fq, const PG8_LAS float* rowscale = nullptr) const {
        const int row0 = u.pm * BM + wr * 64 + fr;
        if (u.pn < 8) {
            const int col0 = u.pn * HALF + wc * 32 + 8 * fq;
#pragma unroll
            for (int ai = 0; ai < 2; ++ai)
#pragma unroll
                for (int m = 0; m < 4; ++m) { const int row = row0 + ai * HALF + m * 16; bf16_t* rowp = U + (size_t)row * 1024 + col0;
                    const float s = rowscale ? rowscale[row - u.pm * BM] * sb : sb, su = s * s;
                    *(u32x4*)rowp = pack8((acc[ai][0][m][0] * su) * acc[ai][1][m][0], (acc[ai][0][m][1] * su) * acc[ai][1][m][1]); }
        } else {
            const int col0 = (u.pn - 8) * BM + wc * 32 + 8 * fq;
#pragma unroll
            for (int ai = 0; ai < 2; ++ai)
#pragma unroll
                for (int m = 0; m < 4; ++m) { const int row = row0 + ai * HALF + m * 16; bf16_t* rowp = Bg + (size_t)row * 1024 + col0;
                    const float s = rowscale ? rowscale[row - u.pm * BM] * sb : sb;
#pragma unroll
                    for (int bj = 0; bj < 2; ++bj) *(u32x4*)(rowp + bj * HALF) = pack8(acc[ai][bj][m][0] * s, acc[ai][bj][m][1] * s); }
        }
    }
};
__device__ __forceinline__ float silu_mul(float g, float u) { return g * __builtin_amdgcn_rcpf(1.0f + __builtin_amdgcn_exp2f(-1.4426950408889634f * g)) * u; }
struct EpiSwiGLU {
    static constexpr bool PERM = true, AFTER_DRAIN = false;
    bf16_t* O; int ldc;
    __device__ __forceinline__ void operator()(const f32x4 (&acc)[2][2][4][2], const Unit& u, int wr, int wc, int fr, int fq, const PG8_LAS float* rowscale = nullptr) const {
        const int row0 = u.pm * BM + wr * 64 + fr, col0 = u.pn * HALF + wc * 32 + 8 * fq;
#pragma unroll
        for (int ai = 0; ai < 2; ++ai)
#pragma unroll
            for (int m = 0; m < 4; ++m) { bf16_t* rowp = O + (size_t)(row0 + ai * HALF + m * 16) * ldc + col0;
                f32x4 h0, h1;
#pragma unroll
                for (int j = 0; j < 4; ++j) { h0[j] = silu_mul(acc[ai][0][m][0][j], acc[ai][1][m][0][j]); h1[j] = silu_mul(acc[ai][0][m][1][j], acc[ai][1][m][1][j]); }
                *(u32x4*)rowp = pack8(h0, h1); }
    }
};
typedef unsigned u32x2 __attribute__((ext_vector_type(2)));
__device__ __forceinline__ unsigned pk4_i8(float a, float b, float c, float d) {
    const float M = 12582912.0f;
    const unsigned ua = __float_as_uint(__builtin_amdgcn_fmed3f(a, -127.f, 127.f) + M) & 0xffu, ub = __float_as_uint(__builtin_amdgcn_fmed3f(b, -127.f, 127.f) + M) & 0xffu;
    const unsigned uc = __float_as_uint(__builtin_amdgcn_fmed3f(c, -127.f, 127.f) + M) & 0xffu, ud = __float_as_uint(__builtin_amdgcn_fmed3f(d, -127.f, 127.f) + M) & 0xffu;
    return ua | (ub << 8) | (uc << 16) | (ud << 24);
}
__device__ __forceinline__ unsigned pk4_fp8(float a, float b, float c, float d) { int w = 0; w = __builtin_amdgcn_cvt_pk_fp8_f32(a, b, w, false); w = __builtin_amdgcn_cvt_pk_fp8_f32(c, d, w, true); return (unsigned)w; }
__device__ __forceinline__ f32x4 sigmoid_poly(f32x4 g) {
#pragma unroll
    for (int j = 0; j < 4; ++j) g[j] = __builtin_amdgcn_fmed3f(g[j], -6.0f, 6.0f);
    const f32x4 g2 = g * g;
    f32x4 p = g2 * -7.679571572410948e-09f + 9.237889806797302e-07f;
    p = p * g2 + -4.464401370582264e-05f; p = p * g2 + 0.0011428644842571107f; p = p * g2 + -0.018061106095597954f; p = p * g2 + 0.2474573026545305f;
    return g * p + 0.5f;
}
struct EpiSwiGLU8 {
    static constexpr bool PERM = true, AFTER_DRAIN = false;
    unsigned char* O; int ldc; float inscale0, outscale;
    __device__ __forceinline__ void operator()(const f32x4 (&acc)[2][2][4][2], const Unit& u, int wr, int wc, int fr, int fq, const PG8_LAS float* rowscale = nullptr) const {
        const int row0 = u.pm * BM + wr * 64 + fr, col0 = u.pn * HALF + wc * 32 + 8 * fq;
        const float s_ = inscale0, s2_ = s_ * s_, c2_ = s2_ * outscale, hk = 0.5f * c2_, lim = 6.0f / s_;
        const float k0 = 0.2474573026545305f * (c2_ * s_), k1 = -0.018061106095597954f * (c2_ * s_ * s2_), k2 = 0.0011428644842571107f * (c2_ * s_ * s2_ * s2_), k3 = -4.464401370582264e-05f * (c2_ * s_ * s2_ * s2_ * s2_),
                    k4 = 9.237889806797302e-07f * (c2_ * s_ * s2_ * s2_ * s2_ * s2_), k5 = -7.679571572410948e-09f * (c2_ * s_ * s2_ * s2_ * s2_ * s2_ * s2_);
#pragma unroll
        for (int ai = 0; ai < 2; ++ai)
#pragma unroll
            for (int m = 0; m < 4; ++m) { const int row = row0 + ai * HALF + m * 16; unsigned char* rowp = O + (size_t)row * ldc + col0;
                const float inscale = rowscale ? rowscale[row - u.pm * BM] * inscale0 : inscale0;
                const float c2 = inscale * inscale * outscale;
                f32x4 h[2];
#pragma unroll
                for (int n = 0; n < 2; ++n) { const f32x4 ag = acc[ai][0][m][n], au = acc[ai][1][m][n];
                    f32x4 p;
                    if (rowscale == nullptr) {
                        f32x4 agc;
#pragma unroll
                        for (int j = 0; j < 4; ++j) agc[j] = __builtin_amdgcn_fmed3f(ag[j], -lim, lim);
                        const f32x4 t = agc * agc; f32x4 q = t * k5 + k4; q = q * t + k3; q = q * t + k2; q = q * t + k1; q = q * t + k0;
                        p = (ag * au) * (agc * q + hk);
                    } else
                    p = ((ag * c2) * au) * sigmoid_poly(ag * inscale);
#pragma unroll
                    for (int j = 0; j < 4; ++j) p[j] = __builtin_amdgcn_fmed3f(p[j], -416.f, 416.f);
                    h[n] = p; }
                u32x2 w; w.x = pk4_fp8(h[0][0], h[0][1], h[0][2], h[0][3]); w.y = pk4_fp8(h[1][0], h[1][1], h[1][2], h[1][3]);
                *(u32x2*)rowp = w; }
    }
};
constexpr float QK8_QS = 4.0f, QK8_KS = 0.25f;
constexpr float VT_SCALE = 8.0f;
struct EpiQKV {
    static constexpr bool PERM = true, AFTER_DRAIN = false;
    bf16_t *Q, *K, *V; const float* rope; float qscale, oscale;
    __device__ __forceinline__ void operator()(const f32x4 (&acc)[2][2][4][2], const Unit& u, int wr, int wc, int fr, int fq, const PG8_LAS float* rowscale = nullptr) const {
        const int t = u.pn >> 2, colt = (u.pn & 3) * BM; const bool lat = u.pm < 128;
        bf16_t* base; int orow;
        if (t == 0) { base = Q; orow = u.pm * BM; }
        else { base = (t == 1) ? K : V; orow = lat ? ((u.pm >> 3) * 2304 + 256 + (u.pm & 7) * BM) : ((u.pm - 128) * 2304); }
        const int rloc = wr * 64 + fr, col0 = colt + wc * 32 + 8 * fq;
        unsigned char* kp = (unsigned char*)K + (unsigned)((((lat ? (u.pm >> 3) : (u.pm - 128)) * 16 + (colt >> 7) * 2 + (wc >> 1)) * 2304 + (lat ? 256 + (u.pm & 7) * BM : 0) + rloc) * 64 + (wc & 1) * 32 + 8 * fq);
        const bool dorope = lat && (t < 2);
        const int axis = wc & 1; const float sgn = (fq < 2) ? -1.f : 1.f; const float qs0 = ((t == 0) ? qscale * QK8_QS : QK8_KS) * oscale;
        if (t == 2) {
            unsigned char* vt = (unsigned char*)V; const int kb = lat ? 256 + (u.pm & 7) * BM : 0, bb = lat ? (u.pm >> 3) : (u.pm - 128);
            const int qi = fr & 3; const unsigned sel1 = (qi & 1) ? 0x03070105u : 0x06020400u, sel2 = (qi & 2) ? 0x03020706u : 0x05040100u;
#pragma unroll
            for (int ai = 0; ai < 2; ++ai)
#pragma unroll
                for (int m = 0; m < 4; ++m) { const int rl = rloc + ai * HALF + m * 16, kpos = kb + rl; const float qs = (rowscale ? rowscale[rl] * qs0 : qs0) * (VT_SCALE / QK8_KS);
#pragma unroll
                    for (int bj = 0; bj < 2; ++bj) { const int ch = col0 + bj * HALF; const f32x4 v0 = acc[ai][bj][m][0] * qs, v1 = acc[ai][bj][m][1] * qs;
                        const int kg = ((kpos & 63) - qi) >> 2;
                        unsigned char* p = vt + ((size_t)(((bb * 8 + (ch >> 7)) * 36 + (kpos >> 6)) * 128 + (ch & 127) + qi)) * 64 + (32 * (kg & 1) + 16 * (kg >> 3) + 4 * ((kg >> 1) & 3));
                        unsigned w[2] = {pk4_fp8(v0[0], v0[1], v0[2], v0[3]), pk4_fp8(v1[0], v1[1], v1[2], v1[3])};
#pragma unroll
                        for (int k = 0; k < 2; ++k) { const unsigned x = (unsigned)__builtin_amdgcn_mov_dpp((int)w[k], 0xB1, 0xF, 0xF, true), t1 = __builtin_amdgcn_perm(x, w[k], sel1);
                            const unsigned y = (unsigned)__builtin_amdgcn_mov_dpp((int)t1, 0x4E, 0xF, 0xF, true); w[k] = __builtin_amdgcn_perm(y, t1, sel2); }
                        *(unsigned*)p = w[0]; *(unsigned*)(p + 256) = w[1]; } }
            return; }
#pragma unroll
        for (int ai = 0; ai < 2; ++ai)
#pragma unroll
            for (int m = 0; m < 4; ++m) { const int rl = rloc + ai * HALF + m * 16; unsigned char* rowp = (unsigned char*)base + (size_t)(orow + rl) * 1024 + col0;
                const float qs = rowscale ? rowscale[rl] * qs0 : qs0;
                f32x4 c0 = {1.f, 1.f, 1.f, 1.f}, c1 = c0, s0 = {0.f, 0.f, 0.f, 0.f}, s1 = s0;
                if (dorope) { const int tok = (u.pm & 7) * BM + rl, pos = axis ? (tok & 63) : (tok >> 6); const float* tp = rope + pos * 32 + 8 * (fq & 1);
                    c0 = *(const f32x4*)tp; c1 = *(const f32x4*)(tp + 4); s0 = *(const f32x4*)(tp + 16); s1 = *(const f32x4*)(tp + 20); }
#pragma unroll
                for (int bj = 0; bj < 2; ++bj) { f32x4 v0 = acc[ai][bj][m][0], v1 = acc[ai][bj][m][1];
                    if (dorope) { f32x4 p0, p1;
#pragma unroll
                        for (int j = 0; j < 4; ++j) { p0[j] = __shfl_xor(v0[j], 32); p1[j] = __shfl_xor(v1[j], 32); }
                        v0 = v0 * c0 + (p0 * s0) * sgn; v1 = v1 * c1 + (p1 * s1) * sgn; }
                    v0 = v0 * qs; v1 = v1 * qs;
                    u32x2 w; w.x = pk4_fp8(v0[0], v0[1], v0[2], v0[3]); w.y = pk4_fp8(v1[0], v1[1], v1[2], v1[3]);
                    if (t == 1) *(u32x2*)(kp + (ai * HALF + m * 16) * 64 + bj * (2 * 2304 * 64)) = w;
                    else *(u32x2*)(rowp + bj * HALF) = w; } }
    }
};

struct EpiNull {
    static constexpr bool PERM = true, AFTER_DRAIN = false;
    __device__ __forceinline__ void operator()(const f32x4 (&acc)[2][2][4][2], const Unit& u, int wr, int wc, int fr, int fq, const PG8_LAS float* rowscale = nullptr) const {}
};
struct SchedGrid {
    int nM, nN, G, c;
    __device__ __forceinline__ bool next(int i, Unit& u) const { const long L = (long)i * G + c; if (L >= (long)nM * nN) return false; tile_decode((int)L, nM, nN, u.pm, u.pn); u.pb = u.pn; return true; }
    __device__ __forceinline__ void a_ready(const Unit&) const {}
    __device__ __forceinline__ void done(const Unit&) const {}
};
struct SchedMoE {
    int nM, nN, G, c;
    __device__ __forceinline__ bool next(int i, Unit& u) const { const long L = (long)i * G + c; if (L >= (long)nM * nN) return false; tile_decode((int)L, nM, nN, u.pm, u.pn);
        u.pb = ((u.pm < 256) ? (u.pm >> 4) : ((u.pm - 256) >> 1)) * nN + u.pn; return true; }
    __device__ __forceinline__ void a_ready(const Unit&) const {}
    __device__ __forceinline__ void done(const Unit&) const {}
};
struct SchedQKV {
    int G, c;
    __device__ __forceinline__ bool next(int i, Unit& u) const { const long L = (long)i * G + c;
        if (L < 1536) { tile_decode((int)L, 128, 12, u.pm, u.pn); u.pb = u.pn; return true; }
        if (L < 1664) { tile_decode((int)L - 1536, 16, 8, u.pm, u.pn); u.pm += 128; u.pn += 4; u.pb = u.pn; return true; }
        return false; }
    __device__ __forceinline__ void a_ready(const Unit&) const {}
    __device__ __forceinline__ void done(const Unit&) const {}
};
struct SchedSame {
    int nM, nN, G, c;
    __device__ __forceinline__ bool next(int i, Unit& u) const { const long L = (long)i * G + c; if (L >= (long)nM * nN) return false; u.pm = c & 7; u.pn = 0; u.pb = c & 3; return true; }
    __device__ __forceinline__ void a_ready(const Unit&) const {}
    __device__ __forceinline__ void done(const Unit&) const {}
};
}

namespace att {
using bf16 = unsigned short;
using bf16x8 = __attribute__((ext_vector_type(8))) short;
using s16x4  = __attribute__((ext_vector_type(4))) short;
using f32x16 = __attribute__((ext_vector_type(16))) float;
using u32x4  = __attribute__((ext_vector_type(4))) unsigned;
using v8i    = __attribute__((ext_vector_type(8))) int;
using v4i    = __attribute__((ext_vector_type(4))) int;
constexpr int NW = 8, QBLK = 32, KVBLK = 64, LDQ = 1024, LDK = 1024, LDO = 2048, NKEYS = 2304;
constexpr float THR2 = 3.0f, PBIAS = 5.0f;
constexpr float VT_UNSCALE = 1.0f / 8.0f;
constexpr size_t SHM_V = KVBLK * 128  , SHM_K = KVBLK * 64  , SHM_ATTN = 2 * SHM_V + 2 * SHM_K + NW * 64 * 4;
#define KSWZ64(row, colB) ((row) * 128 + ((colB) ^ ((((row) >> 1) & 7) << 4)))
#define SBAR() __builtin_amdgcn_sched_barrier(0)
__device__ __forceinline__ int crow(int r, int hi) { return (r & 3) + 8 * (r >> 2) + 4 * hi; }
__device__ __forceinline__ unsigned cvtpk(float lo, float hi) { unsigned r; asm volatile("v_cvt_pk_bf16_f32 %0, %1, %2" : "=v"(r) : "v"(lo), "v"(hi)); return r; }
__device__ __forceinline__ bf16x8 ld8(const bf16* p) { return *reinterpret_cast<const bf16x8*>(p); }

__device__ __forceinline__ int cvt4_fp8(float a, float b, float c, float d) { int w; asm volatile("" : "=v"(w));
  w = __builtin_amdgcn_cvt_pk_fp8_f32(a, b, w, false); w = __builtin_amdgcn_cvt_pk_fp8_f32(c, d, w, true); return w; }
template <int PM, bool FIRST>
__device__ __forceinline__ void partialSM(f32x16& p0, f32x16& p1, f32x16& minit, float& alpha, int (&pk)[6], float (&rest)[8]) {
  float pmax = p0[0];
#pragma unroll
  for (int r = 1; r < 16; ++r) pmax = fmaxf(pmax, p0[r]);
#pragma unroll
  for (int r = 0; r < 16; ++r) pmax = fmaxf(pmax, p1[r]);
  { auto rr = __builtin_amdgcn_permlane32_swap(__float_as_uint(pmax), __float_as_uint(pmax), false, false);
    pmax = fmaxf(__uint_as_float(rr[0]), __uint_as_float(rr[1])); }
  if (!FIRST && (PM >= 4 || __builtin_expect(__all(pmax <= THR2 + PBIAS), 1))) { alpha = 1.f; }
  else { const float d = FIRST ? pmax - PBIAS : fmaxf(pmax - PBIAS, 0.f); alpha = FIRST ? 0.f : __builtin_amdgcn_exp2f(-d);
#pragma unroll
    for (int r = 0; r < 16; ++r) { p0[r] -= d; p1[r] -= d; minit[r] -= d; } }
#pragma unroll
  for (int r = 0; r < 16; ++r) p0[r] = (PM == 1) ? p0[r] * 0.5f : __builtin_amdgcn_exp2f(p0[r]);
#pragma unroll
  for (int r = 0; r < 8; ++r) p1[r] = (PM == 1) ? p1[r] * 0.5f : __builtin_amdgcn_exp2f(p1[r]);
#pragma unroll
  for (int g = 0; g < 4; ++g) pk[g] = cvt4_fp8(p0[4 * g], p0[4 * g + 1], p0[4 * g + 2], p0[4 * g + 3]);
  pk[4] = cvt4_fp8(p1[0], p1[1], p1[2], p1[3]); pk[5] = cvt4_fp8(p1[4], p1[5], p1[6], p1[7]);
#pragma unroll
  for (int r = 0; r < 8; ++r) rest[r] = p1[8 + r];
}
__device__ __forceinline__ float sm_max16(const f32x16& p, float m) {
#pragma unroll
  for (int r = 0; r < 16; r += 2) m = fmaxf(fmaxf(m, p[r]), p[r + 1]);
  return m; }
__device__ __forceinline__ float sm_maxfin(float pmax) {
  auto rr = __builtin_amdgcn_permlane32_swap(__float_as_uint(pmax), __float_as_uint(pmax), false, false);
  return fmaxf(__uint_as_float(rr[0]), __uint_as_float(rr[1])); }
template <int PM>
__device__ __forceinline__ void sm_rebase(f32x16& p0, f32x16& p1, f32x16& minit, float pmax, float& alpha) {
  if (PM >= 4 || __builtin_expect(__all(pmax <= THR2 + PBIAS), 1)) { alpha = 1.f; }
  else { const float d = fmaxf(pmax - PBIAS, 0.f); alpha = __builtin_amdgcn_exp2f(-d);
#pragma unroll
    for (int r = 0; r < 16; ++r) { p0[r] -= d; p1[r] -= d; minit[r] -= d; } } }
template <int PM, int LO>
__device__ __forceinline__ void sm_exp8(f32x16& p) {
#pragma unroll
  for (int r = LO; r < LO + 8; ++r) p[r] = (PM == 1) ? p[r] * 0.5f : __builtin_amdgcn_exp2f(p[r]); }
template <int PM>
__device__ __forceinline__ void finishSM(const int (&pk)[6], float (&rest)[8], v8i& pop) {
#pragma unroll
  for (int r = 0; r < 8; ++r) rest[r] = (PM == 1) ? rest[r] * 0.5f : __builtin_amdgcn_exp2f(rest[r]);
  const int b2 = cvt4_fp8(rest[0], rest[1], rest[2], rest[3]), b3 = cvt4_fp8(rest[4], rest[5], rest[6], rest[7]);
  pop = v8i{pk[0], pk[1], pk[2], pk[3], pk[4], pk[5], b2, b3};
}
template <int OFF> __device__ __forceinline__ v4i lds_rd128(int addr) { v4i r; asm volatile("ds_read_b128 %0, %1 offset:%2" : "=&v"(r) : "v"(addr), "i"(OFF) : "memory"); return r; }
template <int OFF> __device__ __forceinline__ v4i lds_rd128g(int addr, const v8i& guard) { v4i r; asm volatile("ds_read_b128 %0, %1 offset:%2" : "=&v"(r) : "v"(addr), "i"(OFF), "v"(guard) : "memory"); return r; }
__device__ __forceinline__ void k_load(v8i (&kf)[2], int ka_lo, int ka_hi, const v8i& guard) {
  const v4i a0 = lds_rd128g<0>(ka_lo, guard), a1 = lds_rd128g<0>(ka_hi, guard), b0 = lds_rd128g<2048>(ka_lo, guard), b1 = lds_rd128g<2048>(ka_hi, guard);
  kf[0] = __builtin_shufflevector(a0, a1, 0, 1, 2, 3, 4, 5, 6, 7); kf[1] = __builtin_shufflevector(b0, b1, 0, 1, 2, 3, 4, 5, 6, 7);
}
template <int PM>
__device__ __forceinline__ void qk_mm(f32x16& p0, f32x16& p1, const f32x16& minit, const v8i (&kf)[2], const v8i& qr) {
  if constexpr (PM == 3) { p0 = minit; p1 = minit; asm volatile("" : "+v"(p0), "+v"(p1) : "v"(qr), "v"(kf[0]), "v"(kf[1])); return; }
  p0 = __builtin_amdgcn_mfma_scale_f32_32x32x64_f8f6f4(kf[0], qr, minit, 0, 0, 0, 0, 0, 0);
  p1 = __builtin_amdgcn_mfma_scale_f32_32x32x64_f8f6f4(kf[1], qr, minit, 0, 0, 0, 0, 0, 0);
}
__device__ __forceinline__ int v_st(int k, int c) { const int kk = (k & ~0xC) | ((k & 4) << 1) | ((k & 8) >> 1); return ((kk >> 3) * 4 + (c >> 5)) * 512 + ((kk & 7) * 32 + (c & 31)) * 2; }
__device__ __forceinline__ int v_rd_base(int lane) { return ((lane & 3) << 3) | (((lane >> 2) & 3) << 6) | (((lane >> 4) & 1) << 5) | (((lane >> 5) & 1) << 8); }
constexpr int v_rd_off(int d0, int ks, int half) { return d0 * 512 + ks * 4096 + half * 2048; }
template <int OFF> __device__ __forceinline__ s16x4 tr_read(int vb) {
  s16x4 r; asm volatile("ds_read_b64_tr_b16 %0, %1 offset:%2" : "=&v"(r) : "v"(vb), "i"(OFF) : "memory"); return r;
}
__device__ __forceinline__ void v_load(v8i (&vf)[4], int va_lo, int va_hi) {
  { const v4i lo = lds_rd128<0>(va_lo), hh = lds_rd128<0>(va_hi); vf[0] = __builtin_shufflevector(lo, hh, 0, 1, 2, 3, 4, 5, 6, 7); }
  { const v4i lo = lds_rd128<2048>(va_lo), hh = lds_rd128<2048>(va_hi); vf[1] = __builtin_shufflevector(lo, hh, 0, 1, 2, 3, 4, 5, 6, 7); }
  { const v4i lo = lds_rd128<4096>(va_lo), hh = lds_rd128<4096>(va_hi); vf[2] = __builtin_shufflevector(lo, hh, 0, 1, 2, 3, 4, 5, 6, 7); }
  { const v4i lo = lds_rd128<6144>(va_lo), hh = lds_rd128<6144>(va_hi); vf[3] = __builtin_shufflevector(lo, hh, 0, 1, 2, 3, 4, 5, 6, 7); }
}
__device__ __forceinline__ void pv_one(f32x16& od, const v8i& vfd, const v8i& pop) { asm volatile("v_mfma_f32_32x32x64_f8f6f4 %0, %1, %2, %0" : "+v"(od) : "v"(pop), "v"(vfd)); }
using f32x4a = __attribute__((ext_vector_type(4))) float;
__device__ __forceinline__ void pv_sum(f32x4a& lacc, const v8i& sel, const v8i& pop) { asm volatile("v_mfma_f32_16x16x128_f8f6f4 %0, %1, %2, %0" : "+v"(lacc) : "v"(pop), "v"(sel)); }
#define ATT_LAS __attribute__((address_space(3)))
constexpr int SHM_V2 = 2 * (int)SHM_V, SHM_K2 = 2 * (int)SHM_K;
constexpr int RING_V = 0, RING_K = 3 * SHM_V2, RING_WS = RING_K + 3 * SHM_K2, RING_END = RING_WS + NW * 64 * 4;
template <int PM>
__device__ __forceinline__ void attn_pass(const unsigned char* __restrict__ Qb, const unsigned char* __restrict__ Kh, const unsigned char* __restrict__ Vh, const unsigned char* Kn, const unsigned char* Vn, bool pre, char* lds, ATT_LAS unsigned char* lds3, f32x16 (&o)[4], float (&rli)[16]) {
  const int tid = threadIdx.x, wid = __builtin_amdgcn_readfirstlane(tid >> 6), lane = tid & 63, r32 = lane & 31, hi = lane >> 5;
#define LDS_WAIT_V() asm volatile("s_waitcnt lgkmcnt(0)" : "+v"(vfr[0]), "+v"(vfr[1]), "+v"(vfr[2]), "+v"(vfr[3]) :: "memory")
  char* V_lds = lds + RING_V; char* K_lds = lds + RING_K; const int vbase = (int)(uintptr_t)V_lds, kbase = (int)(uintptr_t)K_lds;
  float* ws = (float*)(lds + RING_WS) + wid * 64; float* al_l = ws + 32;
  v8i qr; f32x16 minit = f32x16{}; f32x4a lacc = f32x4a{};
  v8i ones; { int c1 = ((lane & 15) == ((lane >> 4) & 1)) ? 0x38383838 : 0; asm volatile("" : "+v"(c1)); ones = v8i{c1, c1, c1, c1, c1, c1, c1, c1}; }
#pragma unroll
  for (int d = 0; d < 4; ++d) o[d] = f32x16{};
  const unsigned qoff = (unsigned)((wid * QBLK + r32) * LDQ + hi * 32);
  const unsigned kgo = (unsigned)(wid * 1024 + (lane >> 2) * 64 + (((lane & 3) ^ ((lane >> 4) & 3)) << 4));
  const int voffl = r32 * 64 + (((2 * hi) ^ ((r32 >> 2) & 3)) << 4), voffh = r32 * 64 + (((2 * hi + 1) ^ ((r32 >> 2) & 3)) << 4);
  constexpr int NT = NKEYS / KVBLK;
  constexpr int NS = NT / 2;
#define DMA_KS(s_, slotoff) do { if constexpr (PM == 6) break; const bool nx_ = (s_) >= NS && Kn != nullptr; const int ss_ = (s_) < NS ? (s_) : (nx_ ? (s_) - NS : NS - 1); const char* kp_ = (const char*)(nx_ ? Kn : Kh); \
    __builtin_amdgcn_global_load_lds((const unsigned*)(kp_ + (size_t)ss_ * 8192 + kgo), (ATT_LAS unsigned*)(lds3 + RING_K + (slotoff) + wid * 1024), 16, 0, 0); } while (0)
#define DMA_VS(s_, slotoff) do { if constexpr (PM == 6) break; const bool nx_ = (s_) >= NS && Vn != nullptr; const int ss_ = (s_) < NS ? (s_) : (nx_ ? (s_) - NS : NS - 1); const char* vp_ = (const char*)(nx_ ? Vn : Vh); \
    __builtin_amdgcn_global_load_lds((const unsigned*)(vp_ + (size_t)ss_ * 16384 + kgo), (ATT_LAS unsigned*)(lds3 + RING_V + (slotoff) + wid * 1024), 16, 0, 0); \
    __builtin_amdgcn_global_load_lds((const unsigned*)(vp_ + (size_t)ss_ * 16384 + 8192 + kgo), (ATT_LAS unsigned*)(lds3 + RING_V + (slotoff) + 8192 + wid * 1024), 16, 0, 0); } while (0)
#define WAITBAR(n) do { if constexpr (PM == 4) asm volatile("s_waitcnt vmcnt(" #n ") lgkmcnt(0)" ::: "memory"); else if constexpr (PM == 6) asm volatile("s_waitcnt lgkmcnt(0)\n\ts_barrier" ::: "memory"); else asm volatile("s_waitcnt vmcnt(" #n ") lgkmcnt(0)\n\ts_barrier" ::: "memory"); } while (0)
#define MFMA_DRAIN() asm volatile("s_nop 15\n\ts_nop 7" ::: "memory")
#define RESC(a) do { if (__any((a) < 1.f)) { MFMA_DRAIN(); if (hi == 0) al_l[r32] = (a); asm volatile("s_waitcnt lgkmcnt(0)" ::: "memory"); \
    _Pragma("unroll") for (int r = 0; r < 16; ++r) { const float a_ = al_l[crow(r, hi)]; o[0][r] *= a_; o[1][r] *= a_; o[2][r] *= a_; o[3][r] *= a_; } \
    _Pragma("unroll") for (int r = 0; r < 4; ++r) lacc[r] *= al_l[16 * (lane & 1) + 4 * (lane >> 4) + r]; } } while (0)
  int kw0 = 0, kw1 = SHM_K2, kw2 = 2 * SHM_K2, vw0 = 0, vw1 = SHM_V2, vw2 = 2 * SHM_V2;
#define ROT() do { const int k_ = kw0; kw0 = kw1; kw1 = kw2; kw2 = k_; const int v_ = vw0; vw0 = vw1; vw1 = vw2; vw2 = v_; } while (0)
#define WAITBAR_K(n) do { if constexpr (PM == 4) asm volatile("s_waitcnt vmcnt(" #n ") lgkmcnt(0)" : "+v"(kfr[0]), "+v"(kfr[1]) :: "memory"); else if constexpr (PM == 6) asm volatile("s_waitcnt lgkmcnt(0)\n\ts_barrier" : "+v"(kfr[0]), "+v"(kfr[1]) :: "memory"); \
    else asm volatile("s_waitcnt vmcnt(" #n ") lgkmcnt(0)\n\ts_barrier" : "+v"(kfr[0]), "+v"(kfr[1]) :: "memory"); } while (0)
#define KLOAD(slot_) do { if constexpr (PM == 5) asm volatile("" : "=v"(kfr[0]), "=v"(kfr[1])); else k_load(kfr, kbase + (slot_) + voffl, kbase + (slot_) + voffh, pop); } while (0)
#define VLOAD(slot_) do { if constexpr (PM == 5) asm volatile("" : "=v"(vfr[0]), "=v"(vfr[1]), "=v"(vfr[2]), "=v"(vfr[3])); else v_load(vfr, vbase + (slot_) + voffl, vbase + (slot_) + voffh); } while (0)
#define PV1(d_) do { if constexpr (PM != 2) pv_one(o[d_], vfr[d_], pop); else asm volatile("" : "+v"(o[d_]) : "v"(pop), "v"(vfr[d_])); } while (0)
#define PVS() do { if constexpr (PM != 2) pv_sum(lacc, ones, pop); else asm volatile("" : "+v"(lacc) : "v"(pop)); } while (0)
#define STEP(pkN, rsN, alN, pkO, rsO, VOFF, KOFF, KRD) do { f32x16 p0_, p1_; float pm_; \
    SBAR(); VLOAD(VOFF); SBAR(); \
    qk_mm<PM>(p0_, p1_, minit, kfr, qr); \
    finishSM<PM>(pkO, rsO, pop); SBAR(); \
    LDS_WAIT_V(); \
    PV1(0); SBAR(); pm_ = sm_max16(p0_, p0_[0]); SBAR(); \
    PV1(1); SBAR(); pm_ = sm_maxfin(sm_max16(p1_, pm_)); SBAR(); \
    if (KRD) { KLOAD(KOFF); SBAR(); } \
    sm_rebase<PM>(p0_, p1_, minit, pm_, alN); SBAR(); \
    PV1(2); SBAR(); sm_exp8<PM, 0>(p0_); SBAR(); \
    PV1(3); SBAR(); sm_exp8<PM, 8>(p0_); SBAR(); \
    PVS();  SBAR(); sm_exp8<PM, 0>(p1_); \
    _Pragma("unroll") for (int g_ = 0; g_ < 4; ++g_) pkN[g_] = cvt4_fp8(p0_[4 * g_], p0_[4 * g_ + 1], p0_[4 * g_ + 2], p0_[4 * g_ + 3]); \
    pkN[4] = cvt4_fp8(p1_[0], p1_[1], p1_[2], p1_[3]); pkN[5] = cvt4_fp8(p1_[4], p1_[5], p1_[6], p1_[7]); \
    _Pragma("unroll") for (int r_ = 0; r_ < 8; ++r_) rsN[r_] = p1_[8 + r_]; \
    asm volatile("" : "+v"(pkN[0]), "+v"(pkN[1]), "+v"(pkN[2]), "+v"(pkN[3]), "+v"(pkN[4]), "+v"(pkN[5]), "+v"(rsN[0]), "+v"(rsN[1]), "+v"(rsN[2]), "+v"(rsN[3]), "+v"(rsN[4]), "+v"(rsN[5]), "+v"(rsN[6]), "+v"(rsN[7]));   \
    } while (0)
  if (!pre) { DMA_KS(0, 0); DMA_KS(1, SHM_K2); DMA_KS(2, 2 * SHM_K2); DMA_VS(0, 0); DMA_VS(1, SHM_V2); }
  { const v4i q0 = *reinterpret_cast<const v4i*>(Qb + qoff), q1 = *reinterpret_cast<const v4i*>(Qb + qoff + 16); qr = __builtin_shufflevector(q0, q1, 0, 1, 2, 3, 4, 5, 6, 7); }
  asm volatile("s_waitcnt vmcnt(0)" ::: "memory");
  int pkA[6], pkB[6]; float rsA[8], rsB[8]; float alA, alB; v8i pop = qr, kfr[2], vfr[4];
  asm volatile("s_barrier" ::: "memory");
  KLOAD(0); asm volatile("s_waitcnt lgkmcnt(0)" : "+v"(kfr[0]), "+v"(kfr[1]) :: "memory"); { f32x16 p0_, p1_; qk_mm<PM>(p0_, p1_, minit, kfr, qr); partialSM<PM, true>(p0_, p1_, minit, alA, pkA, rsA); }
  SBAR(); KLOAD(4096); SBAR();
  WAITBAR_K(0);
  if (wid >= 4) __builtin_amdgcn_s_setprio(1);
#pragma unroll 1
  for (int w = 0; w + 1 < NS; ++w) {
    DMA_KS(w + 3, kw0); DMA_VS(w + 2, vw2);
    STEP(pkB, rsB, alB, pkA, rsA, vw0, kw1, true);
    asm volatile("s_waitcnt lgkmcnt(0)" : "+v"(kfr[0]), "+v"(kfr[1]) :: "memory"); RESC(alB);
    STEP(pkA, rsA, alA, pkB, rsB, vw0 + 8192, kw1 + 4096, true);
    WAITBAR_K(3); ROT(); RESC(alA);
  }
  if (Kn != nullptr) { DMA_KS(NS + 2, kw0); DMA_VS(NS + 1, vw2); }
  STEP(pkB, rsB, alB, pkA, rsA, vw0, 0, false);
  RESC(alB);
  SBAR(); VLOAD(vw0 + 8192); SBAR();
  finishSM<PM>(pkB, rsB, pop); SBAR();
  LDS_WAIT_V(); PV1(0); PV1(1); PV1(2); PV1(3); PVS();
  MFMA_DRAIN();
  __builtin_amdgcn_s_setprio(0);
  if ((lane & 15) < 2) {
#pragma unroll
    for (int r = 0; r < 4; ++r) al_l[16 * (lane & 15) + 4 * (lane >> 4) + r] = lacc[r]; }
  asm volatile("s_waitcnt lgkmcnt(0)" ::: "memory");
#pragma unroll
  for (int r = 0; r < 16; ++r) rli[r] = __builtin_amdgcn_rcpf(al_l[crow(r, hi)]) * VT_UNSCALE;
  WAITBAR(0);
#undef LDS_WAIT_V
#undef STEP
#undef PV1
#undef PVS
#undef KLOAD
#undef VLOAD
#undef WAITBAR_K
#undef DMA_KS
#undef DMA_VS
#undef WAITBAR
#undef RESC
#undef MFMA_DRAIN
#undef ROT
}
constexpr int STASH_OFF = RING_END, ATTN_LDS_TOTAL = STASH_OFF + NW * 8192;
template <bool F8, int PM = 0>
__device__ __forceinline__ void attn_diff_unit(const unsigned char* __restrict__ Qb, const unsigned char* __restrict__ Kh, const unsigned char* __restrict__ Vh, const unsigned char* Knext, const unsigned char* Vnext, bool pre, unsigned char* __restrict__ Ob, float lam, const float* __restrict__ subln_g, float gscale, char* lds, ATT_LAS unsigned char* lds3) {
  const int tid = threadIdx.x, wid = tid >> 6, lane = tid & 63, r32 = lane & 31, hi = lane >> 5;
  unsigned* stash = (unsigned*)(lds + STASH_OFF + wid * 8192);
#pragma unroll 1
  for (int map = 0; map < 2; ++map) {
    f32x16 o[4]; float rli[16];
    attn_pass<PM>(Qb + 64 * map, Kh + map * (NKEYS * 64), Vh, map == 0 ? Kh + NKEYS * 64 : Knext, map == 0 ? Vh : Vnext, map == 0 ? pre : true, lds, lds3, o, rli);
    if (map == 0) {
#pragma unroll
      for (int r = 0; r < 16; ++r) { stash[(r * 2 + 0) * 64 + lane] = cvtpk(o[0][r] * rli[r], o[1][r] * rli[r]); stash[(r * 2 + 1) * 64 + lane] = cvtpk(o[2][r] * rli[r], o[3][r] * rli[r]); }
    } else {
  int lane; asm volatile("v_mbcnt_lo_u32_b32 %0, -1, 0\n\tv_mbcnt_hi_u32_b32 %0, -1, %0" : "=v"(lane));
  const int r32 = lane & 31, hi = lane >> 5;
  float ss[16];
#pragma unroll
  for (int r = 0; r < 16; ++r) { const unsigned w0 = stash[(r * 2 + 0) * 64 + lane], w1 = stash[(r * 2 + 1) * 64 + lane];
    o[0][r] = __uint_as_float(w0 << 16) - lam * (o[0][r] * rli[r]); o[1][r] = __uint_as_float(w0 & 0xffff0000u) - lam * (o[1][r] * rli[r]);
    o[2][r] = __uint_as_float(w1 << 16) - lam * (o[2][r] * rli[r]); o[3][r] = __uint_as_float(w1 & 0xffff0000u) - lam * (o[3][r] * rli[r]);
    float q = (o[0][r] * o[0][r] + o[1][r] * o[1][r]) + (o[2][r] * o[2][r] + o[3][r] * o[3][r]);
    q += __shfl_xor(q, 1); q += __shfl_xor(q, 2); q += __shfl_xor(q, 4); q += __shfl_xor(q, 8); q += __shfl_xor(q, 16);
    ss[r] = 1.0f / sqrtf(q * (1.0f / 128.0f) + 1e-6f); }
  float gs[4];
#pragma unroll
  for (int d0 = 0; d0 < 4; ++d0) gs[d0] = subln_g[d0 * 32 + r32] * gscale;
  if constexpr (F8) {
    unsigned char* stg = (unsigned char*)stash;
#pragma unroll
    for (int r = 0; r < 16; ++r) { const int row = crow(r, hi);
#pragma unroll
      for (int d0 = 0; d0 < 4; d0 += 2) { int w = 0; w = __builtin_amdgcn_cvt_pk_fp8_f32(o[d0][r] * ss[r] * gs[d0], o[d0 + 1][r] * ss[r] * gs[d0 + 1], w, false);
        stg[row * 128 + d0 * 32 + r32] = (unsigned char)(w & 0xff); stg[row * 128 + (d0 + 1) * 32 + r32] = (unsigned char)((w >> 8) & 0xff); } }
    asm volatile("s_waitcnt lgkmcnt(0)" ::: "memory");
#pragma unroll
    for (int i = 0; i < 4; ++i) { const int c = i * 64 + lane, row = c >> 3, ch = c & 7; const u32x4 v = *(const u32x4*)(stg + row * 128 + ch * 16);
      *(u32x4*)(Ob + (long)(wid * QBLK + row) * 1024 + ch * 16) = v; }
  } else {
    bf16* stg = (bf16*)(lds + wid * 8192);
#pragma unroll
    for (int r = 0; r < 16; ++r) { const int row = crow(r, hi);
#pragma unroll
      for (int d0 = 0; d0 < 4; d0 += 2) { const unsigned w = cvtpk(o[d0][r] * ss[r] * gs[d0], o[d0 + 1][r] * ss[r] * gs[d0 + 1]);
        stg[row * 128 + d0 * 32 + r32] = (bf16)(w & 0xffffu); stg[row * 128 + (d0 + 1) * 32 + r32] = (bf16)(w >> 16); } }
    asm volatile("s_waitcnt lgkmcnt(0)" ::: "memory");
#pragma unroll
    for (int i = 0; i < 8; ++i) { const int c = i * 64 + lane, row = c >> 4, ch = c & 15; const u32x4 v = *(const u32x4*)((const char*)stg + row * 256 + ch * 16);
      *(u32x4*)(Ob + (long)(wid * QBLK + row) * 2048 + ch * 16) = v; }
  }
    }
  }
  __syncthreads();
}
#undef SBAR
}

constexpr int NWAVES = 8;
constexpr int D = 1024, NB = 16, SEQ = 2048, CTX = 256, ML = NB * SEQ, MC = NB * CTX, MA = ML + MC;
constexpr int NE = 16, FF = 2048, CAPL = 256, CAPC = 32, NPL = 256, NPC = 32;
constexpr int NMOD = 6 * D;
constexpr float EPS = 1e-6f;
constexpr float QSCALE = 0.125f * 1.4426950408889634f;
constexpr size_t MiB = 1u << 20;
constexpr size_t WS_CTL = 0, CTL_ZERO_BYTES = 1 * MiB;
constexpr size_t WS_MOD = 1 * MiB;
constexpr size_t WS_ROPE = 2 * MiB;
constexpr size_t WS_AFF = 3 * MiB;
constexpr size_t WS_INV = 6 * MiB;
constexpr size_t WS_RIDX = 9 * MiB;
constexpr size_t WS_SAH = 10 * MiB, WS_SAH2 = 11 * MiB, WS_SAG = 12 * MiB;
constexpr size_t WS_WIN = 25 * MiB, WS_WOUT = 31 * MiB, WS_WQKV = 33 * MiB, WS_WO = 39 * MiB;
constexpr size_t WS_WGU8 = 41 * MiB;
constexpr size_t WS_WD8 = 169 * MiB;
constexpr size_t WS_H = 233 * MiB;
constexpr size_t WS_H8 = 305 * MiB;
constexpr size_t WS_BUF1 = 341 * MiB, WS_BUF2 = 413 * MiB, WS_BUF3 = 485 * MiB, WS_OPART = 549 * MiB;
constexpr size_t WS_XS8 = 341 * MiB, WS_HID8 = 413 * MiB, WS_Y = 557 * MiB;
constexpr size_t WS_XR = 701 * MiB;
constexpr size_t WS_END = 773 * MiB;
static_assert(WS_HID8 + (size_t)(NPL + NPC) * 256 * FF <= WS_Y && WS_OPART + (size_t)ML * 2048 * 2 <= WS_END && WS_XS8 + (size_t)(NPL + NPC) * 256 * D <= WS_HID8 && WS_Y + (size_t)(NPL + NPC) * 256 * D * 2 <= WS_END, "d_ws map");
#ifndef MIX8
#define MIX8 2
#endif
constexpr bool CONV8 = (MIX8 & 1) != 0, ATT8 = (MIX8 & 2) != 0, CONVO8 = (MIX8 & 4) != 0;
#ifndef I8MASK
#define I8MASK 9
#endif
constexpr bool CIN_I8 = (I8MASK & 1) != 0, QKV_I8 = (I8MASK & 2) != 0, UP_I8 = (I8MASK & 4) != 0, COUT_I8 = (I8MASK & 8) != 0;
constexpr float WS8 = 1024.0f;
constexpr float WSCALE = 64.0f, HSCALE = 4.0f, YSCALE = 8.0f;
constexpr int CW_TMO = 0, CW_BAR = 4096;
constexpr int RING_BYTES = 131072, LDS_BYTES = 147456, LDSCTL_OFF = LDS_BYTES - 1024, MISC_OFF = LDSCTL_OFF + 320;

#define GAS __attribute__((address_space(1)))
#define LAS __attribute__((address_space(3)))
typedef unsigned short bf16;
typedef unsigned v4u __attribute__((ext_vector_type(4)));
typedef unsigned v2u __attribute__((ext_vector_type(2)));
typedef float f32x4 __attribute__((ext_vector_type(4)));
typedef GAS unsigned gu32;
#define RLX_AGENT __ATOMIC_RELAXED, __HIP_MEMORY_SCOPE_AGENT
#define LDS_WAIT() asm volatile("s_waitcnt lgkmcnt(0)" ::: "memory")
#define VM_WAIT() asm volatile("s_waitcnt vmcnt(0)" ::: "memory")
__device__ __forceinline__ unsigned pk2(float lo, float hi) { return pg8::cvt_pk_bf16(lo, hi); }
__device__ __forceinline__ float bflo(unsigned w) { return __uint_as_float(w << 16); }
__device__ __forceinline__ float bfhi(unsigned w) { return __uint_as_float(w & 0xffff0000u); }

#define XB_TMO      128
#define XB_XCNT(j)  (256  + 64 * (j))
#define XB_XSUB(j)  (1280 + 64 * (j))
#define XB_XGEN(j)  (2304 + 64 * (j))
#define XB_TOP      3328
#define XB_TOPGEN   3392
#define XCD_BAR_WORDS 3456
#define XB_SPIN_CAP (1u << 18)

__device__ __forceinline__ unsigned xb_ld(unsigned* p)              { return __hip_atomic_load(p, __ATOMIC_RELAXED, __HIP_MEMORY_SCOPE_AGENT); }
__device__ __forceinline__ unsigned xb_add(unsigned* p, unsigned v) { return __hip_atomic_fetch_add(p, v, __ATOMIC_RELAXED, __HIP_MEMORY_SCOPE_AGENT); }
__device__ __forceinline__ unsigned xb_xcc_id() { return (unsigned)__builtin_amdgcn_s_getreg((3 << 11) | 20) & 0xFu; }
#define XB_SPIN(cond, bar) do { unsigned _sp = 0; while (cond) { __builtin_amdgcn_s_sleep(1); \
    if ((++_sp & 255u) == 0u) { if (xb_ld(&(bar)[XB_TMO])) break; if (_sp > XB_SPIN_CAP) { atomicAdd(&(bar)[XB_TMO], 1u); break; } } } } while (0)

struct XcdBarrier {
    unsigned* bar; unsigned x;
    volatile LAS unsigned* st;
};

__device__ __forceinline__ XcdBarrier xcd_barrier_post(unsigned* bar, volatile LAS unsigned* st) {
    XcdBarrier b; b.bar = bar; b.x = xb_xcc_id(); b.st = st;
    if (threadIdx.x == 0) (void)xb_add(&bar[XB_XCNT(b.x)], 1u);
    return b;
}
__device__ __forceinline__ void xcd_barrier_complete(unsigned* bar, unsigned x, unsigned& nloc, unsigned& nx) {
    const unsigned G = gridDim.x * gridDim.y * gridDim.z;
    unsigned sum, cnt, mine, sp = 0u;
    for (;;) {
        sum = 0u; cnt = 0u; mine = 0u;
#pragma unroll
        for (unsigned j = 0; j < 16; ++j) { const unsigned c = xb_ld(&bar[XB_XCNT(j)]); sum += c; cnt += (c > 0u) ? 1u : 0u; mine = (j == x) ? c : mine; }
        if (sum == G) break;
        __builtin_amdgcn_s_sleep(1);
        if ((++sp & 255u) == 0u) { if (xb_ld(&bar[XB_TMO])) break; if (sp > XB_SPIN_CAP) { atomicAdd(&bar[XB_TMO], 1u); break; } }
    }
    nloc = mine > 0u ? mine : 1u; nx = cnt > 0u ? cnt : 1u;
}

__device__ __forceinline__ void xcd_barrier(const XcdBarrier& b) {
    asm volatile("s_waitcnt vmcnt(0)" ::: "memory");
    __syncthreads();
    if (threadIdx.x == 0) {
        unsigned* bar = b.bar;
        __builtin_amdgcn_s_waitcnt(0);
        unsigned nloc = b.st[0], nx = b.st[1];
        if (nloc == 0u) { xcd_barrier_complete(bar, b.x, nloc, nx); b.st[0] = nloc; b.st[1] = nx; }
        const unsigned old = xb_add(&bar[XB_XSUB(b.x)], 1u);
        const unsigned gen = old / nloc;
        if (old + 1u == (gen + 1u) * nloc) {
            __builtin_amdgcn_fence(__ATOMIC_ACQUIRE, "agent");
            __builtin_amdgcn_fence(__ATOMIC_RELEASE, "agent");
            asm volatile("s_waitcnt vmcnt(0)" ::: "memory");
            const unsigned og = xb_add(&bar[XB_TOP], 1u);
            const unsigned tg = og / nx;
            if (og + 1u == (tg + 1u) * nx) xb_add(&bar[XB_TOPGEN], 1u);
            else XB_SPIN(xb_ld(&bar[XB_TOPGEN]) == tg, bar);
            xb_add(&bar[XB_XGEN(b.x)], 1u);
            asm volatile("s_waitcnt vmcnt(0)" ::: "memory");
        } else {
            __builtin_amdgcn_fence(__ATOMIC_ACQUIRE, "agent");
            XB_SPIN(xb_ld(&bar[XB_XGEN(b.x)]) == gen, bar);
            asm volatile("s_waitcnt vmcnt(0)" ::: "memory");
        }
    }
    __syncthreads();
}

struct R16 { f32x4 v[4]; };
__device__ __forceinline__ int lane_now() { int l; asm volatile("v_mbcnt_lo_u32_b32 %0, -1, 0\n\tv_mbcnt_hi_u32_b32 %0, -1, %0" : "=v"(l)); return l; }
__device__ __forceinline__ float wave_sum(float v) {
#pragma unroll
    for (int o = 1; o < 64; o <<= 1) v += __shfl_xor(v, o);
    return v;
}
__device__ __forceinline__ void ld_f32(R16& r, const float* p, int lane) {
#pragma unroll
    for (int j = 0; j < 4; ++j) r.v[j] = ((const f32x4*)p)[lane + 64 * j];
}
__device__ __forceinline__ void st_f32(float* p, int lane, const R16& r) {
#pragma unroll
    for (int j = 0; j < 4; ++j) ((f32x4*)p)[lane + 64 * j] = r.v[j];
}
__device__ __forceinline__ void ld_bf16(R16& r, const bf16* p, int lane) {
#pragma unroll
    for (int j = 0; j < 4; ++j) { const v2u w = ((const v2u*)p)[lane + 64 * j]; r.v[j] = (f32x4){bflo(w.x), bfhi(w.x), bflo(w.y), bfhi(w.y)}; }
}
__device__ __forceinline__ void st_bf16(bf16* p, int lane, const R16& r) {
#pragma unroll
    for (int j = 0; j < 4; ++j) { v2u w; w.x = pk2(r.v[j][0], r.v[j][1]); w.y = pk2(r.v[j][2], r.v[j][3]); ((v2u*)p)[lane + 64 * j] = w; }
}
__device__ __forceinline__ void st_fp8(unsigned char* p, int lane, const R16& r) {
#pragma unroll
    for (int j = 0; j < 4; ++j) ((unsigned*)p)[lane + 64 * j] = pg8::pk4_fp8(r.v[j][0], r.v[j][1], r.v[j][2], r.v[j][3]);
}
__device__ __forceinline__ float st_i8(unsigned char* p, float* scale_out, int lane, const R16& r) {
    float mx = 0.f;
#pragma unroll
    for (int j = 0; j < 4; ++j) mx = fmaxf(fmaxf(mx, fmaxf(fabsf(r.v[j][0]), fabsf(r.v[j][1]))), fmaxf(fabsf(r.v[j][2]), fabsf(r.v[j][3])));
#pragma unroll
    for (int o = 1; o < 64; o <<= 1) mx = fmaxf(mx, __shfl_xor(mx, o));
    const float inv = (mx > 0.f) ? 127.0f / mx : 0.f;
#pragma unroll
    for (int j = 0; j < 4; ++j) ((unsigned*)p)[lane + 64 * j] = pg8::pk4_i8(r.v[j][0] * inv, r.v[j][1] * inv, r.v[j][2] * inv, r.v[j][3] * inv);
    const float s_ = (mx > 0.f) ? mx * (1.0f / 127.0f) : 1.0f;
    if (scale_out != nullptr && lane == 0) *scale_out = s_;
    return s_;
}
__device__ __forceinline__ float sumsq(const R16& r) {
    float s = 0.f;
#pragma unroll
    for (int j = 0; j < 4; ++j) s += (r.v[j][0] * r.v[j][0] + r.v[j][1] * r.v[j][1]) + (r.v[j][2] * r.v[j][2] + r.v[j][3] * r.v[j][3]);
    return s;
}
__device__ __forceinline__ float rms_scale(const R16& r) { return 1.0f / sqrtf(wave_sum(sumsq(r)) * (1.0f / 1024.0f) + EPS); }

struct Args { const float* in[24]; float* out; unsigned char* ws; int ph_lo, ph_hi; };
enum { I_X = 0, I_C, I_CTX, I_CCTX, I_ADAW, I_ADAB, I_PREMIX, I_POSTMIX, I_PREFFN, I_POSTFFN, I_CWIN, I_CK, I_CWOUT, I_WQKV, I_LQ1, I_LK1, I_LQ2, I_LK2, I_SUBLN, I_WO, I_ROUTER, I_WG, I_WU, I_WDN };
constexpr int N_PHASES = 19;

__device__ __forceinline__ void titem_decode(const Args& a, int it, const float*& src, unsigned char*& dst, int& N, int& K, int& f8) {
    unsigned char* ws = a.ws; int r = it;
    if (r < 768) {
        const int kb = r / 96, nb = r % 96, n0 = nb * 32, part = n0 >> 10, ch = n0 & 1023;
        const int drow = (part == 0) ? (2048 + ch) : ((ch >> 7) * 256 + (ch & 127) + (part == 2 ? 128 : 0));
        N = 3072; f8 = CIN_I8 ? 2 : (CONV8 ? 1 : 0); K = f8 ? 1024 : 2048; src = a.in[I_CWIN] + (size_t)(kb * 128) * 3072 + n0; dst = ws + WS_WIN + (size_t)drow * K + kb * (f8 ? 128 : 256); return; }
    r -= 768;
    if (r < 256) { const int kb = r / 32, nb = r % 32; N = 1024; f8 = COUT_I8 ? 2 : (CONVO8 ? 1 : 0); K = f8 ? 1024 : 2048; src = a.in[I_CWOUT] + (size_t)(kb * 128) * 1024 + nb * 32; dst = ws + WS_WOUT + (size_t)(nb * 32) * K + kb * (f8 ? 128 : 256); return; }
    r -= 256;
    if (r < 768) { const int kb = r / 96, nb = r % 96; N = 3072; f8 = QKV_I8 ? 2 : (ATT8 ? 1 : 0); K = f8 ? 1024 : 2048; src = a.in[I_WQKV] + (size_t)(kb * 128) * 3072 + nb * 32; dst = ws + WS_WQKV + (size_t)(nb * 32) * K + kb * (f8 ? 128 : 256); return; }
    r -= 768;
    if (r < 256) { const int kb = r / 32, nb = r % 32; N = 1024; f8 = ATT8 ? 1 : 0; K = ATT8 ? 1024 : 2048; src = a.in[I_WO] + (size_t)(kb * 128) * 1024 + nb * 32; dst = ws + WS_WO + (size_t)(nb * 32) * K + kb * (ATT8 ? 128 : 256); return; }
    r -= 256;
    const int seg = r >> 13, which = seg % 3, le = (seg / 3) * 16 + ((r & 8191) >> 9), item = r & 511;
    f8 = 1;
    if (which < 2) {             f8 = UP_I8 ? 2 : 1;
        const int kb = item >> 6, nb = item & 63, f0 = nb * 32, drow = (f0 >> 7) * 256 + (f0 & 127) + (which ? 128 : 0);
        N = 2048; K = 1024; src = a.in[which ? I_WU : I_WG] + (size_t)le * 1024 * 2048 + (size_t)(kb * 128) * 2048 + f0; dst = ws + WS_WGU8 + ((size_t)le * 4096 + drow) * 1024 + kb * 128;
    } else {
        const int kb = item >> 5, nb = item & 31;
        N = 1024; K = 2048; src = a.in[I_WDN] + (size_t)le * 2048 * 1024 + (size_t)(kb * 128) * 1024 + nb * 32; dst = ws + WS_WD8 + ((size_t)le * 1024 + nb * 32) * 2048 + kb * 128;
    }
}

constexpr int I_SMALL = 768 + 256 + 768 + 256, I_MOE = 16384, NITEMS = I_SMALL + 3 * I_MOE;
enum { DS_TOPK1 = 0, DS_QKV, DS_DOWN0, DS_TOPK0, DS_COUT, DS_CIN, DS_N };
#ifndef DEFQ
#define DEFQ {4, 3, 6, 4, 2, 6}
#endif
__device__ __forceinline__ int def_idle_waves(int slot, int G) {
    const int NGW = G * NWAVES;
    if (slot == DS_TOPK0) return NGW > 512 ? NGW - 512 : 0;
    if (slot == DS_TOPK1) return NGW > 256 ? NGW - 256 : 0;
    const int units = (slot == DS_CIN) ? (MA / 256) * 12 : (slot == DS_COUT) ? (MA / 256) * 4 : (slot == DS_DOWN0) ? (NPL + NPC) * 4 : 128 * 12 + 16 * 8, rem = units % G;
    return rem ? (G - rem) * NWAVES : 0; }
__device__ __forceinline__ int def_count(int slot, int G) { constexpr int q[DS_N] = DEFQ; return (G == 256) ? q[slot] * def_idle_waves(slot, G) : 0; }
__device__ __forceinline__ int def_base(int slot, int G) { int b = NITEMS; for (int s = 0; s <= slot; ++s) b -= def_count(s, G); return b; }
__device__ __forceinline__ void copy_items(const Args& a, LAS float* scr, int lane, int it0, int step, int it_end) {
    if (it0 < it_end) {
        const float* src; unsigned char* dst; int N, K; int f8;
        f32x4 buf[16];
#define ITEM_LOAD() do { _Pragma("unroll") for (int i = 0; i < 16; ++i) buf[i] = *(const f32x4*)(src + (size_t)(8 * i + (lane >> 3)) * N + 4 * (lane & 7)); } while (0)
        int it = it0;
        titem_decode(a, it, src, dst, N, K, f8); ITEM_LOAD();
        for (;;) {
#pragma unroll
            for (int i = 0; i < 16; ++i) { LAS float* d = scr + (8 * i + (lane >> 3)) * 33 + 4 * (lane & 7); d[0] = buf[i][0]; d[1] = buf[i][1]; d[2] = buf[i][2]; d[3] = buf[i][3]; }
            unsigned char* cdst = dst; const int cK = K; const int cf8 = f8;
            const int nxt = it + step; const bool has = nxt < it_end;
            if (has) { titem_decode(a, nxt, src, dst, N, K, f8); ITEM_LOAD(); }
            LDS_WAIT(); asm volatile("" ::: "memory");
            const int c = lane & 15;
            if (cf8 == 2) {
#pragma unroll
                for (int j = 0; j < 8; ++j) { const int n = (lane >> 4) + 4 * j; const LAS float* s = scr + (8 * c) * 33 + n;
                    v2u o; o.x = pg8::pk4_i8(s[0 * 33] * WS8, s[1 * 33] * WS8, s[2 * 33] * WS8, s[3 * 33] * WS8); o.y = pg8::pk4_i8(s[4 * 33] * WS8, s[5 * 33] * WS8, s[6 * 33] * WS8, s[7 * 33] * WS8);
                    *(GAS v2u*)(cdst + (size_t)n * cK + 8 * c) = o; }
            } else if (cf8 == 1) {
#pragma unroll
                for (int j = 0; j < 8; ++j) { const int n = (lane >> 4) + 4 * j; const LAS float* s = scr + (8 * c) * 33 + n;
                    v2u o; o.x = pg8::pk4_fp8(s[0 * 33] * WSCALE, s[1 * 33] * WSCALE, s[2 * 33] * WSCALE, s[3 * 33] * WSCALE); o.y = pg8::pk4_fp8(s[4 * 33] * WSCALE, s[5 * 33] * WSCALE, s[6 * 33] * WSCALE, s[7 * 33] * WSCALE);
                    *(GAS v2u*)(cdst + (size_t)n * cK + 8 * c) = o; }
            } else {
#pragma unroll
                for (int j = 0; j < 8; ++j) { const int n = (lane >> 4) + 4 * j; const LAS float* s = scr + (8 * c) * 33 + n;
                    v4u o; o.x = pk2(s[0 * 33], s[1 * 33]); o.y = pk2(s[2 * 33], s[3 * 33]); o.z = pk2(s[4 * 33], s[5 * 33]); o.w = pk2(s[6 * 33], s[7 * 33]);
                    *(GAS v4u*)(cdst + (size_t)n * cK + 16 * c) = o; }
            }
            LDS_WAIT(); asm volatile("" ::: "memory");
            if (!has) break;
            it = nxt;
        }
#undef ITEM_LOAD
    }
}
__device__ __forceinline__ void tail_items(const Args& a, LAS unsigned char* lds, int slot, int units, int G, int bx, int wave, int lane) {
    const int rem = units % G;
    if (rem != 0 && bx >= rem) { const int idle = def_idle_waves(slot, G), base = def_base(slot, G);
        copy_items(a, (LAS float*)(lds + wave * (128 * 33 * 4)), lane, base + (bx - rem) * NWAVES + wave, idle, base + def_count(slot, G)); }
}
__device__ __forceinline__ void phase_prologue_a(const Args& a, LAS unsigned char* lds, int vcu, int G, int wave, int lane, int tid) {
    unsigned char* ws = a.ws;
    if (vcu < 192) {
        LAS float* sl = (LAS float*)lds;
        LAS float* red = sl + 17 * 1024;
        const float* c = a.in[I_C]; const float* cc = a.in[I_CCTX];
        for (int idx = tid; idx < 17 * 1024; idx += 512) { const int r = idx >> 10, k = idx & 1023; const float v = (r < 16) ? c[r * 1024 + k] : cc[k]; sl[idx] = v / (1.0f + __expf(-v)); }
        __syncthreads();
        const int layer = vcu / 96, n0 = (vcu % 96) * 64;
        const float* W = a.in[I_ADAW] + (size_t)layer * 1024 * NMOD + n0 + lane;
        float acc[17];
#pragma unroll
        for (int r = 0; r < 17; ++r) acc[r] = 0.f;
        const int k0 = wave * 128;
#pragma unroll 2
        for (int kk = 0; kk < 128; kk += 4) {
            const float w0 = W[(size_t)(k0 + kk) * NMOD], w1 = W[(size_t)(k0 + kk + 1) * NMOD], w2 = W[(size_t)(k0 + kk + 2) * NMOD], w3 = W[(size_t)(k0 + kk + 3) * NMOD];
#pragma unroll
            for (int r = 0; r < 17; ++r) { const f32x4 s = *(const LAS f32x4*)(sl + r * 1024 + k0 + kk); acc[r] += (s[0] * w0 + s[1] * w1) + (s[2] * w2 + s[3] * w3); }
        }
#pragma unroll
        for (int r = 0; r < 17; ++r) red[(wave * 17 + r) * 64 + lane] = acc[r];
        __syncthreads();
        float* MOD = (float*)(ws + WS_MOD);
        for (int idx = tid; idx < 17 * 64; idx += 512) { const int r = idx >> 6, l = idx & 63; float s = 0.f;
#pragma unroll
            for (int w = 0; w < 8; ++w) s += red[(w * 17 + r) * 64 + l];
            MOD[(size_t)(layer * 17 + r) * NMOD + n0 + l] = s + a.in[I_ADAB][layer * NMOD + n0 + l]; }
        __syncthreads();
    }
    if (vcu == G - 1) { float* rt = (float*)(ws + WS_ROPE);
#pragma unroll 1
        for (int f = 2 * wave; f < 2 * wave + 2; ++f) { const float inv = 1.0f / powf(10000.0f, (float)f / 16.0f); const float ang = (float)lane * inv; rt[lane * 32 + f] = cosf(ang); rt[lane * 32 + 16 + f] = sinf(ang); } }
    LAS float* scr = (LAS float*)(lds + wave * (128 * 33 * 4));
    const int gw = vcu * NWAVES + wave, NGW = G * NWAVES;
    copy_items(a, scr, lane, gw, NGW, def_base(DS_N - 1, G));
}

__device__ __forceinline__ void phase_prologue_b(const Args& a, int gw, int NGW, int lane) {
    const float* MOD = (const float*)(a.ws + WS_MOD); bf16* H = (bf16*)(a.ws + WS_H);
    R16 g; ld_f32(g, a.in[I_PREMIX], lane);
    const int rpw = (MA + NGW - 1) / NGW, m_begin = gw * rpw, m_end = (m_begin + rpw < MA) ? m_begin + rpw : MA;
    int cur_b = -1; R16 sh, sc, nx; float scv = 1.0f;
#define PB_PREF(mrow_) do { const int m_ = (mrow_); ld_f32(nx, (m_ < ML) ? a.in[I_X] + (size_t)m_ * D : a.in[I_CTX] + (size_t)(m_ - ML) * D, lane); } while (0)
    if (m_begin < m_end) PB_PREF(m_begin);
    for (int m = m_begin; m < m_end; ++m) {
        const int brow = (m < ML) ? (m >> 11) : 16;
        if (brow != cur_b) { const float* md = MOD + (size_t)brow * NMOD; ld_f32(sh, md, lane); ld_f32(sc, md + 1024, lane); cur_b = brow; }
        R16 x = nx;
        if (m + 1 < m_end) PB_PREF(m + 1);
        const float rs = rms_scale(x);
#pragma unroll
        for (int j = 0; j < 4; ++j) x.v[j] = (x.v[j] * rs) * g.v[j] * (sc.v[j] + 1.0f) + sh.v[j];
        if constexpr (CIN_I8) { const float s_ = st_i8(a.ws + WS_H + (size_t)m * D, nullptr, lane, x); scv = (lane == m - m_begin) ? s_ : scv; }
        else if constexpr (CONV8) st_fp8(a.ws + WS_H + (size_t)m * D, lane, x); else st_bf16(H + (size_t)m * D, lane, x);
    }
    if constexpr (CIN_I8) { if (lane < m_end - m_begin) ((float*)(a.ws + WS_SAH))[m_begin + lane] = scv; }
#undef PB_PREF
}

__device__ __forceinline__ void phase_conv(const Args& a, int gw, int NGW, int lane) {
    const bf16* Bg = (const bf16*)(a.ws + WS_BUF1); const bf16* U = (const bf16*)(a.ws + WS_BUF2); bf16* Z = (bf16*)(a.ws + WS_H);
    float k0[16], k1[16], k2[16];
#pragma unroll
    for (int i = 0; i < 16; ++i) { k0[i] = a.in[I_CK][lane * 16 + i]; k1[i] = a.in[I_CK][1024 + lane * 16 + i]; k2[i] = a.in[I_CK][2048 + lane * 16 + i]; }
    const int rpw = (MA + NGW - 1) / NGW, m_begin = gw * rpw, m_end = (m_begin + rpw < MA) ? m_begin + rpw : MA;
    const v4u zero = {0u, 0u, 0u, 0u};
    float scv = 1.0f; v4u rm[2], r0[2], rp[2], nb[2];
#define CV_ROW(dst, mrow_) do { const int m_ = (mrow_); if (m_ >= 0 && m_ < MA) { const v4u* p_ = (const v4u*)(U + (size_t)m_ * D + lane * 16); dst[0] = p_[0]; dst[1] = p_[1]; } else { dst[0] = zero; dst[1] = zero; } } while (0)
    if (m_begin < m_end) { CV_ROW(rm, m_begin - 1); CV_ROW(r0, m_begin); CV_ROW(rp, m_begin + 1); const v4u* br = (const v4u*)(Bg + (size_t)m_begin * D + lane * 16); nb[0] = br[0]; nb[1] = br[1]; }
    for (int m = m_begin; m < m_end; ++m) {
        int t, n; if (m < ML) { t = m & 2047; n = 2048; } else { t = (m - ML) & 255; n = 256; }
        v4u b[2], u0[2], um[2], up[2];
        b[0] = nb[0]; b[1] = nb[1]; u0[0] = r0[0]; u0[1] = r0[1];
        if (t > 0) { um[0] = rm[0]; um[1] = rm[1]; } else { um[0] = zero; um[1] = zero; }
        if (t < n - 1) { up[0] = rp[0]; up[1] = rp[1]; } else { up[0] = zero; up[1] = zero; }
        rm[0] = r0[0]; rm[1] = r0[1]; r0[0] = rp[0]; r0[1] = rp[1];
        if (m + 1 < m_end) { CV_ROW(rp, m + 2); const v4u* br = (const v4u*)(Bg + (size_t)(m + 1) * D + lane * 16); nb[0] = br[0]; nb[1] = br[1]; }
        v4u z[2]; float zf[16];
#pragma unroll
        for (int h = 0; h < 2; ++h)
#pragma unroll
            for (int q = 0; q < 4; ++q) { const int i = h * 8 + q * 2;
                const float lo = bflo(b[h][q]) * (k0[i] * bflo(um[h][q]) + k1[i] * bflo(u0[h][q]) + k2[i] * bflo(up[h][q]));
                const float hi = bfhi(b[h][q]) * (k0[i + 1] * bfhi(um[h][q]) + k1[i + 1] * bfhi(u0[h][q]) + k2[i + 1] * bfhi(up[h][q]));
                if constexpr (COUT_I8) { zf[i] = lo; zf[i + 1] = hi; } else z[h][q] = pk2(lo, hi); }
        if constexpr (COUT_I8) {
            float mx = 0.f;
#pragma unroll
            for (int i = 0; i < 16; ++i) mx = fmaxf(mx, fabsf(zf[i]));
#pragma unroll
            for (int o = 1; o < 64; o <<= 1) mx = fmaxf(mx, __shfl_xor(mx, o));
            const float inv = (mx > 0.f) ? 127.0f / mx : 0.f; v4u w8;
#pragma unroll
            for (int q2 = 0; q2 < 4; ++q2) w8[q2] = pg8::pk4_i8(zf[4 * q2] * inv, zf[4 * q2 + 1] * inv, zf[4 * q2 + 2] * inv, zf[4 * q2 + 3] * inv);
            *(v4u*)(a.ws + WS_H + (size_t)m * D + lane * 16) = w8;
            scv = (lane == m - m_begin) ? ((mx > 0.f) ? mx * (1.0f / 127.0f) : 1.0f) : scv;
        } else
        if constexpr (CONVO8) { v4u w8;
#pragma unroll
            for (int q2 = 0; q2 < 4; ++q2) { const unsigned lo = z[q2 >> 1][(q2 & 1) * 2], hi = z[q2 >> 1][(q2 & 1) * 2 + 1]; w8[q2] = pg8::pk4_fp8(bflo(lo), bfhi(lo), bflo(hi), bfhi(hi)); }
            *(v4u*)(a.ws + WS_H + (size_t)m * D + lane * 16) = w8; }
        else { v4u* zr = (v4u*)(Z + (size_t)m * D + lane * 16); zr[0] = z[0]; zr[1] = z[1]; }
    }
    if constexpr (COUT_I8) { if (lane < m_end - m_begin) ((float*)(a.ws + WS_SAH))[m_begin + lane] = scv; }
#undef CV_ROW
}

__device__ __forceinline__ void phase_postmix(const Args& a, int layer, LAS unsigned char* lds, int gw, int NGW, int lane, int tid) {
    const float* MOD = (const float*)(a.ws + WS_MOD); unsigned char* H8 = a.ws + WS_H8; const bf16* Mb = (const bf16*)(a.ws + WS_BUF1);
    float* AFF = (float*)(a.ws + WS_AFF); bf16* XR = (bf16*)(a.ws + WS_XR);
    const int nrows = (layer == 0) ? MA : ML;
    LAS f32x4* wl = (LAS f32x4*)lds;
    const f32x4* rw = (const f32x4*)(a.in[I_ROUTER] + (size_t)layer * D * NE);
    R16 gpm, gpf; ld_f32(gpm, a.in[I_POSTMIX] + layer * D, lane); ld_f32(gpf, a.in[I_PREFFN] + layer * D, lane);
    const int rpw = (nrows + NGW - 1) / NGW, m_begin = gw * rpw, m_end = (m_begin + rpw < nrows) ? m_begin + rpw : nrows;
    int cur_b = -1; R16 t0, sh, sc; v2u nmm[4], nxb[4]; f32x4 nxf[4];
#define PM_PREF(mrow_) do { const int m_ = (mrow_); _Pragma("unroll") for (int j = 0; j < 4; ++j) nmm[j] = ((const v2u*)(Mb + (size_t)m_ * D))[lane + 64 * j]; \
        if (layer == 0) { const f32x4* xp_ = (const f32x4*)((m_ < ML) ? a.in[I_X] + (size_t)m_ * D : a.in[I_CTX] + (size_t)(m_ - ML) * D); _Pragma("unroll") for (int j = 0; j < 4; ++j) nxf[j] = xp_[lane + 64 * j]; } \
        else { _Pragma("unroll") for (int j = 0; j < 4; ++j) nxb[j] = ((const v2u*)(XR + (size_t)m_ * D))[lane + 64 * j]; } } while (0)
    if (m_begin < m_end) PM_PREF(m_begin);
    for (int idx = tid; idx < 4096; idx += 512) { const int k = idx >> 2, c = idx & 3, j = k >> 8, l = (k >> 2) & 63, i = k & 3; wl[((j * 4 + i) * 4 + c) * 64 + l] = rw[idx]; }
    __syncthreads();
    LAS float* affb = (LAS float*)(lds + 65536 + (tid >> 6) * 2048);
    for (int m = m_begin; m < m_end; ++m) {
        asm volatile("" ::: "memory");
        const int brow = (m < ML) ? (m >> 11) : 16;
        if (brow != cur_b) { const float* md = MOD + (size_t)(layer * 17 + brow) * NMOD; ld_f32(t0, md + 2048, lane); ld_f32(sh, md + 3072, lane); ld_f32(sc, md + 4096, lane); cur_b = brow; }
        R16 mm, x;
#pragma unroll
        for (int j = 0; j < 4; ++j) { mm.v[j] = (f32x4){bflo(nmm[j].x), bfhi(nmm[j].x), bflo(nmm[j].y), bfhi(nmm[j].y)};
            if (layer == 0) x.v[j] = nxf[j]; else x.v[j] = (f32x4){bflo(nxb[j].x), bfhi(nxb[j].x), bflo(nxb[j].y), bfhi(nxb[j].y)}; }
        if (m + 1 < m_end) PM_PREF(m + 1);
        const float rs = rms_scale(mm);
#pragma unroll
        for (int j = 0; j < 4; ++j) x.v[j] = x.v[j] + t0.v[j] * ((mm.v[j] * rs) * gpm.v[j]);
        st_bf16(XR + (size_t)m * D, lane, x);
        const float rs2 = rms_scale(x);
#pragma unroll
        for (int j = 0; j < 4; ++j) x.v[j] = (x.v[j] * rs2) * gpf.v[j] * (sc.v[j] + 1.0f) + sh.v[j];
#pragma unroll
        for (int j = 0; j < 4; ++j) if constexpr (!UP_I8) ((unsigned*)(H8 + (size_t)m * D))[lane + 64 * j] = pg8::pk4_fp8(x.v[j][0], x.v[j][1], x.v[j][2], x.v[j][3]);
        if constexpr (UP_I8) st_i8(H8 + (size_t)m * D, (float*)(a.ws + WS_SAH2) + m, lane, x);
        f32x4 lgv[4];
#pragma unroll
        for (int c = 0; c < 4; ++c) lgv[c] = (f32x4){0.f, 0.f, 0.f, 0.f};
#pragma unroll
        for (int j = 0; j < 4; ++j)
#pragma unroll
            for (int i = 0; i < 4; ++i) { const float hv = x.v[j][i];
#pragma unroll
                for (int c = 0; c < 4; ++c) { const f32x4 w = wl[((j * 4 + i) * 4 + c) * 64 + lane]; lgv[c] = lgv[c] + w * hv; } }
        float lg[16];
#pragma unroll
        for (int e = 0; e < 16; ++e) lg[e] = lgv[e >> 2][e & 3];
        { const bool up = (lane & 32) != 0;
#pragma unroll
          for (int i = 0; i < 8; ++i) { const float snd = up ? lg[i] : lg[i + 8]; const float rcv = __shfl_xor(snd, 32); lg[i] = (up ? lg[i + 8] : lg[i]) + rcv; } }
        { const bool up = (lane & 16) != 0;
#pragma unroll
          for (int i = 0; i < 4; ++i) { const float snd = up ? lg[i] : lg[i + 4]; const float rcv = __shfl_xor(snd, 16); lg[i] = (up ? lg[i + 4] : lg[i]) + rcv; } }
        { const bool up = (lane & 8) != 0;
#pragma unroll
          for (int i = 0; i < 2; ++i) { const float snd = up ? lg[i] : lg[i + 2]; const float rcv = __shfl_xor(snd, 8); lg[i] = (up ? lg[i + 2] : lg[i]) + rcv; } }
        { const bool up = (lane & 4) != 0; const float snd = up ? lg[0] : lg[1]; const float rcv = __shfl_xor(snd, 4); lg[0] = (up ? lg[1] : lg[0]) + rcv; }
        float lgt = lg[0]; lgt += __shfl_xor(lgt, 2); lgt += __shfl_xor(lgt, 1);
        float mx = lgt;
#pragma unroll
        for (int o = 4; o < 64; o <<= 1) mx = fmaxf(mx, __shfl_xor(mx, o));
        const float ex = __expf(lgt - mx); float sm = ex;
#pragma unroll
        for (int o = 4; o < 64; o <<= 1) sm += __shfl_xor(sm, o);
        if ((lane & 3) == 0) affb[(lane >> 2) * 32 + (m - m_begin)] = ex / sm;
    }
    { const int nr = m_end - m_begin;
#pragma unroll
      for (int e = 0; e < 16; ++e) if (lane < nr) AFF[(size_t)e * MA + m_begin + lane] = affb[e * 32 + lane]; }
#undef PM_PREF
    __syncthreads();
}

template <int NJ>
__device__ __forceinline__ void topk_select(const float* AFF, int* INV, int* RIDX, const float* SAH2, float* SAG, int rowbase, int e, int cap, int xsbase, int lane) {
    unsigned key[NJ];
#pragma unroll
    for (int j = 0; j < NJ; ++j) key[j] = __float_as_uint(AFF[(size_t)e * MA + rowbase + j * 64 + lane]);
    unsigned prefix = 0u;
    for (int bit = 30; bit >= 0; --bit) {
        const unsigned cand = prefix | (1u << bit); int cnt = 0;
#pragma unroll
        for (int j = 0; j < NJ; ++j) cnt += __popcll(__ballot(key[j] >= cand));
        if (cnt >= cap) prefix = cand;
    }
    const unsigned T = prefix; int ngt = 0;
#pragma unroll
    for (int j = 0; j < NJ; ++j) ngt += __popcll(__ballot(key[j] > T));
    const int need = cap - ngt; const unsigned long long lt = (1ull << lane) - 1ull;
    int selbase = 0, eqbase = 0;
#pragma unroll
    for (int j = 0; j < NJ; ++j) {
        const bool gt = key[j] > T, eq = key[j] == T; const unsigned long long eqm = __ballot(eq); const int eqr = eqbase + __popcll(eqm & lt);
        const bool sel = gt || (eq && eqr < need); const unsigned long long sm = __ballot(sel); const int slot = selbase + __popcll(sm & lt);
        const int t = j * 64 + lane;
        if (sel) { RIDX[xsbase + slot] = rowbase + t; if constexpr (UP_I8) SAG[xsbase + slot] = SAH2[rowbase + t]; }
        INV[(size_t)e * MA + rowbase + t] = sel ? (xsbase + slot) : -1;
        selbase += __popcll(sm); eqbase += __popcll(eqm);
    }
}
__device__ __forceinline__ void phase_topk(const Args& a, int layer, LAS unsigned char* lds, int gw, int NGW, int lane) {
    const float* AFF = (const float*)(a.ws + WS_AFF); int* INV = (int*)(a.ws + WS_INV); int* RIDX = (int*)(a.ws + WS_RIDX);
    const float* SAH2 = (const float*)(a.ws + WS_SAH2); float* SAG = (float*)(a.ws + WS_SAG);
    const int nitems = (layer == 0) ? 512 : 256;
    for (int it = gw; it < nitems; it += NGW) {
        if (it < 256) { const int e = it >> 4, b = it & 15; topk_select<32>(AFF, INV, RIDX, SAH2, SAG, b * SEQ, e, CAPL, it * 256, lane); }
        else { const int j = it - 256, e = j >> 4, b = j & 15; topk_select<4>(AFF, INV, RIDX, SAH2, SAG, ML + b * CTX, e, CAPC, (NPL + e * 2 + (b >> 3)) * 256 + (b & 7) * CAPC, lane); }
    }
    if (gw >= nitems) { const int G_ = NGW / NWAVES, slot = (layer == 0) ? DS_TOPK0 : DS_TOPK1, idle = def_idle_waves(slot, G_), base = def_base(slot, G_);
        copy_items(a, (LAS float*)(lds + (gw / G_) * (128 * 33 * 4)), lane, base + (gw - nitems), idle, base + def_count(slot, G_)); }
}

__device__ __forceinline__ void phase_combine(const Args& a, int layer, LAS unsigned char* lds, int wave, int gw, int NGW, int lane) {
    const float* MOD = (const float*)(a.ws + WS_MOD); bf16* H = (bf16*)(a.ws + WS_H); const unsigned char* Y = a.ws + WS_Y;
    const float* AFF = (const float*)(a.ws + WS_AFF); const int* INV = (const int*)(a.ws + WS_INV); bf16* XR = (bf16*)(a.ws + WS_XR);
    const int nrows = (layer == 0) ? MA : ML;
    R16 gpo, gnx; ld_f32(gpo, a.in[I_POSTFFN] + layer * D, lane); ld_f32(gnx, a.in[I_PREMIX] + D, lane);
    const int rpw = (nrows + NGW - 1) / NGW, m_begin = gw * rpw, m_end = (m_begin + rpw < nrows) ? m_begin + rpw : nrows;
    int cur_b = -1; R16 g2, sh1, sc1;
    int inv_n = -1; float af_n = 0.f;
    int ninv_c = -1; float naf_c = 0.f; unsigned nyw[4][4]; float ngk[4]; unsigned nrest = 0; v2u nxr[4];
#define CB_IDX(mrow_, iv_, av_) do { const int m_ = (mrow_); const bool ok_ = (lane < 16) && (m_ < m_end); const int o_ = ok_ ? (lane * 32 + (m_ - m_begin)) : 0; const int i_ = binv[o_]; const float a_ = baff[o_]; iv_ = ok_ ? i_ : -1; av_ = ok_ ? a_ : 0.f; } while (0)
#define CB_REQ(mrow_, iv_, av_) do { const int m_ = (mrow_); unsigned mk_ = (unsigned)__ballot((iv_) >= 0) & 0xffffu; \
        _Pragma("unroll") for (int k = 0; k < 4; ++k) { int yr_ = 0; float g_ = 0.f;         \
            if (mk_ != 0) { const int e_ = __builtin_ctz(mk_); mk_ &= mk_ - 1; yr_ = __builtin_amdgcn_readlane((iv_), e_); g_ = __uint_as_float((unsigned)__builtin_amdgcn_readlane((int)__float_as_uint(av_), e_)) * (1.0f / YSCALE); } \
            ngk[k] = g_; _Pragma("unroll") for (int j = 0; j < 4; ++j) nyw[k][j] = ((const unsigned*)(Y + (size_t)yr_ * D))[lane + 64 * j]; } \
        nrest = mk_; ninv_c = (iv_); naf_c = (av_); \
        _Pragma("unroll") for (int j = 0; j < 4; ++j) nxr[j] = ((const v2u*)(XR + (size_t)m_ * D))[lane + 64 * j]; } while (0)
    LAS int* binv = (LAS int*)(lds + wave * 4096); LAS float* baff = (LAS float*)(lds + wave * 4096 + 2048);
    { const int nr = m_end - m_begin; const bool okl = lane < nr; const int ml = okl ? m_begin + lane : 0; int ti[16]; float ta[16];
#pragma unroll
      for (int e = 0; e < 16; ++e) { ti[e] = INV[(size_t)e * MA + ml]; ta[e] = AFF[(size_t)e * MA + ml]; }
      if (lane < 32) {
#pragma unroll
        for (int e = 0; e < 16; ++e) { binv[e * 32 + lane] = okl ? ti[e] : -1; baff[e * 32 + lane] = okl ? ta[e] : 0.f; } } }
    if (m_begin < m_end) { int iv0; float av0; CB_IDX(m_begin, iv0, av0); CB_REQ(m_begin, iv0, av0); CB_IDX(m_begin + 1, inv_n, af_n); }
    for (int m = m_begin; m < m_end; ++m) {
        const int brow = (m < ML) ? (m >> 11) : 16;
        if (brow != cur_b) { const float* md = MOD + (size_t)(layer * 17 + brow) * NMOD; ld_f32(g2, md + 5120, lane);
            if (layer == 0) { const float* md1 = MOD + (size_t)(17 + brow) * NMOD; ld_f32(sh1, md1, lane); ld_f32(sc1, md1 + 1024, lane); } cur_b = brow; }
        unsigned yw[4][4]; float gk[4]; const unsigned rest = nrest; const int inv = ninv_c; const float af = naf_c; R16 x;
#pragma unroll
        for (int k = 0; k < 4; ++k) { gk[k] = ngk[k];
#pragma unroll
            for (int j = 0; j < 4; ++j) yw[k][j] = nyw[k][j]; }
#pragma unroll
        for (int j = 0; j < 4; ++j) x.v[j] = (f32x4){bflo(nxr[j].x), bfhi(nxr[j].x), bflo(nxr[j].y), bfhi(nxr[j].y)};
        if (m + 1 < m_end) { CB_REQ(m + 1, inv_n, af_n); CB_IDX(m + 2, inv_n, af_n); }
        R16 f;
#pragma unroll
        for (int j = 0; j < 4; ++j) f.v[j] = (f32x4){0.f, 0.f, 0.f, 0.f};
#pragma unroll
        for (int k = 0; k < 4; ++k)
#pragma unroll
            for (int j = 0; j < 4; ++j) { const auto lo = __builtin_amdgcn_cvt_pk_f32_fp8((int)yw[k][j], false), hi = __builtin_amdgcn_cvt_pk_f32_fp8((int)yw[k][j], true);
                f.v[j] = f.v[j] + (f32x4){lo[0], lo[1], hi[0], hi[1]} * gk[k]; }
        for (unsigned mk = rest; mk != 0; mk &= mk - 1) { const int e = __builtin_ctz(mk); const int yr = __builtin_amdgcn_readlane(inv, e);
            const float gt = __uint_as_float((unsigned)__builtin_amdgcn_readlane((int)__float_as_uint(af), e)) * (1.0f / YSCALE);
#pragma unroll
            for (int j = 0; j < 4; ++j) { const unsigned w = ((const unsigned*)(Y + (size_t)yr * D))[lane + 64 * j];
                const auto lo = __builtin_amdgcn_cvt_pk_f32_fp8((int)w, false), hi = __builtin_amdgcn_cvt_pk_f32_fp8((int)w, true); f.v[j] = f.v[j] + (f32x4){lo[0], lo[1], hi[0], hi[1]} * gt; } }
        const float rs = rms_scale(f);
#pragma unroll
        for (int j = 0; j < 4; ++j) x.v[j] = x.v[j] + g2.v[j] * ((f.v[j] * rs) * gpo.v[j]);
        if (layer == 0) st_bf16(XR + (size_t)m * D, lane, x); else st_f32(a.out + (size_t)m * D, lane, x);
        if (layer == 0) {
            const float rs2 = rms_scale(x);
#pragma unroll
            for (int j = 0; j < 4; ++j) x.v[j] = (x.v[j] * rs2) * gnx.v[j] * (sc1.v[j] + 1.0f) + sh1.v[j];
            if constexpr (QKV_I8) st_i8(a.ws + WS_H + (size_t)m * D, (float*)(a.ws + WS_SAH) + m, lane, x);
            else if constexpr (ATT8) st_fp8(a.ws + WS_H + (size_t)m * D, lane, x); else st_bf16(H + (size_t)m * D, lane, x);
        }
    }
#undef CB_IDX
#undef CB_REQ
}

constexpr float LAM_INIT = 0.35550906759096926f;
__device__ __forceinline__ void phase_finish(const Args& a, int gw, int NGW, int lane) {
    const bf16* OP = (const bf16*)(a.ws + WS_OPART); bf16* A2 = (bf16*)(a.ws + WS_BUF3);
    const float s1 = wave_sum(a.in[I_LQ1][lane] * a.in[I_LK1][lane]), s2 = wave_sum(a.in[I_LQ2][lane] * a.in[I_LK2][lane]);
    const float lam = expf(s1) - expf(s2) + LAM_INIT;
    const int h = lane >> 3, sub = lane & 7;
    float g[16];
#pragma unroll
    for (int i = 0; i < 16; ++i) g[i] = a.in[I_SUBLN][sub * 16 + i] * (1.0f - LAM_INIT);
    for (int m = gw; m < ML; m += NGW) {
        const v4u* p0 = (const v4u*)(OP + (size_t)m * 2048 + h * 256 + sub * 16); const v4u* p1 = (const v4u*)(OP + (size_t)m * 2048 + h * 256 + 128 + sub * 16);
        v4u x0[2], x1[2]; x0[0] = p0[0]; x0[1] = p0[1]; x1[0] = p1[0]; x1[1] = p1[1];
        float o[16]; float ss = 0.f;
#pragma unroll
        for (int hh = 0; hh < 2; ++hh)
#pragma unroll
            for (int q = 0; q < 4; ++q) { const int i = hh * 8 + q * 2; o[i] = bflo(x0[hh][q]) - lam * bflo(x1[hh][q]); o[i + 1] = bfhi(x0[hh][q]) - lam * bfhi(x1[hh][q]); ss += o[i] * o[i] + o[i + 1] * o[i + 1]; }
        ss += __shfl_xor(ss, 1); ss += __shfl_xor(ss, 2); ss += __shfl_xor(ss, 4);
        const float rs = 1.0f / sqrtf(ss * (1.0f / 128.0f) + EPS);
        v4u w[2];
#pragma unroll
        for (int hh = 0; hh < 2; ++hh)
#pragma unroll
            for (int q = 0; q < 4; ++q) { const int i = hh * 8 + q * 2; w[hh][q] = pk2(o[i] * rs * g[i], o[i + 1] * rs * g[i + 1]); }
        if constexpr (ATT8) { v4u w8;
#pragma unroll
            for (int q2 = 0; q2 < 4; ++q2) { const int i = q2 * 4; w8[q2] = pg8::pk4_fp8(o[i] * rs * g[i], o[i + 1] * rs * g[i + 1], o[i + 2] * rs * g[i + 2], o[i + 3] * rs * g[i + 3]); }
            *(v4u*)(a.ws + WS_BUF3 + (size_t)m * D + h * 128 + sub * 16) = w8; }
        else { v4u* dst = (v4u*)(A2 + (size_t)m * D + h * 128 + sub * 16); dst[0] = w[0]; dst[1] = w[1]; }
    }
}

__global__ void __launch_bounds__(NWAVES * 64, 2) fwd_kernel(Args args) {
    extern __shared__ __attribute__((aligned(16))) unsigned char lds_raw[];
    LAS unsigned char* lds = (LAS unsigned char*)lds_raw;
    volatile LAS unsigned* MISC = (volatile LAS unsigned*)(lds + MISC_OFF);
    const int tid = threadIdx.x, lane = tid & 63, wave = __builtin_amdgcn_readfirstlane(tid >> 6);
    const int G = gridDim.x; const int bx = blockIdx.x; const int vcu = (G % 8 == 0) ? (bx % 8) * (G / 8) + bx / 8 : bx;
    const int gw = vcu * NWAVES + wave, NGW = G * NWAVES;
    unsigned char* ws = args.ws;
    gu32* ctl = (gu32*)(ws + WS_CTL);
    for (int u = tid; u < (LDS_BYTES - LDSCTL_OFF) / 4; u += NWAVES * 64) ((LAS unsigned*)(lds + LDSCTL_OFF))[u] = 0u;
    __syncthreads();
    XcdBarrier bar; bar.bar = (unsigned*)(ctl + CW_BAR); bar.x = 0; bar.st = nullptr;
    if (!MK_SPLIT) bar = xcd_barrier_post((unsigned*)(ctl + CW_BAR), MISC + 8);
    const int lo = args.ph_lo, hi = args.ph_hi;
#ifndef PH_MASK
#define PH_MASK 0xFFFFFFFFu
#endif
#define IN(k) (((PH_MASK >> (((k) >= 14) ? (k) - 9 : (k))) & 1u) && lo <= (k) && (k) < hi)
#define SEAM(k) do { if (IN(k) && IN((k) + 1)) xcd_barrier(bar); } while (0)
#ifndef DUP_MASK
#define DUP_MASK 0u
#endif
#ifndef PROBE_NULLEPI
#define PROBE_NULLEPI 0
#endif
#ifndef PROBE_ATT
#define PROBE_ATT 0
#endif
#define REPS(k) (((DUP_MASK >> (k)) & 1u) ? 2 : 1)
#define DUPLOOP(k) _Pragma("unroll") for (int rep_ = 0; rep_ < REPS(k); (++rep_ < REPS(k)) ? xcd_barrier(bar) : (void)0)

    bf16* Hb = (bf16*)(ws + WS_H);
    if (IN(0)) DUPLOOP(0) { phase_prologue_a(args, lds, vcu, G, wave, lane_now(), wave * 64 + lane_now()); } SEAM(0);
    if (IN(1)) DUPLOOP(1) { phase_prologue_b(args, gw, NGW, lane_now()); } SEAM(1);

    if (IN(2)) DUPLOOP(2) {
        pg8::Gemm g{Hb, (const bf16*)(ws + WS_WIN), MA, 3072, (CIN_I8 || CONV8) ? D / 2 : D}; pg8::SchedGrid S{MA / 256, 12, G, bx};
        pg8::EpiConvIn E{(bf16*)(ws + WS_BUF2), (bf16*)(ws + WS_BUF1), CIN_I8 ? 1.0f / WS8 : (CONV8 ? 1.0f / WSCALE : 1.0f)};
        if constexpr (CIN_I8) pg8::gemm_phase_i8<pg8::EpiConvIn, pg8::SchedGrid, true, true>(lds, g, S, E, (const float*)(ws + WS_SAH));
        else if constexpr (CONV8) pg8::gemm_phase8<pg8::EpiConvIn, pg8::SchedGrid, true, true>(lds, g, S, E); else pg8::gemm_phase<pg8::EpiConvIn, pg8::SchedGrid, true, true>(lds, g, S, E);
        tail_items(args, lds, DS_CIN, (MA / 256) * 12, G, bx, wave, lane_now());
    } SEAM(2);
    if (IN(3)) DUPLOOP(3) { phase_conv(args, gw, NGW, lane_now()); } SEAM(3);
    if (IN(4)) DUPLOOP(4) {
        pg8::Gemm g{Hb, (const bf16*)(ws + WS_WOUT), MA, D, (COUT_I8 || CONVO8) ? D / 2 : D}; pg8::SchedGrid S{MA / 256, 4, G, bx};
        pg8::EpiPlain E{(bf16*)(ws + WS_BUF1), D, COUT_I8 ? 1.0f / WS8 : (CONVO8 ? 1.0f / WSCALE : 1.0f)};
        if constexpr (COUT_I8) pg8::gemm_phase_i8<pg8::EpiPlain, pg8::SchedGrid, true, true>(lds, g, S, E, (const float*)(ws + WS_SAH));
        else if constexpr (CONVO8) pg8::gemm_phase8<pg8::EpiPlain, pg8::SchedGrid, true, true>(lds, g, S, E); else pg8::gemm_phase<pg8::EpiPlain, pg8::SchedGrid, true, true>(lds, g, S, E);
        tail_items(args, lds, DS_COUT, (MA / 256) * 4, G, bx, wave, lane_now());
    } SEAM(4);

#define FFN_BLOCK(layer, pb) do { \
        constexpr int npanels = ((layer) == 0) ? (NPL + NPC) : NPL; \
        if (IN(pb)) DUPLOOP(pb) { phase_postmix(args, (layer), lds, gw, NGW, lane_now(), wave * 64 + lane_now()); } SEAM(pb); \
        if (IN((pb) + 1)) DUPLOOP((pb) + 1) { phase_topk(args, (layer), lds, wave * G + vcu, NGW, lane_now());     } SEAM((pb) + 1); \
        if (IN((pb) + 2)) DUPLOOP((pb) + 2) { \
            pg8::Gemm g{(const bf16*)(ws + WS_H8), (const bf16*)(ws + WS_WGU8 + (size_t)(layer) * NE * 4096 * D), npanels * 256, 4096, D / 2}; pg8::SchedMoE S{npanels, 16, G, bx}; \
            pg8::EpiSwiGLU8 E{ws + WS_HID8, FF, UP_I8 ? 1.0f / WS8 : 1.0f / WSCALE, HSCALE}; \
            if (PROBE_NULLEPI == 1 && REPS((pb) + 2) == 2 && rep_ == 0) { pg8::EpiNull E0; pg8::gemm_phase8g<pg8::EpiNull, pg8::SchedMoE, true, true>(lds, g, S, E0, (const int*)(ws + WS_RIDX)); } else \
            if (PROBE_NULLEPI == 2 && REPS((pb) + 2) == 2 && rep_ == 0) { pg8::EpiNull E0; pg8::SchedSame S0{npanels, 16, G, bx}; pg8::gemm_phase8g<pg8::EpiNull, pg8::SchedSame, true, true>(lds, g, S0, E0, (const int*)(ws + WS_RIDX)); } else \
            if constexpr (UP_I8) pg8::gemm_phase_i8g<pg8::EpiSwiGLU8, pg8::SchedMoE, true, true>(lds, g, S, E, (const int*)(ws + WS_RIDX), (const float*)(ws + WS_SAG)); else \
            pg8::gemm_phase8g<pg8::EpiSwiGLU8, pg8::SchedMoE, true, true>(lds, g, S, E, (const int*)(ws + WS_RIDX)); \
        } SEAM((pb) + 2); \
        if (IN((pb) + 3)) DUPLOOP((pb) + 3) { \
            pg8::Gemm g{(const bf16*)(ws + WS_HID8), (const bf16*)(ws + WS_WD8 + (size_t)(layer) * NE * D * FF), npanels * 256, D, FF / 2}; pg8::SchedMoE S{npanels, 4, G, bx}; \
            pg8::EpiPlain8 E{ws + WS_Y, D, YSCALE / (WSCALE * HSCALE)}; \
            pg8::gemm_phase8<pg8::EpiPlain8, pg8::SchedMoE, true, true>(lds, g, S, E); \
            if ((layer) == 0) tail_items(args, lds, DS_DOWN0, npanels * 4, G, bx, wave, lane_now()); \
        } SEAM((pb) + 3); \
        if (IN((pb) + 4)) DUPLOOP((pb) + 4) { phase_combine(args, (layer), lds, wave, gw, NGW, lane_now()); } \
    } while (0)

    FFN_BLOCK(0, 5); SEAM(9);

    if (IN(10)) DUPLOOP(10) {
        pg8::Gemm g{Hb, (const bf16*)(ws + WS_WQKV), MA, 3072, (QKV_I8 || ATT8) ? D / 2 : D}; pg8::SchedQKV S{G, bx};
        pg8::EpiQKV E{(bf16*)(ws + WS_BUF3), (bf16*)(ws + WS_BUF1), (bf16*)(ws + WS_BUF2), (const float*)(ws + WS_ROPE), QSCALE, QKV_I8 ? 1.0f / WS8 : (ATT8 ? 1.0f / WSCALE : 1.0f)};
        if constexpr (QKV_I8) pg8::gemm_phase_i8<pg8::EpiQKV, pg8::SchedQKV, true, true>(lds, g, S, E, (const float*)(ws + WS_SAH));
        else if constexpr (ATT8) pg8::gemm_phase8<pg8::EpiQKV, pg8::SchedQKV, true, true>(lds, g, S, E); else pg8::gemm_phase<pg8::EpiQKV, pg8::SchedQKV, true, true>(lds, g, S, E);
        tail_items(args, lds, DS_QKV, 128 * 12 + 16 * 8, G, bx, wave, lane_now());
    } SEAM(10);
    if (IN(11)) DUPLOOP(11) {
        static_assert(att::ATTN_LDS_TOTAL <= LDSCTL_OFF, "attention LDS");
        const unsigned char* Q = ws + WS_BUF3; const unsigned char* Kb = ws + WS_BUF1;   const unsigned char* Vt = ws + WS_BUF2;   unsigned char* A2 = ws + WS_OPART;
        const float s1 = wave_sum(args.in[I_LQ1][lane_now()] * args.in[I_LK1][lane_now()]), s2 = wave_sum(args.in[I_LQ2][lane_now()] * args.in[I_LK2][lane_now()]);
        const float lam = __uint_as_float(__builtin_amdgcn_readfirstlane(__float_as_uint(expf(s1) - expf(s2) + LAM_INIT)));
        for (int L = vcu; L < 1024; L += G) { const int qb = L & 7, h = (L >> 3) & 7, b = L >> 6;
            const int Ln = L + G; const bool hn = Ln < 1024; const int bhn = hn ? (Ln >> 3) : 0;
            const unsigned char* Kn = hn ? Kb + (size_t)bhn * (2 * 2304 * 64) : nullptr; const unsigned char* Vn = hn ? Vt + (size_t)bhn * (36 * 8192) : nullptr;
            if (PROBE_ATT != 0 && REPS(11) == 2 && rep_ == 0) att::attn_diff_unit<ATT8, PROBE_ATT>(Q + ((size_t)b * SEQ + qb * 256) * D + h * 128, Kb + (size_t)(b * 8 + h) * (2 * 2304 * 64), Vt + (size_t)(b * 8 + h) * (36 * 8192), nullptr, nullptr, false,
                                      A2 + ((size_t)b * SEQ + qb * 256) * (ATT8 ? D : 2 * D) + h * (ATT8 ? 128 : 256), lam, args.in[I_SUBLN], 1.0f - LAM_INIT, (char*)lds_raw, lds); else
            att::attn_diff_unit<ATT8>(Q + ((size_t)b * SEQ + qb * 256) * D + h * 128, Kb + (size_t)(b * 8 + h) * (2 * 2304 * 64), Vt + (size_t)(b * 8 + h) * (36 * 8192), Kn, Vn, L != vcu,
                                      A2 + ((size_t)b * SEQ + qb * 256) * (ATT8 ? D : 2 * D) + h * (ATT8 ? 128 : 256), lam, args.in[I_SUBLN], 1.0f - LAM_INIT, (char*)lds_raw, lds); }
    } SEAM(11);
    if (IN(13)) DUPLOOP(13) {
        pg8::Gemm g{(const bf16*)(ws + WS_OPART), (const bf16*)(ws + WS_WO), ML, D, ATT8 ? D / 2 : D}; pg8::SchedGrid S{ML / 256, 4, G, bx};
        pg8::EpiPlain E{(bf16*)(ws + WS_BUF1), D, ATT8 ? 1.0f / WSCALE : 1.0f};
        if constexpr (ATT8) pg8::gemm_phase8<pg8::EpiPlain, pg8::SchedGrid, true, true>(lds, g, S, E); else pg8::gemm_phase<pg8::EpiPlain, pg8::SchedGrid, true, true>(lds, g, S, E);
    } SEAM(13);

    FFN_BLOCK(1, 14);
#undef FFN_BLOCK
#undef IN
#undef SEAM
}

extern "C" void kernel_launch(void* const* d_in, const int* in_sizes, int n_in, void* d_out, int out_size, void* d_ws, size_t ws_size, hipStream_t stream) {
    static int grid = 0;
    if (grid == 0) {
        if (n_in != 24 || in_sizes[0] != ML * D || out_size != ML * D || ws_size < WS_END) {
            fprintf(stderr, "kernel_launch: shape mismatch: n_in %d in0 %d out %d ws %zu (need >= %zu); nothing launched\n", n_in, n_in > 0 ? in_sizes[0] : -1, out_size, ws_size, (size_t)WS_END); grid = -1; return; }
        int dev = 0, cus = 0, per_cu = 0;
        if (hipGetDevice(&dev) != hipSuccess || hipDeviceGetAttribute(&cus, hipDeviceAttributeMultiprocessorCount, dev) != hipSuccess) { fprintf(stderr, "kernel_launch: device query failed\n"); grid = -1; return; }
        if (hipFuncSetAttribute((const void*)fwd_kernel, hipFuncAttributeMaxDynamicSharedMemorySize, LDS_BYTES) != hipSuccess) { fprintf(stderr, "kernel_launch: hipFuncSetAttribute failed\n"); grid = -1; return; }
        if (hipOccupancyMaxActiveBlocksPerMultiprocessor(&per_cu, (const void*)fwd_kernel, NWAVES * 64, LDS_BYTES) != hipSuccess || per_cu < 1)
            fprintf(stderr, "kernel_launch: note: occupancy query reports %d workgroups per CU\n", per_cu);
        (void)hipGetLastError();
        grid = cus;
    }
    if (grid < 0) return;
    if (hipMemsetAsync((char*)d_ws + WS_CTL, 0, CTL_ZERO_BYTES, stream) != hipSuccess) { fprintf(stderr, "kernel_launch: memset failed\n"); return; }
    Args a{};
    for (int i = 0; i < 24; ++i) a.in[i] = (const float*)d_in[i];
    a.out = (float*)d_out; a.ws = (unsigned char*)d_ws;
#if MK_SPLIT
    for (int p = 0; p < N_PHASES; ++p) { a.ph_lo = p; a.ph_hi = p + 1; hipLaunchKernelGGL(fwd_kernel, dim3(grid), dim3(NWAVES * 64), LDS_BYTES, stream, a); }
#else
    a.ph_lo = 0; a.ph_hi = N_PHASES;
    hipLaunchKernelGGL(fwd_kernel, dim3(grid), dim3(NWAVES * 64), LDS_BYTES, stream, a);
#endif
    const hipError_t le = hipPeekAtLastError();
    if (le != hipSuccess) fprintf(stderr, "kernel_launch: launch failed: %s\n", hipGetErrorName(le));
}
```
